# Optimizing an MI355X kernel written in HIP

```python
import math
import jax, jax.numpy as jnp
from jax import lax
import numpy as np

D_MODEL = 2048
BATCH = 2
SEQ = 16384
DEPTH = 2
DEC_BATCH = 4
DEC_SEQ = 2048
PAST_LEN = 128

MIX_W = D_MODEL
GROUP_W = MIX_W // 4
HEAD_DIM = 64
N_HEADS = GROUP_W // HEAD_DIM
N_KV = 2
N_REP = N_HEADS // N_KV
KV_W = N_KV * HEAD_DIM
SCONV_K = 3
CONF_K = 31
WINDOW = 128
WB = 128
QB = 128
GRID_W = 64
ROPE_THETA = 10000.0
D_FF = 4 * D_MODEL
RMS_EPS = 1e-6
LN_EPS = 1e-5
SPLIT_SIZES = (GROUP_W, GROUP_W, GROUP_W,
               GROUP_W, KV_W, KV_W,
               GROUP_W, KV_W, KV_W,
               GROUP_W, GROUP_W)
IN_W = sum(SPLIT_SIZES)

kernel_name = 'hymba_style_hybrid_encoder'


def _rms(x, g):
    xf = x.astype(jnp.float32)
    y = xf * lax.rsqrt(jnp.mean(xf * xf, axis=-1, keepdims=True) + RMS_EPS)
    return (y * g.astype(jnp.float32)).astype(x.dtype)


def _layernorm(x, g, b):
    xf = x.astype(jnp.float32)
    mu = jnp.mean(xf, axis=-1, keepdims=True)
    var = jnp.mean(jnp.square(xf - mu), axis=-1, keepdims=True)
    y = (xf - mu) * lax.rsqrt(var + LN_EPS)
    return (y * g.astype(jnp.float32) + b.astype(jnp.float32)).astype(x.dtype)


def _rope_cos_sin(pos, dim):
    inv = 1.0 / (ROPE_THETA ** (jnp.arange(0, dim, 2, dtype=jnp.float32) / dim))
    ang = pos.astype(jnp.float32)[:, None] * inv[None, :]
    return jnp.cos(ang), jnp.sin(ang)


def _apply_rope(x, cos, sin):
    xf = x.astype(jnp.float32)
    half = xf.shape[-1] // 2
    x1, x2 = xf[..., :half], xf[..., half:]
    c = cos[None, :, None, :]
    s = sin[None, :, None, :]
    return jnp.concatenate([x1 * c - x2 * s, x2 * c + x1 * s], axis=-1).astype(x.dtype)


def _dwconv(x, w, b=None):
    k, c = w.shape
    y = lax.conv_general_dilated(x, w.astype(x.dtype)[:, None, :], window_strides=(1,),
                                 padding=[(k // 2, k // 2)],
                                 dimension_numbers=('NWC', 'WIO', 'NWC'),
                                 feature_group_count=c)
    if b is not None:
        y = y + b.astype(x.dtype)
    return y


def _global_attn(q, k, v):
    b, s, _, d = q.shape
    nb = s // QB
    scale = 1.0 / math.sqrt(d)
    qb = (q * scale).reshape(b, nb, QB, N_KV, N_REP, d).transpose(1, 0, 2, 3, 4, 5)

    def block(qi):
        sc = jnp.einsum('bqkgd,bskd->bkgqs', qi, k).astype(jnp.float32)
        p = jax.nn.softmax(sc, axis=-1).astype(v.dtype)
        return jnp.einsum('bkgqs,bskd->bqkgd', p, v)

    o = lax.map(block, qb)
    return o.transpose(1, 0, 2, 3, 4, 5).reshape(b, s, N_HEADS * d)


def _window_attn(q, k, v, sink):
    b, s, _, d = q.shape
    nb = s // WB
    scale = 1.0 / math.sqrt(d)
    qb = (q * scale).reshape(b, nb, WB, N_KV, N_REP, d)

    def band(t):
        tp = jnp.pad(t, ((0, 0), (WB, WB), (0, 0), (0, 0))).reshape(b, nb + 2, WB, N_KV, d)
        return jnp.concatenate([tp[:, :-2], tp[:, 1:-1], tp[:, 2:]], axis=2)

    kw, vw = band(k), band(v)
    n = jnp.arange(nb)[:, None, None]
    i = jnp.arange(WB)[None, :, None]
    j = jnp.arange(3 * WB)[None, None, :]
    qpos = n * WB + i
    kpos = n * WB - WB + j
    valid = (jnp.abs(qpos - kpos) <= WINDOW) & (kpos >= 0) & (kpos < s)
    sc = jnp.einsum('bnqkgd,bnskd->bnkgqs', qb, kw).astype(jnp.float32)
    sc = jnp.where(valid[None, :, None, None, :, :], sc, -1e30)
    sk = sink.astype(jnp.float32).reshape(1, 1, N_KV, N_REP, 1, 1)
    m = jnp.maximum(jnp.max(sc, axis=-1, keepdims=True), sk)
    e = jnp.exp(sc - m)
    p = (e / (jnp.sum(e, axis=-1, keepdims=True) + jnp.exp(sk - m))).astype(v.dtype)
    o = jnp.einsum('bnkgqs,bnskd->bnqkgd', p, vw)
    return o.reshape(b, s, N_HEADS * d)


def _layer(x, pre_mix_g, w_in, conv_a_w, q_norm_g, k_norm_g, sink_c, conv_d_w, conv_d_b,
           ln_d_g, ln_d_b, w_out, post_mix_g, pre_ffn_g, w_ff1, w_ff2, post_ffn_g):
    b, s, _ = x.shape
    rows = s // GRID_W
    row_pos = jnp.repeat(jnp.arange(rows), GRID_W)
    col_pos = jnp.tile(jnp.arange(GRID_W), rows)
    lin_pos = jnp.arange(s)

    h = _rms(x, pre_mix_g)
    z = jnp.einsum('bsd,de->bse', h, w_in.astype(h.dtype))
    idx = np.cumsum(SPLIT_SIZES)[:-1].tolist()
    (a_b, a_c, a_v, qB, kB, vB, qC, kC, vC, d_a, d_g) = jnp.split(z, idx, axis=-1)

    y_a = a_b * _dwconv(a_c * a_v, conv_a_w)

    qB = _rms(qB.reshape(b, s, N_HEADS, HEAD_DIM), q_norm_g)
    kB = _rms(kB.reshape(b, s, N_KV, HEAD_DIM), k_norm_g)
    vB = vB.reshape(b, s, N_KV, HEAD_DIM)
    half = HEAD_DIM // 2
    rc, rs = _rope_cos_sin(row_pos, half)
    cc, cs = _rope_cos_sin(col_pos, half)

    def axial(t):
        return jnp.concatenate([_apply_rope(t[..., :half], rc, rs),
                                _apply_rope(t[..., half:], cc, cs)], axis=-1)

    y_b = _global_attn(axial(qB), axial(kB), vB)

    lc, ls = _rope_cos_sin(lin_pos, HEAD_DIM)
    qC = _apply_rope(qC.reshape(b, s, N_HEADS, HEAD_DIM), lc, ls)
    kC = _apply_rope(kC.reshape(b, s, N_KV, HEAD_DIM), lc, ls)
    vC = vC.reshape(b, s, N_KV, HEAD_DIM)
    y_c = _window_attn(qC, kC, vC, sink_c)

    u = d_a * jax.nn.sigmoid(d_g)
    u = _dwconv(u, conv_d_w, conv_d_b)
    y_d = jax.nn.silu(_layernorm(u, ln_d_g, ln_d_b))

    y = jnp.concatenate([y_a, y_b, y_c, y_d], axis=-1)
    y = jnp.einsum('bse,ed->bsd', y, w_out.astype(y.dtype))
    x = x + _rms(y, post_mix_g)

    h = _rms(x, pre_ffn_g)
    u = jnp.square(jax.nn.relu(jnp.einsum('bsd,df->bsf', h, w_ff1.astype(h.dtype))))
    y = jnp.einsum('bsf,fd->bsd', u, w_ff2.astype(u.dtype))
    return x + _rms(y, post_ffn_g)


def setup_inputs(seed: int = 0) -> dict:
    key = jax.random.key(seed)
    ks = jax.random.split(key, 24)
    f32 = jnp.float32

    def nrm(k, shape, scale):
        return jax.random.normal(k, shape, f32) * scale

    def gain(k, shape):
        return 1.0 + 0.05 * jax.random.normal(k, shape, f32)

    return {
        'x_prompt': nrm(ks[0], (BATCH, SEQ, D_MODEL), 1.0),
        'x_sample': nrm(ks[1], (DEC_BATCH, DEC_SEQ, D_MODEL), 1.0),
        'pre_mix_g': gain(ks[2], (DEPTH, D_MODEL)),
        'w_in': nrm(ks[3], (DEPTH, D_MODEL, IN_W), D_MODEL ** -0.5),
        'conv_a_w': nrm(ks[4], (DEPTH, SCONV_K, GROUP_W), SCONV_K ** -0.5),
        'q_norm_g': gain(ks[5], (DEPTH, HEAD_DIM)),
        'k_norm_g': gain(ks[6], (DEPTH, HEAD_DIM)),
        'sink_c': nrm(ks[7], (DEPTH, N_HEADS), 0.5),
        'conv_d_w': nrm(ks[8], (DEPTH, CONF_K, GROUP_W), CONF_K ** -0.5),
        'conv_d_b': nrm(ks[9], (DEPTH, GROUP_W), 0.02),
        'ln_d_g': gain(ks[10], (DEPTH, GROUP_W)),
        'ln_d_b': nrm(ks[11], (DEPTH, GROUP_W), 0.02),
        'w_out': nrm(ks[12], (DEPTH, MIX_W, D_MODEL), MIX_W ** -0.5),
        'post_mix_g': gain(ks[13], (DEPTH, D_MODEL)),
        'pre_ffn_g': gain(ks[14], (DEPTH, D_MODEL)),
        'w_ff1': nrm(ks[15], (DEPTH, D_MODEL, D_FF), D_MODEL ** -0.5),
        'w_ff2': nrm(ks[16], (DEPTH, D_FF, D_MODEL), D_FF ** -0.5),
        'post_ffn_g': gain(ks[17], (DEPTH, D_MODEL)),
    }


def reference(x_prompt, x_sample, pre_mix_g, w_in, conv_a_w, q_norm_g, k_norm_g, sink_c,
              conv_d_w, conv_d_b, ln_d_g, ln_d_b, w_out, post_mix_g, pre_ffn_g, w_ff1,
              w_ff2, post_ffn_g):
    yp = x_prompt
    ys = x_sample
    for l in range(DEPTH):
        params = (pre_mix_g[l], w_in[l], conv_a_w[l], q_norm_g[l], k_norm_g[l], sink_c[l],
                  conv_d_w[l], conv_d_b[l], ln_d_g[l], ln_d_b[l], w_out[l], post_mix_g[l],
                  pre_ffn_g[l], w_ff1[l], w_ff2[l], post_ffn_g[l])
        yp = _layer(yp, *params)
        ys = _layer(ys, *params)
    return (yp, ys)
```

```cpp
#include <hip/hip_runtime.h>
#include <hip/hip_bf16.h>
#include <cstdio>
#include <cstdint>
#include <cmath>
namespace pg8 {
#define PG8_LAS __attribute__((address_space(3)))
typedef unsigned short bf16_t;
typedef short bf16x8 __attribute__((ext_vector_type(8)));
typedef float f32x4 __attribute__((ext_vector_type(4)));
typedef unsigned u32x4 __attribute__((ext_vector_type(4)));
constexpr int BM = 256, BK = 64, HALF = 128, HTB = HALF * BK * 2  , STAGE_BYTES = 8 * HTB, NXCD = 8, WGM = 8;

__host__ __device__ __forceinline__ int lds_byte(int r, int c) { const int st = (r >> 4) * 2 + (c >> 5), rr = r & 15, cc = c & 31, ob = rr * 64 + cc * 2; return st * 1024 + (ob ^ (((ob >> 9) & 1) << 5)); }
__host__ __device__ __forceinline__ void stage_rc(int b, int& R, int& C) { const int st = b / 1024, sb = b % 1024, swz = sb ^ (((sb >> 9) & 1) << 5); R = (st >> 1) * 16 + swz / 64; C = (st & 1) * 32 + (swz % 64) / 2; }
__host__ __device__ __forceinline__ int perm32(int rho) { const int n = rho >> 4, i = rho & 15; return 8 * (i >> 2) + 4 * n + (i & 3); }

struct Unit { int pm, pn; };
struct Gemm { const bf16_t* A; const bf16_t* Bt; int M, N, K; };

struct StaticOrder {
    int nM, nN, nwg, G, c;
    __host__ __device__ void init(int M, int N, int G_, int c_) { nM = M / BM; nN = N / BM; nwg = nM * nN; G = G_; c = c_; }
    __host__ __device__ bool next(int i, Unit& u) const {
        const long L = (long)i * G + c; if (L >= nwg) return false;
        int wgid = (int)L; { const int q = nwg / NXCD, r = nwg % NXCD, xcd = wgid % NXCD, off = wgid / NXCD; wgid = (xcd < r ? xcd * (q + 1) : r * (q + 1) + (xcd - r) * q) + off; }
        const int nig = WGM * nN, gid = wgid / nig, fm = gid * WGM, gsz = (nM - fm) < WGM ? (nM - fm) : WGM;
        u.pm = fm + ((wgid % nig) % gsz); u.pn = (wgid % nig) / gsz; return true;
    }
    __device__ __forceinline__ void a_ready(const Unit&) const {}
    __device__ __forceinline__ void done(const Unit&) const {}
};

__device__ __forceinline__ unsigned cvt_pk_bf16(float lo, float hi) { unsigned r; asm volatile("v_cvt_pk_bf16_f32 %0, %1, %2" : "=v"(r) : "v"(lo), "v"(hi)); return r; }
typedef float f32x2 __attribute__((ext_vector_type(2)));
__device__ __forceinline__ f32x2 gelu_pk(f32x2 v) {
    const f32x2 av = __builtin_elementwise_abs(v), d = av * 0.2316418882f + 1.0f;
    f32x2 t; t.x = __builtin_amdgcn_rcpf(d.x); t.y = __builtin_amdgcn_rcpf(d.y);
    f32x2 q = t * 0.5307027145f + (-0.7265760135f); q = q * t + 0.7107068705f; q = q * t + (-0.142248368f); q = q * t + 0.127414796f; q = q * t;
    const f32x2 s = (v * v) * (-0.72134752044f);
    f32x2 e; e.x = __builtin_amdgcn_exp2f(s.x); e.y = __builtin_amdgcn_exp2f(s.y);
    const f32x2 m = v * (q * e), r = v - m;
    f32x2 o; o.x = v.x < 0.f ? m.x : r.x; o.y = v.y < 0.f ? m.y : r.y; return o;
}

template <int ACT  > struct EpiBf16 {
    static constexpr bool PERM = true, AFTER_DRAIN = false; static_assert(ACT == 0 || ACT == 1 || ACT == 2, "EpiBf16: ACT is 0 (none), 1 (gelu_pk) or 2 (squared relu)");
    bf16_t* O; int ldc; const float* bias; int split_cols; size_t split_stride; float scale0;
    __device__ __forceinline__ void operator()(const f32x4 (&acc)[2][2][4][2], const Unit& u, int wr, int wc, int fr, int fq) const {
        const int row0 = u.pm * BM + wr * 64 + fr; int colt = u.pn * BM; bf16_t* base = O;
        float sc = 1.f; if (split_cols) { const int t = colt / split_cols; base += (size_t)t * split_stride; colt -= t * split_cols; if (t == 0) sc = scale0; }
        const int col0 = colt + wc * 32 + 8 * fq, bcol0 = u.pn * BM + wc * 32 + 8 * fq;
        f32x4 bv[2][2];
#pragma unroll
        for (int bj = 0; bj < 2; ++bj)
#pragma unroll
            for (int n = 0; n < 2; ++n) bv[bj][n] = bias ? *(const f32x4*)(bias + bcol0 + bj * HALF + 4 * n) : (f32x4){0.f, 0.f, 0.f, 0.f};
#pragma unroll
        for (int ai = 0; ai < 2; ++ai)
#pragma unroll
            for (int m = 0; m < 4; ++m) { bf16_t* rowp = base + (size_t)(row0 + ai * HALF + m * 16) * ldc + col0;
#pragma unroll
                for (int bj = 0; bj < 2; ++bj) { f32x4 v0 = acc[ai][bj][m][0] + bv[bj][0], v1 = acc[ai][bj][m][1] + bv[bj][1];
                    if (ACT == 1) { f32x2 a = gelu_pk((f32x2){v0[0], v0[1]}), b = gelu_pk((f32x2){v0[2], v0[3]}), c = gelu_pk((f32x2){v1[0], v1[1]}), d = gelu_pk((f32x2){v1[2], v1[3]});
                        v0 = (f32x4){a.x, a.y, b.x, b.y}; v1 = (f32x4){c.x, c.y, d.x, d.y}; }
                    if (ACT == 2) { const f32x4 z4 = (f32x4){0.f, 0.f, 0.f, 0.f}; v0 = __builtin_elementwise_max(v0, z4); v1 = __builtin_elementwise_max(v1, z4); v0 = v0 * v0; v1 = v1 * v1; }
                    v0 = v0 * sc; v1 = v1 * sc; u32x4 w; w.x = cvt_pk_bf16(v0[0], v0[1]); w.y = cvt_pk_bf16(v0[2], v0[3]); w.z = cvt_pk_bf16(v1[0], v1[1]); w.w = cvt_pk_bf16(v1[2], v1[3]);
                    *(u32x4*)(rowp + bj * HALF) = w; } }
    }
};

template <class Epi, class Sched, bool ALIGN_EPI = false, bool SP2 = false>
__device__ __forceinline__ void gemm_phase(PG8_LAS unsigned char* lds, const Gemm g, const Sched& S, const Epi& E) {
    int tid_ = threadIdx.x; asm volatile("" : "+v"(tid_));
    const int tid = tid_, wid = __builtin_amdgcn_readfirstlane(tid >> 6), lane = tid & 63, wr = wid >> 2, wc = wid & 3, fr = lane & 15, fq = lane >> 4;
    const int K = g.K, nt = K / BK;
    unsigned voffA[2], voffB[2];
#pragma unroll
    for (int i = 0; i < 2; ++i) { int R, C; stage_rc(tid * 16 + i * 8192, R, C); const int Rb = Epi::PERM ? ((R & ~31) + perm32(R & 31)) : R;
        voffA[i] = (unsigned)(R * K + C) * 2u; voffB[i] = (unsigned)(Rb * K + C) * 2u; }
    const size_t kstep = (size_t)(BK * 2);
    const size_t hstep = (size_t)HALF * K * 2;
    const size_t tstep = 2 * hstep;
    const unsigned ldsw = (unsigned)wid * 1024u;
    const int aoff = lds_byte(wr * 64 + fr, fq * 8), boff = lds_byte(wc * 32 + fr, fq * 8);
#define PG8_SA(b, h) (((b) * 2 + (h)) * HTB)
#define PG8_SB(b, h) ((4 + (b) * 2 + (h)) * HTB)
#define PG8_STAGE(bufoff, gbase, voff) do { _Pragma("unroll") for (int _i = 0; _i < 2; ++_i) \
        __builtin_amdgcn_global_load_lds((const unsigned*)((const char*)(gbase) + (voff)[_i]), (PG8_LAS unsigned*)(lds + (bufoff) + ldsw + _i * 8192), 16, 0, 0); } while (0)
#define PG8_LDA(dst, b, h) do { _Pragma("unroll") for (int m = 0; m < 4; ++m) _Pragma("unroll") for (int k = 0; k < 2; ++k) dst[m][k] = *(const PG8_LAS bf16x8*)(lds + PG8_SA(b, h) + aoff + m * 2048 + k * 1024); } while (0)
#define PG8_LDB(dst, b, h) do { _Pragma("unroll") for (int n = 0; n < 2; ++n) _Pragma("unroll") for (int k = 0; k < 2; ++k) dst[n][k] = *(const PG8_LAS bf16x8*)(lds + PG8_SB(b, h) + boff + n * 2048 + k * 1024); } while (0)
#define PG8_MMA(ai, bj, At, Bt) do { __builtin_amdgcn_s_setprio(1); _Pragma("unroll") for (int m = 0; m < 4; ++m) _Pragma("unroll") for (int n = 0; n < 2; ++n) _Pragma("unroll") for (int k = 0; k < 2; ++k) \
        acc[ai][bj][m][n] = __builtin_amdgcn_mfma_f32_16x16x32_bf16(Bt[n][k], At[m][k], acc[ai][bj][m][n], 0, 0, 0); __builtin_amdgcn_s_setprio(0); } while (0)
#define PG8_WAIT_V(n) asm volatile("s_waitcnt vmcnt(" #n ")" ::: "memory")
#define PG8_WAIT_L(n) asm volatile("s_waitcnt lgkmcnt(" #n ")" ::: "memory")
#define PG8_BAR __builtin_amdgcn_s_barrier()
#define PG8_SCHED __builtin_amdgcn_sched_barrier(0)
    Unit cur, nxt; int ui = 0;
    if (!S.next(0, cur)) return;
    f32x4 acc[2][2][4][2];
#pragma unroll
    for (int a = 0; a < 2; ++a)
#pragma unroll
        for (int b = 0; b < 2; ++b)
#pragma unroll
            for (int m = 0; m < 4; ++m)
#pragma unroll
                for (int n = 0; n < 2; ++n) acc[a][b][m][n] = (f32x4){0.f, 0.f, 0.f, 0.f};
    bf16x8 At[4][2], B0[2][2], B1[2][2];
    const char* cA = (const char*)g.A + (size_t)cur.pm * tstep; const char* cB = (const char*)g.Bt + (size_t)cur.pn * tstep;
    S.a_ready(cur);
    if constexpr (SP2) {
        PG8_STAGE(PG8_SB(0, 0), cB, voffB); PG8_STAGE(PG8_SB(0, 1), cB + hstep, voffB); PG8_STAGE(PG8_SA(0, 0), cA, voffA); PG8_STAGE(PG8_SA(0, 1), cA + hstep, voffA);
        if (wr == 1) PG8_BAR;
        PG8_WAIT_V(2); PG8_BAR;
        PG8_STAGE(PG8_SB(1, 0), cB + kstep, voffB); PG8_STAGE(PG8_SA(1, 0), cA + kstep, voffA); PG8_STAGE(PG8_SB(1, 1), cB + hstep + kstep, voffB);
        PG8_WAIT_V(6); PG8_BAR;
    } else {
        PG8_STAGE(PG8_SB(0, 0), cB, voffB); PG8_STAGE(PG8_SA(0, 0), cA, voffA); PG8_STAGE(PG8_SB(0, 1), cB + hstep, voffB); PG8_STAGE(PG8_SA(0, 1), cA + hstep, voffA);
        if (wr == 1) PG8_BAR;
        PG8_WAIT_V(4); PG8_BAR;
        PG8_STAGE(PG8_SB(1, 0), cB + kstep, voffB); PG8_STAGE(PG8_SA(1, 0), cA + kstep, voffA); PG8_STAGE(PG8_SB(1, 1), cB + hstep + kstep, voffB);
        PG8_WAIT_V(6); PG8_BAR;
    }
    for (;;) {
        const bool has_next = S.next(ui + 1, nxt);
        const char* nA = has_next ? (const char*)g.A + (size_t)nxt.pm * tstep : cA; const char* nB = has_next ? (const char*)g.Bt + (size_t)nxt.pn * tstep : cB;
        for (int t = 0; t < nt; t += 2) {
            const bool last = (t == nt - 2);
            const char* a1 = cA + (size_t)(t + 1) * kstep;
            const char* a2 = last ? nA : cA + (size_t)(t + 2) * kstep; const char* b2 = last ? nB : cB + (size_t)(t + 2) * kstep;
            const char* a3 = a2 + kstep; const char* b3 = b2 + kstep;
            if (last && has_next) S.a_ready(nxt);
            if constexpr (SP2) {
            PG8_LDB(B0, 0, 0); PG8_LDB(B1, 0, 1); PG8_SCHED; PG8_LDA(At, 0, 0); PG8_STAGE(PG8_SA(1, 1), a1 + hstep, voffA);
            PG8_WAIT_V(8); PG8_WAIT_L(0); PG8_BAR; PG8_MMA(0, 0, At, B0); PG8_MMA(0, 1, At, B1); PG8_BAR; PG8_SCHED;
            PG8_LDA(At, 0, 1); PG8_STAGE(PG8_SB(0, 0), b2, voffB); PG8_STAGE(PG8_SB(0, 1), b2 + hstep, voffB); PG8_STAGE(PG8_SA(0, 0), a2, voffA);
            PG8_WAIT_V(8); PG8_WAIT_L(0); PG8_BAR; PG8_MMA(1, 0, At, B0); PG8_MMA(1, 1, At, B1); PG8_BAR; PG8_SCHED;
            PG8_LDB(B0, 1, 0); PG8_LDB(B1, 1, 1); PG8_SCHED; PG8_LDA(At, 1, 0); PG8_STAGE(PG8_SA(0, 1), a2 + hstep, voffA);
            PG8_WAIT_V(8); PG8_WAIT_L(0); PG8_BAR; PG8_MMA(0, 0, At, B0); PG8_MMA(0, 1, At, B1); PG8_BAR; PG8_SCHED;
            PG8_LDA(At, 1, 1); PG8_STAGE(PG8_SB(1, 0), b3, voffB); PG8_STAGE(PG8_SB(1, 1), b3 + hstep, voffB); PG8_STAGE(PG8_SA(1, 0), a3, voffA);
            PG8_WAIT_V(8); PG8_WAIT_L(0); PG8_BAR; PG8_MMA(1, 0, At, B0); PG8_MMA(1, 1, At, B1); PG8_BAR; PG8_SCHED;
            } else {
            PG8_LDB(B0, 0, 0); PG8_SCHED; PG8_LDA(At, 0, 0); PG8_STAGE(PG8_SA(1, 1), a1 + hstep, voffA);
            PG8_WAIT_L(8); PG8_BAR; PG8_WAIT_L(0); PG8_MMA(0, 0, At, B0); PG8_BAR; PG8_SCHED;
            PG8_LDB(B1, 0, 1); PG8_STAGE(PG8_SB(0, 0), b2, voffB);
            PG8_BAR; PG8_WAIT_L(0); PG8_MMA(0, 1, At, B1); PG8_BAR;
            PG8_LDA(At, 0, 1); PG8_STAGE(PG8_SA(0, 0), a2, voffA);
            PG8_BAR; PG8_WAIT_L(0); PG8_MMA(1, 0, At, B0); PG8_BAR; PG8_SCHED;
            PG8_STAGE(PG8_SB(0, 1), b2 + hstep, voffB);
            PG8_WAIT_V(6); PG8_BAR; PG8_MMA(1, 1, At, B1); PG8_BAR;
            PG8_LDB(B0, 1, 0); PG8_SCHED; PG8_LDA(At, 1, 0); PG8_STAGE(PG8_SA(0, 1), a2 + hstep, voffA);
            PG8_WAIT_L(8); PG8_BAR; PG8_WAIT_L(0); PG8_MMA(0, 0, At, B0); PG8_BAR; PG8_SCHED;
            PG8_LDB(B1, 1, 1); PG8_STAGE(PG8_SB(1, 0), b3, voffB);
            PG8_BAR; PG8_WAIT_L(0); PG8_MMA(0, 1, At, B1); PG8_BAR;
            PG8_LDA(At, 1, 1); PG8_STAGE(PG8_SA(1, 0), a3, voffA);
            PG8_BAR; PG8_WAIT_L(0); PG8_MMA(1, 0, At, B0); PG8_BAR; PG8_SCHED;
            PG8_STAGE(PG8_SB(1, 1), b3 + hstep, voffB);
            PG8_WAIT_V(6); PG8_BAR; PG8_MMA(1, 1, At, B1); PG8_BAR;
            }
        }
        if constexpr (ALIGN_EPI) { if (wr == 0) PG8_BAR; }
        if constexpr (!Epi::AFTER_DRAIN) { E(acc, cur, wr, wc, fr, fq); S.done(cur); }
        if (!has_next) break;
#pragma unroll
        for (int a = 0; a < 2; ++a)
#pragma unroll
            for (int b = 0; b < 2; ++b)
#pragma unroll
                for (int m = 0; m < 4; ++m)
#pragma unroll
                    for (int n = 0; n < 2; ++n) acc[a][b][m][n] = (f32x4){0.f, 0.f, 0.f, 0.f};
        cur = nxt; cA = nA; cB = nB; ++ui;
        if constexpr (ALIGN_EPI) { if (wr == 1) PG8_BAR; }
    }
    PG8_WAIT_V(0);
    if constexpr (!ALIGN_EPI) { if (wr == 0) PG8_BAR; }
    PG8_BAR;
    if constexpr (Epi::AFTER_DRAIN) { E.fused(acc, cur, wr, wc, fr, fq, lds, wid, lane); S.done(cur); }
#undef PG8_SA
#undef PG8_SB
#undef PG8_STAGE
#undef PG8_LDA
#undef PG8_LDB
#undef PG8_MMA
#undef PG8_WAIT_V
#undef PG8_WAIT_L
#undef PG8_BAR
#undef PG8_SCHED
}
}

namespace attn_body {
using bf16=__hip_bfloat16;
using bf16x8=__attribute__((ext_vector_type(8)))short;
using s16x4=__attribute__((ext_vector_type(4)))short;
using f32x16=__attribute__((ext_vector_type(16)))float;
using u32x4=__attribute__((ext_vector_type(4)))unsigned;
constexpr int D=64,ZP=4096,OP=2048;
constexpr int NW=8,QBLK=32,QB=QBLK*NW,KVBLK=64;
constexpr int ATTN_UNIT_ROWS=QB;
__device__ __forceinline__ int crow(int r,int hi){return (r&3)+8*(r>>2)+4*hi;}
#define SBAR() __builtin_amdgcn_sched_barrier(0)
template<int MODE> __device__ __forceinline__ int trow(int t,int q0,int S){
  if constexpr(MODE==0){ return 64*t; }
  else { const int j=(t+3)&7; const int kpos=q0-128+64*j; return (kpos>=0&&kpos<S)?kpos:(q0+64); }
}
template<int MODE> __device__ __forceinline__ void tmask(f32x16&p0,f32x16&p1,int t,int qrel,int hi,int q0,int S){
  if constexpr(MODE==1){
    const float NEG=-INFINITY; const int j=(t+3)&7; const int krel0=-128+64*j; const int kpos=q0+krel0;
    const int base=(kpos>=0&&kpos<S)?(krel0+4*hi-qrel+128):100000;
    #pragma unroll
    for(int r=0;r<16;++r){const int kv=base+(r&3)+8*(r>>2); if((unsigned)kv>256u)p0[r]=NEG; if((unsigned)(kv+32)>256u)p1[r]=NEG;}
  }
}

constexpr int NSLOT=3, SLOTB=8192;
constexpr int LDS_K=0, LDS_V=NSLOT*SLOTB, LDS_WS=2*NSLOT*SLOTB, LDS_OST=LDS_WS+NW*64*4, LDS_BYTES=LDS_OST+NW*4096;
constexpr float C2=0.125f*1.4426950408889634f;
__device__ __forceinline__ void glds16(const void*gsrc,unsigned lds_dst){unsigned keep;
  asm volatile("s_mov_b32 %0, m0\n\ts_mov_b32 m0, %2\n\ts_nop 0\n\tglobal_load_lds_dwordx4 %1, off\n\ts_mov_b32 m0, %0":"=&s"(keep):"v"(gsrc),"s"(lds_dst):"memory");}
__device__ __forceinline__ float max3f(float a,float b,float c){float r;asm("v_max3_f32 %0, %1, %2, %3":"=v"(r):"v"(a),"v"(b),"v"(c));return r;}
__device__ __forceinline__ float max2f(float a,float b){float r;asm("v_max_f32_e32 %0, %1, %2":"=v"(r):"v"(a),"v"(b));return r;}
__device__ __forceinline__ float fadd_s(float a,float b){float r;asm("v_add_f32_e32 %0, %1, %2":"=v"(r):"v"(a),"v"(b));return r;}
__device__ __forceinline__ float fsub_s(float a,float b){float r;asm("v_sub_f32_e32 %0, %1, %2":"=v"(r):"v"(a),"v"(b));return r;}
typedef float f32x2_t __attribute__((ext_vector_type(2))); typedef __bf16 bf16x2_t __attribute__((ext_vector_type(2)));
__device__ __forceinline__ unsigned cvtpk_s(float lo,float hi){f32x2_t v={lo,hi};bf16x2_t b=__builtin_convertvector(v,bf16x2_t);return __builtin_bit_cast(unsigned,b);}
#define WAIT_BAR(N) asm volatile("s_waitcnt vmcnt(" #N ") lgkmcnt(0)\n\ts_barrier":::"memory")

__device__ __forceinline__ void qkt(f32x16&p0,f32x16&p1,const char*Kslot,const bf16x8*qr,const f32x16&negm,int r32,int hi){
  const char*kb=Kslot+hi*1024+r32*16;
  #pragma unroll
  for(int d0=0;d0<4;++d0){
    const bf16x8 b0=*reinterpret_cast<const bf16x8*>(kb+d0*2048);
    const bf16x8 b1=*reinterpret_cast<const bf16x8*>(kb+d0*2048+512);
    if(d0==0){p0=__builtin_amdgcn_mfma_f32_32x32x16_bf16(b0,qr[0],negm,0,0,0);p1=__builtin_amdgcn_mfma_f32_32x32x16_bf16(b1,qr[0],negm,0,0,0);}
    else{p0=__builtin_amdgcn_mfma_f32_32x32x16_bf16(b0,qr[d0],p0,0,0,0);p1=__builtin_amdgcn_mfma_f32_32x32x16_bf16(b1,qr[d0],p1,0,0,0);}}
}
typedef __attribute__((address_space(3))) const char* lds_cptr;
typedef short v4i16_t __attribute__((ext_vector_type(4)));
__device__ __forceinline__ void kload8(bf16x8*kf,lds_cptr kp){
  kf[0]=*(const __attribute__((address_space(3))) bf16x8*)(kp);      kf[1]=*(const __attribute__((address_space(3))) bf16x8*)(kp+512);
  kf[2]=*(const __attribute__((address_space(3))) bf16x8*)(kp+2048); kf[3]=*(const __attribute__((address_space(3))) bf16x8*)(kp+2560);
  kf[4]=*(const __attribute__((address_space(3))) bf16x8*)(kp+4096); kf[5]=*(const __attribute__((address_space(3))) bf16x8*)(kp+4608);
  kf[6]=*(const __attribute__((address_space(3))) bf16x8*)(kp+6144); kf[7]=*(const __attribute__((address_space(3))) bf16x8*)(kp+6656);
}
__device__ __forceinline__ void kload2(bf16x8*kf,lds_cptr kp,int j){ kf[2*j]=*(const __attribute__((address_space(3))) bf16x8*)(kp+j*2048); kf[2*j+1]=*(const __attribute__((address_space(3))) bf16x8*)(kp+j*2048+512); }
__device__ __forceinline__ s16x4 vtr(lds_cptr p){ return __builtin_bit_cast(s16x4,__builtin_amdgcn_ds_read_tr16_b64_v4i16((__attribute__((address_space(3))) v4i16_t*)p)); }
__device__ __forceinline__ float rowmax(const f32x16&p0,const f32x16&p1){
  float a=max3f(p0[0],p0[1],p1[0]),b=max3f(p0[2],p0[3],p1[1]);a=max3f(a,p1[2],p1[3]);
  #pragma unroll
  for(int r=4;r<16;r+=4){a=max3f(a,p0[r],p0[r+1]);b=max3f(b,p0[r+2],p0[r+3]);a=max3f(a,p1[r],p1[r+1]);b=max3f(b,p1[r+2],p1[r+3]);}
  const float m=max2f(a,b);
  auto rr=__builtin_amdgcn_permlane32_swap(__float_as_uint(m),__float_as_uint(m),false,false);
  return max2f(__uint_as_float(rr[0]),__uint_as_float(rr[1]));
}
__device__ __forceinline__ void pv(f32x16*o,int vb,bf16x8 pa0,bf16x8 pa1,bf16x8 pa2,bf16x8 pa3){
  #pragma unroll
  for(int d0=0;d0<2;++d0){s16x4 lo[4],hi[4];
    #pragma unroll
    for(int ks=0;ks<4;++ks){
      asm volatile("ds_read_b64_tr_b16 %0,%1 offset:%c2":"=&v"(lo[ks]):"v"(vb),"i"(d0*4096+ks*1024):"memory");
      asm volatile("ds_read_b64_tr_b16 %0,%1 offset:%c2":"=&v"(hi[ks]):"v"(vb),"i"(d0*4096+ks*1024+512):"memory");}
    asm volatile("s_waitcnt lgkmcnt(0)":::"memory");SBAR();
    #define PK(k) (bf16x8){lo[k][0],lo[k][1],lo[k][2],lo[k][3],hi[k][0],hi[k][1],hi[k][2],hi[k][3]}
    o[d0]=__builtin_amdgcn_mfma_f32_32x32x16_bf16(pa0,PK(0),o[d0],0,0,0);
    o[d0]=__builtin_amdgcn_mfma_f32_32x32x16_bf16(pa1,PK(1),o[d0],0,0,0);
    o[d0]=__builtin_amdgcn_mfma_f32_32x32x16_bf16(pa2,PK(2),o[d0],0,0,0);
    o[d0]=__builtin_amdgcn_mfma_f32_32x32x16_bf16(pa3,PK(3),o[d0],0,0,0);
    #undef PK
  }
}

#ifndef ATTN_STORE16
#define ATTN_STORE16(p,v) (*(u32x4*)(p)=(v))
#endif
template<int MODE,int THRL> __device__ __forceinline__ void attn_unit(const bf16*Qu,const bf16*__restrict__ Ku,const bf16*__restrict__ Vu,bf16*Ou,const int NT,const int q0,const int S,const float sink2,char*shm){
  int tid_=threadIdx.x; asm volatile("":"+v"(tid_)); const int tid=tid_,lane=tid&63,r32=lane&31,hi=lane>>5; const int wid=__builtin_amdgcn_readfirstlane(tid>>6);
  const bf16*Qw=Qu+(long)(wid*QBLK)*ZP;
  const unsigned lds0=(unsigned)(uintptr_t)shm;
  float*wsf=(float*)(shm+LDS_WS)+wid*64;
  const bf16*ksrc=Ku+(long)lane*ZP+wid*8;
  const bf16*vsrc=Vu+(long)(16*(wid&3)+(lane>>2))*ZP+(wid>>2)*32+(lane&3)*8;
  const unsigned kdst=lds0+LDS_K+wid*1024, vdst=lds0+LDS_V+wid*1024;
  #define DMA_K(t,slot) glds16(ksrc+(long)trow<MODE>((t),q0,S)*ZP,(unsigned)__builtin_amdgcn_readfirstlane(kdst+(slot)))
  #define DMA_V(t,slot) glds16(vsrc+(long)trow<MODE>((t),q0,S)*ZP,(unsigned)__builtin_amdgcn_readfirstlane(vdst+(slot)))
  const int vb0=(int)(lds0+LDS_V)+((lane>>4)&1)*32+(lane&3)*8+(4*hi+((lane&15)>>2))*64;
  const char*Kbase=shm+LDS_K; bf16x8 kf[8];
  const lds_cptr shm3=(lds_cptr)shm; const lds_cptr kp0=shm3+LDS_K+hi*1024+r32*16; const lds_cptr vp0=shm3+LDS_V+((lane>>4)&1)*32+(lane&3)*8+(4*hi+((lane&15)>>2))*64;
  DMA_K(0,0);DMA_V(0,0);DMA_K(1,SLOTB);
  bf16x8 qr[4];
  #pragma unroll
  for(int d0=0;d0<4;++d0)qr[d0]=*reinterpret_cast<const bf16x8*>(&Qw[(long)r32*ZP+d0*16+hi*8]);
  float mhat=0.f,l_reg=0.f;f32x16 o[2];o[0]=f32x16{};o[1]=f32x16{};f32x16 negm=f32x16{};asm volatile("":"+v"(negm));
  const int qrel=wid*QBLK+r32;
  #define CMASK(P0,P1,t) tmask<MODE>(P0,P1,(t),qrel,hi,q0,S)
  bool resc=false;
  #define START(P0,P1) do{ const float rm=rowmax(P0,P1); resc=false; \
    { const float dl=rm; mhat=fadd_s(mhat,dl); \
      _Pragma("unroll") for(int r=0;r<16;++r){P0[r]=fsub_s(P0[r],dl);P1[r]=fsub_s(P1[r],dl);} \
      _Pragma("unroll") for(int r=0;r<16;++r)negm[r]=-mhat; asm volatile("":"+v"(negm)); } \
    _Pragma("unroll") for(int r=0;r<16;++r)P0[r]=__builtin_amdgcn_exp2f(P0[r]); }while(0)
  #define RESC() do{ if(resc){ asm volatile("s_waitcnt lgkmcnt(0)":::"memory"); \
      _Pragma("unroll") for(int d_=0;d_<2;++d_) _Pragma("unroll") for(int r=0;r<16;++r)o[d_][r]*=wsf[crow(r,hi)]; } }while(0)
  f32x16 pA0,pA1,pB0,pB1;
  int sl_prev=0,sl_cur=0,sl_next=SLOTB;
  #define ROT() do{sl_prev=sl_cur;sl_cur=sl_next;sl_next=(sl_next==(NSLOT-1)*SLOTB)?0:sl_next+SLOTB;}while(0)
  DMA_K(2,2*SLOTB);
  WAIT_BAR(3);
  qkt(pA0,pA1,Kbase,qr,negm,r32,hi);asm volatile("s_nop 15\n\ts_nop 7":"+v"(pA0),"+v"(pA1));CMASK(pA0,pA1,0);
  START(pA0,pA1);
  _Pragma("unroll") for(int r=0;r<16;++r)pA1[r]=__builtin_amdgcn_exp2f(pA1[r]);
  WAIT_BAR(0);
  DMA_K(3,0);DMA_V(1,SLOTB);
  ROT();
  kload8(kf,kp0+sl_cur);
  WAIT_BAR(2);
  s16x4 vlo[8],vhi[8]; u32x4 pw0,pw1,pw2,pw3;
  #define PKW(P,B) cvtpk_s(P[B],P[B+1])
  #define PAF(k) __builtin_bit_cast(bf16x8,pw##k)
  #define VFR(i) (bf16x8){vlo[i][0],vlo[i][1],vlo[i][2],vlo[i][3],vhi[i][0],vhi[i][1],vhi[i][2],vhi[i][3]}
  #define PIN(x) asm volatile("":"+v"(x))
  #define MX3(a,b,c) __builtin_fmaxf(__builtin_fmaxf((a),(b)),(c))
  #define GAPA(MF,A0,A1,A2,A3,W0,W1,PW) do{ MF; sacc+=A0; sacc+=A1; sacc+=A2; sacc+=A3; PIN(sacc); W0; W1; PIN(PW); SBAR(); }while(0)
  #define EX(v) __builtin_amdgcn_exp2f(v)
  #define GAPB(MF,X,B) do{ MF; X[B]=EX(X[B]); X[B+1]=EX(X[B+1]); X[B+2]=EX(X[B+2]); X[B+3]=EX(X[B+3]); PIN(X); SBAR(); }while(0)
  #define VRD(i) do{ vlo[i]=vtr(vp_+(((i)>>2)*4096+((i)&3)*1024)); vhi[i]=vtr(vp_+(((i)>>2)*4096+((i)&3)*1024+512)); }while(0)
  #define KRD(G,j) do{ if(G){ kload2(kf,kp0+sl_next,j); SBAR(); } }while(0)
  #define STEP(C0,C1,P0,P1,t,GK,GV,GL) do{ SBAR(); \
    const lds_cptr vp_=vp0+sl_prev; \
    VRD(0); SBAR(); float sacc=(P0[0]+P0[1]); \
    GAPA(C0=__builtin_amdgcn_mfma_f32_32x32x16_bf16(kf[0],qr[0],negm,0,0,0), P0[2],P0[3],P0[4],P0[5],     pw0[0]=PKW(P0,0), pw0[1]=PKW(P0,2), pw0); \
    VRD(4); SBAR(); GAPA(C1=__builtin_amdgcn_mfma_f32_32x32x16_bf16(kf[1],qr[0],negm,0,0,0), P0[6],P0[7],P0[8],P0[9],     pw0[2]=PKW(P0,4), pw0[3]=PKW(P0,6), pw0); \
    VRD(1); SBAR(); GAPA(C0=__builtin_amdgcn_mfma_f32_32x32x16_bf16(kf[2],qr[1],C0,0,0,0),   P0[10],P0[11],P0[12],P0[13], pw1[0]=PKW(P0,8), pw1[1]=PKW(P0,10), pw1); \
    VRD(5); SBAR(); GAPA(C1=__builtin_amdgcn_mfma_f32_32x32x16_bf16(kf[3],qr[1],C1,0,0,0),   P0[14],P0[15],P1[0],P1[1],   pw1[2]=PKW(P0,12),pw1[3]=PKW(P0,14), pw1); \
    VRD(2); SBAR(); GAPA(C0=__builtin_amdgcn_mfma_f32_32x32x16_bf16(kf[4],qr[2],C0,0,0,0),   P1[2],P1[3],P1[4],P1[5],     pw2[0]=PKW(P1,0), pw2[1]=PKW(P1,2), pw2); \
    VRD(6); SBAR(); GAPA(C1=__builtin_amdgcn_mfma_f32_32x32x16_bf16(kf[5],qr[2],C1,0,0,0),   P1[6],P1[7],P1[8],P1[9],     pw2[2]=PKW(P1,4), pw2[3]=PKW(P1,6), pw2); \
    VRD(3); SBAR(); GAPA(C0=__builtin_amdgcn_mfma_f32_32x32x16_bf16(kf[6],qr[3],C0,0,0,0),   P1[10],P1[11],P1[12],P1[13], pw3[0]=PKW(P1,8), pw3[1]=PKW(P1,10), pw3); \
    VRD(7); SBAR(); GAPA(C1=__builtin_amdgcn_mfma_f32_32x32x16_bf16(kf[7],qr[3],C1,0,0,0),   P1[14],P1[15],0.f,0.f,       pw3[2]=PKW(P1,12),pw3[3]=PKW(P1,14), pw3); \
    l_reg+=sacc; \
    if(GK){DMA_K((t)+3,sl_cur);} if(GV){DMA_V((t)+1,sl_next);} \
    CMASK(C0,C1,t); \
    { float a=MX3(C0[0],C0[1],C1[0]),b=MX3(C0[2],C0[3],C1[1]); a=MX3(a,C1[2],C1[3]); \
      _Pragma("unroll") for(int r=4;r<16;r+=4){a=MX3(a,C0[r],C0[r+1]);b=MX3(b,C0[r+2],C0[r+3]);a=MX3(a,C1[r],C1[r+1]);b=MX3(b,C1[r+2],C1[r+3]);} \
      float rm=__builtin_fmaxf(a,b); { auto rr=__builtin_amdgcn_permlane32_swap(__float_as_uint(rm),__float_as_uint(rm),false,false); rm=__builtin_fmaxf(__uint_as_float(rr[0]),__uint_as_float(rr[1])); } \
      resc=false; \
      if(__builtin_expect(__any(rm>(float)THRL),0)){ const float dl=__builtin_fmaxf(rm,0.f); mhat+=dl; \
        _Pragma("unroll") for(int r=0;r<16;++r){C0[r]-=dl;C1[r]-=dl;} \
        _Pragma("unroll") for(int r=0;r<16;++r)negm[r]=-mhat; asm volatile("":"+v"(negm)); \
        const float f=__builtin_amdgcn_exp2f(-dl); l_reg*=f; if(hi==0)wsf[r32]=f; resc=true; } } \
    SBAR(); \
    GAPB(o[0]=__builtin_amdgcn_mfma_f32_32x32x16_bf16(PAF(0),VFR(0),o[0],0,0,0), C0,0); \
    GAPB(o[1]=__builtin_amdgcn_mfma_f32_32x32x16_bf16(PAF(0),VFR(4),o[1],0,0,0), C0,4); \
    KRD(GL,0); GAPB(o[0]=__builtin_amdgcn_mfma_f32_32x32x16_bf16(PAF(1),VFR(1),o[0],0,0,0), C0,8); \
    KRD(GL,1); GAPB(o[1]=__builtin_amdgcn_mfma_f32_32x32x16_bf16(PAF(1),VFR(5),o[1],0,0,0), C0,12); \
    KRD(GL,2); GAPB(o[0]=__builtin_amdgcn_mfma_f32_32x32x16_bf16(PAF(2),VFR(2),o[0],0,0,0), C1,0); \
    KRD(GL,3); GAPB(o[1]=__builtin_amdgcn_mfma_f32_32x32x16_bf16(PAF(2),VFR(6),o[1],0,0,0), C1,4); \
    GAPB(o[0]=__builtin_amdgcn_mfma_f32_32x32x16_bf16(PAF(3),VFR(3),o[0],0,0,0), C1,8); \
    GAPB(o[1]=__builtin_amdgcn_mfma_f32_32x32x16_bf16(PAF(3),VFR(7),o[1],0,0,0), C1,12); \
    }while(0)
  int t=1;
  for(;t+5<NT;t+=2){
    STEP(pB0,pB1,pA0,pA1,t,true,true,true);     WAIT_BAR(2); RESC(); ROT();
    STEP(pA0,pA1,pB0,pB1,t+1,true,true,true);   WAIT_BAR(2); RESC(); ROT();
  }
  #define ENDW(tt) do{ if((tt)+3<NT){WAIT_BAR(2);} else if((tt)+2<NT){WAIT_BAR(1);} else {WAIT_BAR(0);} }while(0)
  for(;t+1<NT;t+=2){
    STEP(pB0,pB1,pA0,pA1,t,(t+3<NT),(t+1<NT),(t+1<NT));       ENDW(t);   RESC(); ROT();
    STEP(pA0,pA1,pB0,pB1,t+1,(t+4<NT),(t+2<NT),(t+2<NT));     ENDW(t+1); RESC(); ROT();
  }
  STEP(pB0,pB1,pA0,pA1,NT-1,false,false,false); RESC();
  { float sacc=pB0[0]+pB0[1]; _Pragma("unroll") for(int r=2;r<16;++r)sacc+=pB0[r]; _Pragma("unroll") for(int r=0;r<16;++r)sacc+=pB1[r]; l_reg+=sacc;
    pw0=(u32x4){PKW(pB0,0),PKW(pB0,2),PKW(pB0,4),PKW(pB0,6)};pw1=(u32x4){PKW(pB0,8),PKW(pB0,10),PKW(pB0,12),PKW(pB0,14)};pw2=(u32x4){PKW(pB1,0),PKW(pB1,2),PKW(pB1,4),PKW(pB1,6)};pw3=(u32x4){PKW(pB1,8),PKW(pB1,10),PKW(pB1,12),PKW(pB1,14)};
    SBAR(); pv(o,vb0+sl_cur,PAF(0),PAF(1),PAF(2),PAF(3)); }
  #undef PKW
  #undef PAF
  #undef VFR
  #undef PIN
  #undef MX3
  #undef GAPA
  #undef GAPB
  #undef EX
  #undef VRD
  #undef KRD
  #undef STEP
  #undef ENDW
  {auto rr=__builtin_amdgcn_permlane32_swap(__float_as_uint(l_reg),__float_as_uint(l_reg),false,false);l_reg=__uint_as_float(rr[0])+__uint_as_float(rr[1]);}
  if constexpr(MODE==1) l_reg+=__builtin_amdgcn_exp2f(sink2-mhat);
  if(hi==0)wsf[32+r32]=l_reg;asm volatile("s_waitcnt lgkmcnt(0)":::"memory");
  float rli[16];
  #pragma unroll
  for(int r=0;r<16;++r)rli[r]=__builtin_amdgcn_rcpf(wsf[32+crow(r,hi)]);
  bf16*Ow=Ou+(long)(wid*QBLK)*OP;
  { bf16*stg=(bf16*)(shm+LDS_OST)+wid*2048;
    #pragma unroll
    for(int r=0;r<16;++r){const int orow=crow(r,hi);
      #pragma unroll
      for(int d0=0;d0<2;++d0)stg[orow*64+d0*32+r32]=__float2bfloat16(o[d0][r]*rli[r]);}
    asm volatile("s_waitcnt lgkmcnt(0)":::"memory");
    #pragma unroll
    for(int i=0;i<4;++i){const int row=i*8+(lane>>3),ch=lane&7; const u32x4 v=*(const u32x4*)(stg+row*64+ch*8); ATTN_STORE16(Ow+(long)row*OP+ch*8,v);} }
  asm volatile("s_waitcnt lgkmcnt(0)\n\ts_barrier":::"memory");
  #undef DMA_K
  #undef DMA_V
  #undef CMASK
  #undef START
  #undef RESC
  #undef ROT
}
constexpr int ATTN_LDS_BYTES=LDS_BYTES;
#undef SBAR
#undef WAIT_BAR
}
#define GAS __attribute__((address_space(1)))
#define LAS __attribute__((address_space(3)))
typedef unsigned short bf16;
typedef unsigned v4u __attribute__((ext_vector_type(4)));
typedef float f32x4 __attribute__((ext_vector_type(4)));
typedef short bf16x8 __attribute__((ext_vector_type(8)));
typedef GAS unsigned gu32;
typedef GAS unsigned long long gu64;
#define RLX_AGENT __ATOMIC_RELAXED, __HIP_MEMORY_SCOPE_AGENT
#define LDS_WAIT() asm volatile("s_waitcnt lgkmcnt(0)" ::: "memory")
#define VM_WAIT() asm volatile("s_waitcnt vmcnt(0)" ::: "memory")
__device__ __forceinline__ unsigned long long rt() { return __builtin_amdgcn_s_memrealtime(); }
__device__ __forceinline__ unsigned f2bf(float f) { unsigned u = __builtin_bit_cast(unsigned, f); return (u + 0x7fffu + ((u >> 16) & 1u)) >> 16; }
__device__ __forceinline__ unsigned pk2(float lo, float hi) { return f2bf(lo) | (f2bf(hi) << 16); }

#define XB_TMO      128
#define XB_XCNT(j)  (256  + 64 * (j))
#define XB_XSUB(j)  (1280 + 64 * (j))
#define XB_XGEN(j)  (2304 + 64 * (j))
#define XB_TOP      3328
#define XB_TOPGEN   3392
#define XCD_BAR_WORDS 3456
#define XB_SPIN_CAP (1u << 18)

__device__ __forceinline__ unsigned xb_ld(unsigned* p)              { return __hip_atomic_load(p, __ATOMIC_RELAXED, __HIP_MEMORY_SCOPE_AGENT); }
__device__ __forceinline__ unsigned xb_add(unsigned* p, unsigned v) { return __hip_atomic_fetch_add(p, v, __ATOMIC_RELAXED, __HIP_MEMORY_SCOPE_AGENT); }
__device__ __forceinline__ unsigned xb_xcc_id() { return (unsigned)__builtin_amdgcn_s_getreg((3 << 11) | 20) & 0xFu; }
#define XB_SPIN(cond, bar) do { unsigned _sp = 0; while (cond) { __builtin_amdgcn_s_sleep(1); \
    if ((++_sp & 255u) == 0u) { if (xb_ld(&(bar)[XB_TMO])) break; if (_sp > XB_SPIN_CAP) { atomicAdd(&(bar)[XB_TMO], 1u); break; } } } } while (0)

struct XcdBarrier {
    unsigned* bar; unsigned x;
    volatile LAS unsigned* st;
};

__device__ __forceinline__ XcdBarrier xcd_barrier_post(unsigned* bar, volatile LAS unsigned* st) {
    XcdBarrier b; b.bar = bar; b.x = xb_xcc_id(); b.st = st;
    if (threadIdx.x == 0) (void)xb_add(&bar[XB_XCNT(b.x)], 1u);
    return b;
}
__device__ __forceinline__ void xcd_barrier_complete(unsigned* bar, unsigned x, unsigned& nloc, unsigned& nx) {
    const unsigned G = gridDim.x * gridDim.y * gridDim.z;
    unsigned sum, cnt, mine, sp = 0u;
    for (;;) {
        sum = 0u; cnt = 0u; mine = 0u;
#pragma unroll
        for (unsigned j = 0; j < 16; ++j) { const unsigned c = xb_ld(&bar[XB_XCNT(j)]); sum += c; cnt += (c > 0u) ? 1u : 0u; mine = (j == x) ? c : mine; }
        if (sum == G) break;
        __builtin_amdgcn_s_sleep(1);
        if ((++sp & 255u) == 0u) { if (xb_ld(&bar[XB_TMO])) break; if (sp > XB_SPIN_CAP) { atomicAdd(&bar[XB_TMO], 1u); break; } }
    }
    nloc = mine > 0u ? mine : 1u; nx = cnt > 0u ? cnt : 1u;
}

__device__ __forceinline__ void xcd_barrier(const XcdBarrier& b) {
    asm volatile("s_waitcnt vmcnt(0)" ::: "memory");
    __syncthreads();
    if (threadIdx.x == 0) {
        unsigned* bar = b.bar;
        __builtin_amdgcn_s_waitcnt(0);
        unsigned nloc = b.st[0], nx = b.st[1];
        if (nloc == 0u) { xcd_barrier_complete(bar, b.x, nloc, nx); b.st[0] = nloc; b.st[1] = nx; }
        const unsigned old = xb_add(&bar[XB_XSUB(b.x)], 1u);
        const unsigned gen = old / nloc;
        if (old + 1u == (gen + 1u) * nloc) {
            __builtin_amdgcn_fence(__ATOMIC_RELEASE, "agent");
            asm volatile("s_waitcnt vmcnt(0)" ::: "memory");
            const unsigned og = xb_add(&bar[XB_TOP], 1u);
            const unsigned tg = og / nx;
            if (og + 1u == (tg + 1u) * nx) xb_add(&bar[XB_TOPGEN], 1u);
            else XB_SPIN(xb_ld(&bar[XB_TOPGEN]) == tg, bar);
            __builtin_amdgcn_fence(__ATOMIC_ACQUIRE, "agent");
            xb_add(&bar[XB_XGEN(b.x)], 1u);
            asm volatile("s_waitcnt vmcnt(0)" ::: "memory");
        } else {
            XB_SPIN(xb_ld(&bar[XB_XGEN(b.x)]) == gen, bar);
            __builtin_amdgcn_fence(__ATOMIC_ACQUIRE, "agent");
            asm volatile("s_waitcnt vmcnt(0)" ::: "memory");
        }
    }
    __syncthreads();
}

constexpr int NWAVES = 8;
#ifndef MK_N_LAUNCHES
#define MK_N_LAUNCHES 1
#endif

constexpr int DM = 2048, INW = 4096, FF = 8192, DEPTH = 2;
constexpr int SP = 16384, SS = 2048;
constexpr int MP = 2 * SP, MS = 4 * SS, M = MP + MS;
constexpr int NCHUNK = 5, MC = M / NCHUNK;
constexpr int N_PHASES = 1 + DEPTH * (5 + 2 * NCHUNK + 1);
constexpr float RMS_EPS = 1e-6f, LN_EPS = 1e-5f, LOG2E = 1.4426950408889634f;
constexpr int ZA_B = 0, ZA_C = 512, ZA_V = 1024, ZB_Q = 1536, ZB_K = 2048, ZB_V = 2176, ZC_Q = 2304, ZC_K = 2816, ZC_V = 2944, ZD_A = 3072, ZD_G = 3584;
constexpr int Y_A = 0, Y_B = 512, Y_C = 1024, Y_D = 1536;
static_assert(attn_body::ZP == INW && attn_body::OP == DM, "attention body pitches");

constexpr size_t MiB = 1u << 20;
constexpr size_t WS_CTL = 0, CTL_ZERO_BYTES = 1 * MiB;
constexpr size_t WS_W = 2 * MiB, W_LAYER = 88 * MiB;
constexpr size_t WO_IN = 0, WO_OUT = 16 * MiB, WO_F1 = 24 * MiB, WO_F2 = 56 * MiB;
constexpr size_t WS_Z = WS_W + DEPTH * W_LAYER;
constexpr size_t WS_Y = WS_Z + (size_t)M * INW * 2;
constexpr size_t WS_H = WS_Y + (size_t)M * DM * 2;
constexpr size_t WS_END = WS_H + (size_t)M * DM * 2;
static_assert((size_t)MC * FF * 2 <= (size_t)M * DM * 2, "U chunk fits in the y region");
constexpr int CW_BAR = 4096;

constexpr int RING_OFF = 0, RING_BYTES = 131072;
constexpr int LDSCTL_OFF = RING_BYTES, MISC_OFF = LDSCTL_OFF + 320;
constexpr int LDS_BYTES = 147456;
static_assert(MISC_OFF + 128 <= LDS_BYTES && attn_body::ATTN_LDS_BYTES <= RING_BYTES, "LDS map");

__constant__ float INVF[32] = {
    1.000000000e+00f, 7.498942018e-01f, 5.623413324e-01f, 4.216965139e-01f, 3.162277639e-01f, 2.371373922e-01f, 1.778279394e-01f, 1.333521456e-01f,
    1.000000015e-01f, 7.498941571e-02f, 5.623412877e-02f, 4.216964915e-02f, 3.162277862e-02f, 2.371373586e-02f, 1.778279431e-02f, 1.333521493e-02f,
    9.999999776e-03f, 7.498942316e-03f, 5.623413250e-03f, 4.216964822e-03f, 3.162277862e-03f, 2.371373819e-03f, 1.778279431e-03f, 1.333521446e-03f,
    1.000000047e-03f, 7.498941850e-04f, 5.623413017e-04f, 4.216965463e-04f, 3.162277862e-04f, 2.371373848e-04f, 1.778279402e-04f, 1.333521504e-04f};

typedef unsigned u32x2 __attribute__((ext_vector_type(2)));
struct Frame {
    LAS unsigned char* lds;
    volatile LAS unsigned* MISC;
    gu32* ctl;
    int tid, lane, wave;
    int vcu, G;
    const float *xp, *xs;
    const float *pre_mix_g, *w_in, *conv_a_w, *q_norm_g, *k_norm_g, *sink_c, *conv_d_w, *conv_d_b, *ln_d_g, *ln_d_b, *w_out, *post_mix_g, *pre_ffn_g, *w_ff1, *w_ff2, *post_ffn_g;
    float* out;
    unsigned char* ws;
    bf16 *Z, *Y, *H;
};
__device__ __forceinline__ bf16* wt_ptr(Frame& F, int l, size_t off) { return (bf16*)(F.ws + WS_W + (size_t)l * W_LAYER + off); }

__device__ __forceinline__ float wave_sum(float v) {
#pragma unroll
    for (int o = 1; o < 64; o <<= 1) v += __shfl_xor(v, o);
    return v;
}
__device__ __forceinline__ unsigned cvtpk(float lo, float hi) { typedef float f2 __attribute__((ext_vector_type(2))); typedef __bf16 b2 __attribute__((ext_vector_type(2))); f2 v = {lo, hi}; b2 b = __builtin_convertvector(v, b2); return __builtin_bit_cast(unsigned, b); }
__device__ __forceinline__ float bflo(unsigned w) { return __uint_as_float(w << 16); }
__device__ __forceinline__ float bfhi(unsigned w) { return __uint_as_float(w & 0xffff0000u); }
__device__ __forceinline__ float sigmoidf_(float x) { return 1.0f / (1.0f + __expf(-x)); }
__device__ __forceinline__ void sincos_f(float ang, float& s, float& c) {
    const double rev = (double)ang * 0.15915494309189535; const float fr = (float)(rev - __builtin_rint(rev));
    s = __builtin_amdgcn_sinf(fr); c = __builtin_amdgcn_cosf(fr);
}

__device__ __forceinline__ void p0_transpose_item(const float* W, int K, int N, bf16* WT, LAS float* scr, int item, int lane) {
    const int nblk = N / 32, kb = item / nblk, nb = item % nblk, k0 = 64 * kb, n0 = 32 * nb;
#pragma unroll 8
    for (int i = 0; i < 32; ++i) { const int kk = 2 * i + (lane >> 5); scr[kk * 33 + (lane & 31)] = W[(size_t)(k0 + kk) * N + n0 + (lane & 31)]; }
    LDS_WAIT(); asm volatile("" ::: "memory");
    const int c = lane & 7;
#pragma unroll
    for (int j = 0; j < 4; ++j) { const int n = (lane >> 3) + 8 * j; const LAS float* s = scr + (8 * c) * 33 + n;
        v4u o; o.x = cvtpk(s[0 * 33], s[1 * 33]); o.y = cvtpk(s[2 * 33], s[3 * 33]); o.z = cvtpk(s[4 * 33], s[5 * 33]); o.w = cvtpk(s[6 * 33], s[7 * 33]);
        *(GAS v4u*)(WT + (size_t)(n0 + n) * K + k0 + 8 * c) = o; }
    LDS_WAIT(); asm volatile("" ::: "memory");
}
__device__ __forceinline__ const float* xin_row(Frame& F, int m) { return m < MP ? F.xp + (size_t)m * DM : F.xs + (size_t)(m - MP) * DM; }

__device__ __forceinline__ void p0_prologue(Frame& F) {
    LAS float* scr = (LAS float*)(F.lds + RING_OFF + F.wave * 16384);
    const int gw = F.vcu * NWAVES + F.wave, NGW = F.G * NWAVES;
    constexpr int I_IN = (DM / 64) * (INW / 32), I_OUT = (DM / 64) * (DM / 32), I_F1 = (DM / 64) * (FF / 32), I_F2 = (FF / 64) * (DM / 32), I_L = I_IN + I_OUT + I_F1 + I_F2;
    for (int it = gw; it < DEPTH * I_L; it += NGW) {
        const int l = it / I_L; int r = it % I_L;
        if (r < I_IN) { p0_transpose_item(F.w_in + (size_t)l * DM * INW, DM, INW, wt_ptr(F, l, WO_IN), scr, r, F.lane); continue; } r -= I_IN;
        if (r < I_OUT) { p0_transpose_item(F.w_out + (size_t)l * DM * DM, DM, DM, wt_ptr(F, l, WO_OUT), scr, r, F.lane); continue; } r -= I_OUT;
        if (r < I_F1) { p0_transpose_item(F.w_ff1 + (size_t)l * DM * FF, DM, FF, wt_ptr(F, l, WO_F1), scr, r, F.lane); continue; } r -= I_F1;
        p0_transpose_item(F.w_ff2 + (size_t)l * FF * DM, FF, DM, wt_ptr(F, l, WO_F2), scr, r, F.lane);
    }
    f32x4 g[4][2];
#pragma unroll
    for (int j = 0; j < 4; ++j) { g[j][0] = *(const GAS f32x4*)(F.pre_mix_g + j * 512 + F.lane * 8); g[j][1] = *(const GAS f32x4*)(F.pre_mix_g + j * 512 + F.lane * 8 + 4); }
    for (int m = gw; m < M; m += NGW) {
        const float* xr = xin_row(F, m);
        f32x4 x[4][2]; float ss = 0.f;
#pragma unroll
        for (int j = 0; j < 4; ++j) { x[j][0] = *(const GAS f32x4*)(xr + j * 512 + F.lane * 8); x[j][1] = *(const GAS f32x4*)(xr + j * 512 + F.lane * 8 + 4); }
#pragma unroll
        for (int j = 0; j < 4; ++j)
#pragma unroll
            for (int q = 0; q < 2; ++q) { const f32x4 v = x[j][q]; ss += (v.x * v.x + v.y * v.y) + (v.z * v.z + v.w * v.w); }
        const float r = rsqrtf(wave_sum(ss) * (1.0f / DM) + RMS_EPS);
#pragma unroll
        for (int j = 0; j < 4; ++j) { const f32x4 a = x[j][0] * r * g[j][0], b = x[j][1] * r * g[j][1];
            v4u o; o.x = cvtpk(a.x, a.y); o.y = cvtpk(a.z, a.w); o.z = cvtpk(b.x, b.y); o.w = cvtpk(b.z, b.w);
            *(GAS v4u*)(F.H + (size_t)m * DM + j * 512 + F.lane * 8) = o; }
    }
}

template <bool WRITE_H>
__device__ __forceinline__ void norm_pass(Frame& F, const bf16* YPb, const float* gpost, const float* gpre, const bool first_x) {
    const int gw = F.vcu * NWAVES + F.wave, NGW = F.G * NWAVES;
    f32x4 ga[4][2], gb[4][2];
#pragma unroll
    for (int j = 0; j < 4; ++j) { ga[j][0] = *(const GAS f32x4*)(gpost + j * 512 + F.lane * 8); ga[j][1] = *(const GAS f32x4*)(gpost + j * 512 + F.lane * 8 + 4);
        if (WRITE_H) { gb[j][0] = *(const GAS f32x4*)(gpre + j * 512 + F.lane * 8); gb[j][1] = *(const GAS f32x4*)(gpre + j * 512 + F.lane * 8 + 4); } }
    for (int m = gw; m < M; m += NGW) {
        const float* xr = first_x ? xin_row(F, m) : (const float*)(F.out + (size_t)m * DM);
        v4u y[4]; f32x4 x[4][2];
#pragma unroll
        for (int j = 0; j < 4; ++j) y[j] = *(const GAS v4u*)(YPb + (size_t)m * DM + j * 512 + F.lane * 8);
#pragma unroll
        for (int j = 0; j < 4; ++j) { x[j][0] = *(const GAS f32x4*)(xr + j * 512 + F.lane * 8); x[j][1] = *(const GAS f32x4*)(xr + j * 512 + F.lane * 8 + 4); }
        f32x4 yf[4][2]; float ss = 0.f;
#pragma unroll
        for (int j = 0; j < 4; ++j) { yf[j][0] = (f32x4){bflo(y[j].x), bfhi(y[j].x), bflo(y[j].y), bfhi(y[j].y)}; yf[j][1] = (f32x4){bflo(y[j].z), bfhi(y[j].z), bflo(y[j].w), bfhi(y[j].w)};
#pragma unroll
            for (int q = 0; q < 2; ++q) { const f32x4 v = yf[j][q]; ss += (v.x * v.x + v.y * v.y) + (v.z * v.z + v.w * v.w); } }
        const float r = rsqrtf(wave_sum(ss) * (1.0f / DM) + RMS_EPS);
        float s2 = 0.f;
#pragma unroll
        for (int j = 0; j < 4; ++j)
#pragma unroll
            for (int q = 0; q < 2; ++q) { const f32x4 v = x[j][q] + yf[j][q] * r * ga[j][q]; x[j][q] = v; s2 += (v.x * v.x + v.y * v.y) + (v.z * v.z + v.w * v.w);
                *(GAS f32x4*)(F.out + (size_t)m * DM + j * 512 + F.lane * 8 + q * 4) = v; }
        if (WRITE_H) {
            const float r2 = rsqrtf(wave_sum(s2) * (1.0f / DM) + RMS_EPS);
#pragma unroll
            for (int j = 0; j < 4; ++j) { const f32x4 a = x[j][0] * r2 * gb[j][0], b = x[j][1] * r2 * gb[j][1];
                v4u o; o.x = cvtpk(a.x, a.y); o.y = cvtpk(a.z, a.w); o.z = cvtpk(b.x, b.y); o.w = cvtpk(b.z, b.w);
                *(GAS v4u*)(F.H + (size_t)m * DM + j * 512 + F.lane * 8) = o; }
        }
    }
}

constexpr int PREP_T = 16, PREP_U_ROWS = PREP_T + 30;
static_assert(PREP_U_ROWS * 512 * 4 + PREP_T * 512 * 4 <= RING_BYTES, "prep LDS");
__device__ __forceinline__ void rope_store4(bf16* p1, bf16* p2, const float (&a)[4], const float (&b)[4], const float (&c)[4], const float (&s)[4], float scale, bool pred) {
    float o1[4], o2[4];
#pragma unroll
    for (int k = 0; k < 4; ++k) { o1[k] = (a[k] * c[k] - b[k] * s[k]) * scale; o2[k] = (b[k] * c[k] + a[k] * s[k]) * scale; }
    if (pred) { u32x2 w1, w2; w1.x = cvtpk(o1[0], o1[1]); w1.y = cvtpk(o1[2], o1[3]); w2.x = cvtpk(o2[0], o2[1]); w2.y = cvtpk(o2[2], o2[3]);
        *(GAS u32x2*)p1 = w1; *(GAS u32x2*)p2 = w2; }
}
__device__ __forceinline__ void load4x2(const bf16* p1, const bf16* p2, float (&a)[4], float (&b)[4]) {
    const u32x2 w1 = *(const GAS u32x2*)p1, w2 = *(const GAS u32x2*)p2;
    a[0] = bflo(w1.x); a[1] = bfhi(w1.x); a[2] = bflo(w1.y); a[3] = bfhi(w1.y); b[0] = bflo(w2.x); b[1] = bfhi(w2.x); b[2] = bflo(w2.y); b[3] = bfhi(w2.y);
}
__device__ __forceinline__ void unpack8(const v4u w, float (&f)[8]) { f[0] = bflo(w.x); f[1] = bfhi(w.x); f[2] = bflo(w.y); f[3] = bfhi(w.y); f[4] = bflo(w.z); f[5] = bfhi(w.z); f[6] = bflo(w.w); f[7] = bfhi(w.w); }

__device__ __forceinline__ void prep_phase(Frame& F, const int l) {
    LAS float* U = (LAS float*)(F.lds + RING_OFF);
    LAS float* V = U + PREP_U_ROWS * 512;
    const int lane = F.lane, tid = F.tid, wave = F.wave;
    const float* cdw = F.conv_d_w + (size_t)l * 31 * 512;
    float wd[31];
#pragma unroll
    for (int j = 0; j < 31; ++j) wd[j] = cdw[j * 512 + tid];
    const float cdb = F.conv_d_b[l * 512 + tid];
    const float* caw = F.conv_a_w + (size_t)l * 3 * 512;
    const float* gq = F.q_norm_g + l * 64; const float* gk = F.k_norm_g + l * 64;
    const float C2 = attn_body::C2;
    for (int item = F.vcu; item < M / PREP_T; item += F.G) {
        const int m0 = item * PREP_T;
        int t0, S; if (m0 < MP) { t0 = m0 & (SP - 1); S = SP; } else { t0 = (m0 - MP) & (SS - 1); S = SS; }
#pragma unroll
        for (int it = 0; it < 6; ++it) { const int id = it * 512 + tid;
            if (id < PREP_U_ROWS * 64) { const int rr = id >> 6, ch = (id & 63) * 8, tp = t0 - 15 + rr;
                f32x4 u0 = (f32x4){0.f, 0.f, 0.f, 0.f}, u1 = u0;
                if (tp >= 0 && tp < S) { const bf16* zr = F.Z + (size_t)(m0 - 15 + rr) * INW; float a[8], g[8]; unpack8(*(const GAS v4u*)(zr + ZD_A + ch), a); unpack8(*(const GAS v4u*)(zr + ZD_G + ch), g);
                    u0 = (f32x4){a[0] * sigmoidf_(g[0]), a[1] * sigmoidf_(g[1]), a[2] * sigmoidf_(g[2]), a[3] * sigmoidf_(g[3])};
                    u1 = (f32x4){a[4] * sigmoidf_(g[4]), a[5] * sigmoidf_(g[5]), a[6] * sigmoidf_(g[6]), a[7] * sigmoidf_(g[7])}; }
                *(LAS f32x4*)(U + rr * 512 + ch) = u0; *(LAS f32x4*)(U + rr * 512 + ch + 4) = u1; } }
#pragma unroll 1
        for (int q = 0; q < 2; ++q) {
            const int tt = 2 * wave + q, m = m0 + tt, t = t0 + tt;
            bf16* zr = F.Z + (size_t)m * INW;
            {
                const int hq = lane >> 3, half = (lane >> 2) & 1, i0 = 4 * (lane & 3), pos = half ? (t & 63) : (t >> 6);
                float cs[4], sn[4];
#pragma unroll
                for (int k = 0; k < 4; ++k) sincos_f((float)pos * INVF[2 * (i0 + k)], sn[k], cs[k]);
                {   bf16* p1 = zr + ZB_Q + hq * 64 + half * 32 + i0; bf16* p2 = p1 + 16; float a[4], b[4]; load4x2(p1, p2, a, b);
                    float ss = (a[0] * a[0] + a[1] * a[1]) + (a[2] * a[2] + a[3] * a[3]) + (b[0] * b[0] + b[1] * b[1]) + (b[2] * b[2] + b[3] * b[3]);
                    ss += __shfl_xor(ss, 1); ss += __shfl_xor(ss, 2); ss += __shfl_xor(ss, 4);
                    const float r = rsqrtf(ss * (1.0f / 64.0f) + RMS_EPS);
#pragma unroll
                    for (int k = 0; k < 4; ++k) { a[k] = a[k] * r * gq[half * 32 + i0 + k]; b[k] = b[k] * r * gq[half * 32 + 16 + i0 + k]; }
                    rope_store4(p1, p2, a, b, cs, sn, C2, true); }
                {   const int hk = hq & 1; bf16* p1 = zr + ZB_K + hk * 64 + half * 32 + i0; bf16* p2 = p1 + 16; float a[4], b[4]; load4x2(p1, p2, a, b);
                    float ss = (a[0] * a[0] + a[1] * a[1]) + (a[2] * a[2] + a[3] * a[3]) + (b[0] * b[0] + b[1] * b[1]) + (b[2] * b[2] + b[3] * b[3]);
                    ss += __shfl_xor(ss, 1); ss += __shfl_xor(ss, 2); ss += __shfl_xor(ss, 4);
                    const float r = rsqrtf(ss * (1.0f / 64.0f) + RMS_EPS);
#pragma unroll
                    for (int k = 0; k < 4; ++k) { a[k] = a[k] * r * gk[half * 32 + i0 + k]; b[k] = b[k] * r * gk[half * 32 + 16 + i0 + k]; }
                    rope_store4(p1, p2, a, b, cs, sn, 1.0f, lane < 16); }
            }
            {
                const int hq = lane >> 3, i0 = 4 * (lane & 7);
                float cs[4], sn[4];
#pragma unroll
                for (int k = 0; k < 4; ++k) sincos_f((float)t * INVF[i0 + k], sn[k], cs[k]);
                {   bf16* p1 = zr + ZC_Q + hq * 64 + i0; bf16* p2 = p1 + 32; float a[4], b[4]; load4x2(p1, p2, a, b); rope_store4(p1, p2, a, b, cs, sn, C2, true); }
                {   const int hk = hq & 1; bf16* p1 = zr + ZC_K + hk * 64 + i0; bf16* p2 = p1 + 32; float a[4], b[4]; load4x2(p1, p2, a, b); rope_store4(p1, p2, a, b, cs, sn, 1.0f, lane < 16); }
            }
            {
                const int c0 = lane * 8; float acc[8];
#pragma unroll
                for (int k = 0; k < 8; ++k) acc[k] = 0.f;
#pragma unroll
                for (int j = 0; j < 3; ++j) { const int tp = t + j - 1;
                    if (tp >= 0 && tp < S) { const bf16* zn = F.Z + (size_t)(m + j - 1) * INW; float cc[8], vv[8]; unpack8(*(const GAS v4u*)(zn + ZA_C + c0), cc); unpack8(*(const GAS v4u*)(zn + ZA_V + c0), vv);
                        const f32x4 w0 = *(const GAS f32x4*)(caw + j * 512 + c0), w1 = *(const GAS f32x4*)(caw + j * 512 + c0 + 4);
                        acc[0] += w0.x * (cc[0] * vv[0]); acc[1] += w0.y * (cc[1] * vv[1]); acc[2] += w0.z * (cc[2] * vv[2]); acc[3] += w0.w * (cc[3] * vv[3]);
                        acc[4] += w1.x * (cc[4] * vv[4]); acc[5] += w1.y * (cc[5] * vv[5]); acc[6] += w1.z * (cc[6] * vv[6]); acc[7] += w1.w * (cc[7] * vv[7]); } }
                float bb[8]; unpack8(*(const GAS v4u*)(zr + ZA_B + c0), bb);
                v4u o; o.x = cvtpk(bb[0] * acc[0], bb[1] * acc[1]); o.y = cvtpk(bb[2] * acc[2], bb[3] * acc[3]); o.z = cvtpk(bb[4] * acc[4], bb[5] * acc[5]); o.w = cvtpk(bb[6] * acc[6], bb[7] * acc[7]);
                *(GAS v4u*)(F.Y + (size_t)m * DM + Y_A + c0) = o;
            }
        }
        __syncthreads();
        {   float uu[PREP_U_ROWS];
#pragma unroll
            for (int rr = 0; rr < PREP_U_ROWS; ++rr) uu[rr] = U[rr * 512 + tid];
#pragma unroll
            for (int tt = 0; tt < PREP_T; ++tt) { float a = cdb;
#pragma unroll
                for (int j = 0; j < 31; ++j) a += wd[j] * uu[tt + j];
                V[tt * 512 + tid] = a; } }
        __syncthreads();
#pragma unroll 1
        for (int q = 0; q < 2; ++q) { const int tt = 2 * wave + q, m = m0 + tt, c0 = lane * 8;
            const f32x4 v0 = *(const LAS f32x4*)(V + tt * 512 + c0), v1 = *(const LAS f32x4*)(V + tt * 512 + c0 + 4);
            const float mean = wave_sum((v0.x + v0.y) + (v0.z + v0.w) + (v1.x + v1.y) + (v1.z + v1.w)) * (1.0f / 512.0f);
            const f32x4 d0 = v0 - mean, d1 = v1 - mean;
            const float var = wave_sum((d0.x * d0.x + d0.y * d0.y) + (d0.z * d0.z + d0.w * d0.w) + (d1.x * d1.x + d1.y * d1.y) + (d1.z * d1.z + d1.w * d1.w)) * (1.0f / 512.0f);
            const float r = rsqrtf(var + LN_EPS);
            const f32x4 g0 = *(const GAS f32x4*)(F.ln_d_g + l * 512 + c0), g1 = *(const GAS f32x4*)(F.ln_d_g + l * 512 + c0 + 4), b0 = *(const GAS f32x4*)(F.ln_d_b + l * 512 + c0), b1 = *(const GAS f32x4*)(F.ln_d_b + l * 512 + c0 + 4);
            f32x4 y0 = d0 * r * g0 + b0, y1 = d1 * r * g1 + b1;
            y0 = (f32x4){y0.x * sigmoidf_(y0.x), y0.y * sigmoidf_(y0.y), y0.z * sigmoidf_(y0.z), y0.w * sigmoidf_(y0.w)};
            y1 = (f32x4){y1.x * sigmoidf_(y1.x), y1.y * sigmoidf_(y1.y), y1.z * sigmoidf_(y1.z), y1.w * sigmoidf_(y1.w)};
            v4u o; o.x = cvtpk(y0.x, y0.y); o.y = cvtpk(y0.z, y0.w); o.z = cvtpk(y1.x, y1.y); o.w = cvtpk(y1.z, y1.w);
            *(GAS v4u*)(F.Y + (size_t)m * DM + Y_D + c0) = o; }
        __syncthreads();
    }
}

__device__ __forceinline__ void attn_phase_all(Frame& F, const int l, char* shm) {
    typedef attn_body::bf16 abf;
    const abf* Z = (const abf*)F.Z; abf* Y = (abf*)F.Y;
    for (int i = 0;; ++i) {
        const int idx = i * F.G + F.vcu; if (idx >= 1280) break;
        const int r = idx >> 8, v = idx & 255, x = v >> 5, j = v & 31;
        int head, kv, qb, NT; long srow;
        if (r < 4) { const int sx = x >> 1; kv = sx & 1; head = kv * 4 + (x & 1) * 2 + (r >> 1); qb = (r & 1) * 32 + j; srow = (long)(sx >> 1) * SP; NT = SP / 64; }
        else { kv = x & 1; head = kv * 4 + (j >> 3); qb = j & 7; srow = (long)MP + (long)(x >> 1) * SS; NT = SS / 64; }
        const long qrow = srow + qb * 256;
        attn_body::attn_unit<0, 8>(Z + qrow * INW + ZB_Q + head * 64, Z + srow * INW + ZB_K + kv * 64, Z + srow * INW + ZB_V + kv * 64, Y + qrow * DM + Y_B + head * 64, NT, 0, 0, 0.f, shm);
    }
    for (int i = 0;; ++i) {
        const int u = i * F.G + F.vcu; if (u >= 1280) break;
        const int qblk = u >> 3, head = u & 7, kv = head >> 2; const long qrow = (long)qblk * 256;
        long srow; int S; if (qrow < MP) { srow = (qrow / SP) * SP; S = SP; } else { srow = MP + ((qrow - MP) / SS) * SS; S = SS; }
        const int q0 = (int)(qrow - srow);
        const float sink2 = F.sink_c[l * 8 + head] * LOG2E;
        attn_body::attn_unit<1, 8>(Z + qrow * INW + ZC_Q + head * 64, Z + srow * INW + ZC_K + kv * 64, Z + srow * INW + ZC_V + kv * 64, Y + qrow * DM + Y_C + head * 64, 8, q0, S, sink2, shm);
    }
}

struct Args { const float* in[18]; float* out; unsigned char* ws; int ph_lo, ph_hi, li, pad; };
__global__ void __launch_bounds__(NWAVES * 64, 2) fwd(Args args) {
    extern __shared__ __attribute__((aligned(16))) unsigned char lds[];
    Frame F;
    F.lds = (LAS unsigned char*)lds;
    F.MISC = (volatile LAS unsigned*)(F.lds + MISC_OFF);
    F.tid = threadIdx.x; F.lane = F.tid & 63; F.wave = __builtin_amdgcn_readfirstlane(F.tid >> 6);
    F.G = gridDim.x; { const int bx = blockIdx.x; F.vcu = (F.G % 8 == 0) ? (bx % 8) * (F.G / 8) + bx / 8 : bx; }
    unsigned char* ws = args.ws; F.ws = ws;
    F.ctl = (gu32*)(ws + WS_CTL);
    F.xp = args.in[0]; F.xs = args.in[1]; F.pre_mix_g = args.in[2]; F.w_in = args.in[3]; F.conv_a_w = args.in[4]; F.q_norm_g = args.in[5]; F.k_norm_g = args.in[6]; F.sink_c = args.in[7];
    F.conv_d_w = args.in[8]; F.conv_d_b = args.in[9]; F.ln_d_g = args.in[10]; F.ln_d_b = args.in[11]; F.w_out = args.in[12]; F.post_mix_g = args.in[13]; F.pre_ffn_g = args.in[14];
    F.w_ff1 = args.in[15]; F.w_ff2 = args.in[16]; F.post_ffn_g = args.in[17]; F.out = args.out;
    F.Z = (bf16*)(ws + WS_Z); F.Y = (bf16*)(ws + WS_Y); F.H = (bf16*)(ws + WS_H);
    bf16* const YPb = F.Z;
    bf16* const Ub = F.Y;
    for (int u = F.tid; u < (LDS_BYTES - LDSCTL_OFF) / 4; u += NWAVES * 64) ((LAS unsigned*)(F.lds + LDSCTL_OFF))[u] = 0u;
    __syncthreads();
    XcdBarrier bar; bar.bar = (unsigned*)(F.ctl + CW_BAR); bar.x = 0; bar.st = nullptr;
    if (MK_N_LAUNCHES == 1) bar = xcd_barrier_post((unsigned*)(F.ctl + CW_BAR), F.MISC + 8);
    const int lo = args.ph_lo, hi = args.ph_hi; int ph = 0;
#define PH_BEGIN if (lo <= ph && ph < hi) { { int t_ = threadIdx.x; asm volatile("" : "+v"(t_)); F.tid = t_; F.lane = t_ & 63; F.wave = __builtin_amdgcn_readfirstlane(t_ >> 6); }
#define PH_END   if (ph + 1 < hi) xcd_barrier(bar); } ++ph;

    PH_BEGIN p0_prologue(F); PH_END

#pragma unroll 1
    for (int l = 0; l < DEPTH; ++l) {
        PH_BEGIN { pg8::Gemm g{F.H, wt_ptr(F, l, WO_IN), M, INW, DM}; pg8::StaticOrder S; S.init(M, INW, F.G, (int)blockIdx.x);
            pg8::EpiBf16<0> E{F.Z, INW, nullptr, 0, 0, 1.f};
            pg8::gemm_phase<pg8::EpiBf16<0>, pg8::StaticOrder, true, true>(F.lds + RING_OFF, g, S, E); } PH_END
        PH_BEGIN prep_phase(F, l); PH_END
        PH_BEGIN attn_phase_all(F, l, (char*)lds + RING_OFF); PH_END
        PH_BEGIN { pg8::Gemm g{F.Y, wt_ptr(F, l, WO_OUT), M, DM, DM}; pg8::StaticOrder S; S.init(M, DM, F.G, (int)blockIdx.x);
            pg8::EpiBf16<0> E{YPb, DM, nullptr, 0, 0, 1.f};
            pg8::gemm_phase<pg8::EpiBf16<0>, pg8::StaticOrder, true, true>(F.lds + RING_OFF, g, S, E); } PH_END
        PH_BEGIN norm_pass<true>(F, YPb, F.post_mix_g + l * DM, F.pre_ffn_g + l * DM, l == 0); PH_END
#pragma unroll 1
        for (int c = 0; c < NCHUNK; ++c) {
            PH_BEGIN { pg8::Gemm g{F.H + (size_t)c * MC * DM, wt_ptr(F, l, WO_F1), MC, FF, DM}; pg8::StaticOrder S; S.init(MC, FF, F.G, (int)blockIdx.x);
                pg8::EpiBf16<2> E{Ub, FF, nullptr, 0, 0, 1.f};
                pg8::gemm_phase<pg8::EpiBf16<2>, pg8::StaticOrder, true, true>(F.lds + RING_OFF, g, S, E); } PH_END
            PH_BEGIN { pg8::Gemm g{Ub, wt_ptr(F, l, WO_F2), MC, DM, FF}; pg8::StaticOrder S; S.init(MC, DM, F.G, (int)blockIdx.x);
                pg8::EpiBf16<0> E{YPb + (size_t)c * MC * DM, DM, nullptr, 0, 0, 1.f};
                pg8::gemm_phase<pg8::EpiBf16<0>, pg8::StaticOrder, true, true>(F.lds + RING_OFF, g, S, E); } PH_END
        }
        PH_BEGIN if (l + 1 < DEPTH) norm_pass<true>(F, YPb, F.post_ffn_g + l * DM, F.pre_mix_g + (l + 1) * DM, false); else norm_pass<false>(F, YPb, F.post_ffn_g + l * DM, nullptr, false); PH_END
    }
#undef PH_BEGIN
#undef PH_END
}

extern "C" void kernel_launch(void* const* d_in, const int* in_sizes, int n_in, void* d_out, int out_size, void* d_ws, size_t ws_size, hipStream_t stream) {
    static int grid = 0;
    if (grid == 0) {
        if (n_in != 18 || in_sizes[0] != MP * DM || in_sizes[1] != MS * DM || out_size != M * DM || ws_size < WS_END) {
            fprintf(stderr, "kernel_launch: unexpected shapes (n_in %d, in0 %d, in1 %d, out %d, ws %zu; need ws >= %zu); nothing launched\n", n_in, n_in > 0 ? in_sizes[0] : -1, n_in > 1 ? in_sizes[1] : -1, out_size, ws_size, (size_t)WS_END); grid = -1; return; }
        int dev = 0, cus = 0, per_cu = 0;
        if (hipGetDevice(&dev) != hipSuccess || hipDeviceGetAttribute(&cus, hipDeviceAttributeMultiprocessorCount, dev) != hipSuccess) { fprintf(stderr, "kernel_launch: device query failed\n"); grid = -1; return; }
        if (hipFuncSetAttribute((const void*)fwd, hipFuncAttributeMaxDynamicSharedMemorySize, LDS_BYTES) != hipSuccess) { fprintf(stderr, "kernel_launch: hipFuncSetAttribute failed\n"); grid = -1; return; }
        if (hipOccupancyMaxActiveBlocksPerMultiprocessor(&per_cu, (const void*)fwd, NWAVES * 64, LDS_BYTES) != hipSuccess || per_cu < 1)
            fprintf(stderr, "kernel_launch: note: occupancy query reports %d workgroups per CU\n", per_cu);
        (void)hipGetLastError();
        grid = cus;
    }
    if (grid < 0) return;
    if (hipMemsetAsync((char*)d_ws + WS_CTL, 0, CTL_ZERO_BYTES, stream) != hipSuccess) { fprintf(stderr, "kernel_launch: memset failed\n"); return; }
    Args a{};
    for (int i = 0; i < 18; ++i) a.in[i] = (const float*)d_in[i];
    a.out = (float*)d_out; a.ws = (unsigned char*)d_ws;
    for (int li = 0; li < MK_N_LAUNCHES; ++li) {
        a.ph_lo = (MK_N_LAUNCHES == 1) ? 0 : li; a.ph_hi = (MK_N_LAUNCHES == 1) ? N_PHASES : li + 1; a.li = li; a.pad = 0;
        hipLaunchKernelGGL(fwd, dim3(grid), dim3(NWAVES * 64), LDS_BYTES, stream, a);
        const hipError_t le = hipPeekAtLastError();
        if (le != hipSuccess) { fprintf(stderr, "kernel_launch: launch %d failed: %s\n", li, hipGetErrorName(le)); break; }
    }
}
```

```cpp
#ifndef PSCALE_EXPR
#define PSCALE_EXPR __int_as_float((127 + ref0) << 23)
#endif
#include <hip/hip_runtime.h>
#include <hip/hip_bf16.h>
#include <cstdio>
#include <cstdint>
#include <cmath>
__constant__ float INVF[32] = {
    1.000000000e+00f, 7.498942018e-01f, 5.623413324e-01f, 4.216965139e-01f, 3.162277639e-01f, 2.371373922e-01f, 1.778279394e-01f, 1.333521456e-01f,
    1.000000015e-01f, 7.498941571e-02f, 5.623412877e-02f, 4.216964915e-02f, 3.162277862e-02f, 2.371373586e-02f, 1.778279431e-02f, 1.333521493e-02f,
    9.999999776e-03f, 7.498942316e-03f, 5.623413250e-03f, 4.216964822e-03f, 3.162277862e-03f, 2.371373819e-03f, 1.778279431e-03f, 1.333521446e-03f,
    1.000000047e-03f, 7.498941850e-04f, 5.623413017e-04f, 4.216965463e-04f, 3.162277862e-04f, 2.371373848e-04f, 1.778279402e-04f, 1.333521504e-04f};

__device__ __forceinline__ void sincos_f(float ang, float& s, float& c) {
    const double rev = (double)ang * 0.15915494309189535; const float fr = (float)(rev - __builtin_rint(rev));
    s = __builtin_amdgcn_sinf(fr); c = __builtin_amdgcn_cosf(fr);
}

namespace pg8 {
#define PG8_LAS __attribute__((address_space(3)))
typedef unsigned short bf16_t;
typedef short bf16x8 __attribute__((ext_vector_type(8)));
typedef float f32x4 __attribute__((ext_vector_type(4)));
typedef unsigned u32x4 __attribute__((ext_vector_type(4)));
constexpr int BM = 256, BK = 64, HALF = 128, HTB = HALF * BK * 2  , STAGE_BYTES = 8 * HTB, NXCD = 8, WGM = 8;

__host__ __device__ __forceinline__ int lds_byte(int r, int c) { const int st = (r >> 4) * 2 + (c >> 5), rr = r & 15, cc = c & 31, ob = rr * 64 + cc * 2; return st * 1024 + (ob ^ (((ob >> 9) & 1) << 5)); }
__host__ __device__ __forceinline__ void stage_rc(int b, int& R, int& C) { const int st = b / 1024, sb = b % 1024, swz = sb ^ (((sb >> 9) & 1) << 5); R = (st >> 1) * 16 + swz / 64; C = (st & 1) * 32 + (swz % 64) / 2; }
__host__ __device__ __forceinline__ unsigned tiled_off(int r, int c, int kc) { return ((unsigned)((r >> 4) * (kc >> 5) + (c >> 5)) << 10) + (unsigned)((r & 15) * 64 + (c & 31) * 2); }
__host__ __device__ __forceinline__ int perm32(int rho) { const int n = rho >> 4, i = rho & 15; return 8 * (i >> 2) + 4 * n + (i & 3); }

struct Unit { int pm, pn; };
struct Gemm { const bf16_t* A; const bf16_t* Bt; int M, N, K; };

struct StaticOrder {
    int nM, nN, nwg, G, c;
    __host__ __device__ void init(int M, int N, int G_, int c_) { nM = M / BM; nN = N / BM; nwg = nM * nN; G = G_; c = c_; }
    __host__ __device__ bool next(int i, Unit& u) const {
        const long L = (long)i * G + c; if (L >= nwg) return false;
        int wgid = (int)L; { const int q = nwg / NXCD, r = nwg % NXCD, xcd = wgid % NXCD, off = wgid / NXCD; wgid = (xcd < r ? xcd * (q + 1) : r * (q + 1) + (xcd - r) * q) + off; }
        const int nig = WGM * nN, gid = wgid / nig, fm = gid * WGM, gsz = (nM - fm) < WGM ? (nM - fm) : WGM;
        u.pm = fm + ((wgid % nig) % gsz); u.pn = (wgid % nig) / gsz; return true;
    }
    __device__ __forceinline__ void a_ready(const Unit&) const {}
    __device__ __forceinline__ void done(const Unit&) const {}
};

__device__ __forceinline__ unsigned cvt_pk_bf16(float lo, float hi) { unsigned r; asm volatile("v_cvt_pk_bf16_f32 %0, %1, %2" : "=v"(r) : "v"(lo), "v"(hi)); return r; }
template <int ACT  , bool RS  , bool OTILED = false  > struct EpiBf16 {
    static constexpr bool PERM = true, AFTER_DRAIN = false; static_assert(ACT == 0 || ACT == 2, "EpiBf16: ACT is 0 (none) or 2 (squared relu)");
    bf16_t* O; int ldc; const float* rscale;
    struct State { float rs[2][4]; };
    __device__ __forceinline__ void load(State& st, const Unit& u, int wr, int fr) const {
        if constexpr (RS) { const int row0 = u.pm * BM + wr * 64 + fr;
#pragma unroll
            for (int ai = 0; ai < 2; ++ai)
#pragma unroll
                for (int m = 0; m < 4; ++m) st.rs[ai][m] = rscale[row0 + ai * HALF + m * 16]; }
    }
    __device__ __forceinline__ void operator()(const f32x4 (&acc)[2][2][4][2], const Unit& u, int wr, int wc, int fr, int fq, const State& st) const {
        const int row0 = u.pm * BM + wr * 64 + fr; const int col0 = u.pn * BM + wc * 32 + 8 * fq;
#pragma unroll
        for (int ai = 0; ai < 2; ++ai)
#pragma unroll
            for (int m = 0; m < 4; ++m) { bf16_t* rowp = OTILED ? (bf16_t*)((char*)O + tiled_off(row0 + ai * HALF + m * 16, col0, ldc)) : O + (size_t)(row0 + ai * HALF + m * 16) * ldc + col0;
#pragma unroll
                for (int bj = 0; bj < 2; ++bj) { f32x4 v0 = acc[ai][bj][m][0], v1 = acc[ai][bj][m][1];
                    if constexpr (RS) { v0 = v0 * st.rs[ai][m]; v1 = v1 * st.rs[ai][m]; }
                    if (ACT == 2) { const f32x4 z4 = (f32x4){0.f, 0.f, 0.f, 0.f}; v0 = __builtin_elementwise_max(v0, z4); v1 = __builtin_elementwise_max(v1, z4); v0 = v0 * v0; v1 = v1 * v1; }
                    u32x4 w; w.x = cvt_pk_bf16(v0[0], v0[1]); w.y = cvt_pk_bf16(v0[2], v0[3]); w.z = cvt_pk_bf16(v1[0], v1[1]); w.w = cvt_pk_bf16(v1[2], v1[3]);
                    *(u32x4*)(rowp + (OTILED ? bj * (HALF / 32) * 512 : bj * HALF)) = w; } }
    }
};

struct EpiIn {
    static constexpr bool PERM = true, AFTER_DRAIN = false;
    bf16_t* O; int ldc; const float* rscale;
    struct State { float rs[2][4]; };
    __device__ __forceinline__ void load(State& st, const Unit& u, int wr, int fr) const {
        const int row0 = u.pm * BM + wr * 64 + fr;
#pragma unroll
        for (int ai = 0; ai < 2; ++ai)
#pragma unroll
            for (int m = 0; m < 4; ++m) st.rs[ai][m] = rscale[row0 + ai * HALF + m * 16];
    }
    __device__ __forceinline__ void operator()(const f32x4 (&acc)[2][2][4][2], const Unit& u, int wr, int wc, int fr, int fq, const State& st) const {
        const int row0 = u.pm * BM + wr * 64 + fr, pn = u.pn;
        const int kind = (pn >= 2 && pn < 6) ? 1 : (pn >= 12 ? 2 : 0);
        const int colb = pn < 2 ? 256 * pn : (pn < 6 ? 512 + 128 * (pn - 2) : (pn < 12 ? 1024 + 256 * (pn - 6) : 2560 + 128 * (pn - 12)));
        const int col0 = colb + wc * 32 + 8 * fq;
        if (kind == 0) {
#pragma unroll
            for (int ai = 0; ai < 2; ++ai)
#pragma unroll
                for (int m = 0; m < 4; ++m) { bf16_t* rowp = O + (size_t)(row0 + ai * HALF + m * 16) * ldc + col0;
#pragma unroll
                    for (int bj = 0; bj < 2; ++bj) { const f32x4 v0 = acc[ai][bj][m][0] * st.rs[ai][m], v1 = acc[ai][bj][m][1] * st.rs[ai][m];
                        u32x4 w; w.x = cvt_pk_bf16(v0[0], v0[1]); w.y = cvt_pk_bf16(v0[2], v0[3]); w.z = cvt_pk_bf16(v1[0], v1[1]); w.w = cvt_pk_bf16(v1[2], v1[3]);
                        *(u32x4*)(rowp + bj * HALF) = w; } }
        } else {
#pragma unroll
            for (int ai = 0; ai < 2; ++ai)
#pragma unroll
                for (int m = 0; m < 4; ++m) { bf16_t* rowp = O + (size_t)(row0 + ai * HALF + m * 16) * ldc + col0; float o[8];
#pragma unroll
                    for (int n = 0; n < 2; ++n)
#pragma unroll
                        for (int e = 0; e < 4; ++e) { const float a = acc[ai][0][m][n][e] * st.rs[ai][m], b = acc[ai][1][m][n][e] * st.rs[ai][m];
                            o[4 * n + e] = kind == 1 ? a * b : a * __builtin_amdgcn_rcpf(1.0f + __expf(-b)); }
                    u32x4 w; w.x = cvt_pk_bf16(o[0], o[1]); w.y = cvt_pk_bf16(o[2], o[3]); w.z = cvt_pk_bf16(o[4], o[5]); w.w = cvt_pk_bf16(o[6], o[7]);
                    *(u32x4*)rowp = w; }
        }
    }
};

template <class Epi, class Sched, bool ALIGN_EPI = false, bool SP2 = false, bool ATILED = false>
__device__ __forceinline__ void gemm_phase(PG8_LAS unsigned char* lds, const Gemm g, const Sched& S, const Epi& E) {
    int tid_ = threadIdx.x; asm volatile("" : "+v"(tid_));
    const int tid = tid_, wid = __builtin_amdgcn_readfirstlane(tid >> 6), lane = tid & 63, wr = wid >> 2, wc = wid & 3, fr = lane & 15, fq = lane >> 4;
    const int K = g.K, nt = K / BK;
    unsigned voffA[2], voffB[2];
#pragma unroll
    for (int i = 0; i < 2; ++i) { int R, C; stage_rc(tid * 16 + i * 8192, R, C); static_assert(Epi::PERM, "the tiled weight copies are stored in PERM row order");
        voffA[i] = ATILED ? tiled_off(R, C, K) : (unsigned)(R * K + C) * 2u; voffB[i] = tiled_off(R, C, K); }
    const size_t kstepA = ATILED ? 2048 : (size_t)(BK * 2), kstepB = 2048;
    const size_t hstep = (size_t)HALF * K * 2;
    const size_t tstep = 2 * hstep;
    const unsigned ldsw = (unsigned)wid * 1024u;
    const int aoff = lds_byte(wr * 64 + fr, fq * 8), boff = lds_byte(wc * 32 + fr, fq * 8);
#define PG8_SA(b, h) (((b) * 2 + (h)) * HTB)
#define PG8_SB(b, h) ((4 + (b) * 2 + (h)) * HTB)
#define PG8_STAGE(bufoff, gbase, voff) do { _Pragma("unroll") for (int _i = 0; _i < 2; ++_i) \
        __builtin_amdgcn_global_load_lds((const unsigned*)((const char*)(gbase) + (voff)[_i]), (PG8_LAS unsigned*)(lds + (bufoff) + ldsw + _i * 8192), 16, 0, 0); } while (0)
#define PG8_LDA(dst, b, h) do { _Pragma("unroll") for (int m = 0; m < 4; ++m) _Pragma("unroll") for (int k = 0; k < 2; ++k) dst[m][k] = *(const PG8_LAS bf16x8*)(lds + PG8_SA(b, h) + aoff + m * 2048 + k * 1024); } while (0)
#define PG8_LDB(dst, b, h) do { _Pragma("unroll") for (int n = 0; n < 2; ++n) _Pragma("unroll") for (int k = 0; k < 2; ++k) dst[n][k] = *(const PG8_LAS bf16x8*)(lds + PG8_SB(b, h) + boff + n * 2048 + k * 1024); } while (0)
#define PG8_MMA(ai, bj, At, Bt) do { __builtin_amdgcn_s_setprio(1); _Pragma("unroll") for (int m = 0; m < 4; ++m) _Pragma("unroll") for (int n = 0; n < 2; ++n) _Pragma("unroll") for (int k = 0; k < 2; ++k) \
        acc[ai][bj][m][n] = __builtin_amdgcn_mfma_f32_16x16x32_bf16(Bt[n][k], At[m][k], acc[ai][bj][m][n], 0, 0, 0); __builtin_amdgcn_s_setprio(0); } while (0)
#define PG8_WAIT_V(n) asm volatile("s_waitcnt vmcnt(" #n ")" ::: "memory")
#define PG8_WAIT_L(n) asm volatile("s_waitcnt lgkmcnt(" #n ")" ::: "memory")
#define PG8_BAR __builtin_amdgcn_s_barrier()
#define PG8_SCHED __builtin_amdgcn_sched_barrier(0)
    Unit cur, nxt; int ui = 0;
    if (!S.next(0, cur)) return;
    typename Epi::State est; E.load(est, cur, wr, fr);
    f32x4 acc[2][2][4][2];
#pragma unroll
    for (int a = 0; a < 2; ++a)
#pragma unroll
        for (int b = 0; b < 2; ++b)
#pragma unroll
            for (int m = 0; m < 4; ++m)
#pragma unroll
                for (int n = 0; n < 2; ++n) acc[a][b][m][n] = (f32x4){0.f, 0.f, 0.f, 0.f};
    bf16x8 At[4][2], B0[2][2], B1[2][2];
    const char* cA = (const char*)g.A + (size_t)cur.pm * tstep; const char* cB = (const char*)g.Bt + (size_t)cur.pn * tstep;
    S.a_ready(cur);
    if constexpr (SP2) {
        PG8_STAGE(PG8_SB(0, 0), cB, voffB); PG8_STAGE(PG8_SB(0, 1), cB + hstep, voffB); PG8_STAGE(PG8_SA(0, 0), cA, voffA); PG8_STAGE(PG8_SA(0, 1), cA + hstep, voffA);
        if (wr == 1) PG8_BAR;
        PG8_WAIT_V(2); PG8_BAR;
        PG8_STAGE(PG8_SB(1, 0), cB + kstepB, voffB); PG8_STAGE(PG8_SB(1, 1), cB + hstep + kstepB, voffB);
        PG8_WAIT_V(4); PG8_BAR;
    } else {
        PG8_STAGE(PG8_SB(0, 0), cB, voffB); PG8_STAGE(PG8_SA(0, 0), cA, voffA); PG8_STAGE(PG8_SB(0, 1), cB + hstep, voffB); PG8_STAGE(PG8_SA(0, 1), cA + hstep, voffA);
        if (wr == 1) PG8_BAR;
        PG8_WAIT_V(4); PG8_BAR;
        PG8_STAGE(PG8_SB(1, 0), cB + kstepB, voffB); PG8_STAGE(PG8_SA(1, 0), cA + kstepA, voffA); PG8_STAGE(PG8_SB(1, 1), cB + hstep + kstepB, voffB);
        PG8_WAIT_V(6); PG8_BAR;
    }
    for (;;) {
        const bool has_next = S.next(ui + 1, nxt);
        const char* nA = has_next ? (const char*)g.A + (size_t)nxt.pm * tstep : cA; const char* nB = has_next ? (const char*)g.Bt + (size_t)nxt.pn * tstep : cB;
        for (int t = 0; t < nt; t += 2) {
            const bool last = (t == nt - 2);
            const char* a1 = cA + (size_t)(t + 1) * kstepA;
            const char* a2 = last ? nA : cA + (size_t)(t + 2) * kstepA; const char* b2 = last ? nB : cB + (size_t)(t + 2) * kstepB;
            const char* a3 = a2 + kstepA; const char* b3 = b2 + kstepB;
            if (last && has_next) S.a_ready(nxt);
            if constexpr (SP2) {
            PG8_LDB(B0, 0, 0); PG8_LDB(B1, 0, 1); PG8_SCHED; PG8_LDA(At, 0, 0); PG8_STAGE(PG8_SA(1, 0), a1, voffA); PG8_STAGE(PG8_SA(1, 1), a1 + hstep, voffA);
            PG8_WAIT_V(8); PG8_WAIT_L(0); PG8_BAR; PG8_MMA(0, 0, At, B0); PG8_MMA(0, 1, At, B1); PG8_BAR; PG8_SCHED;
            PG8_LDA(At, 0, 1); PG8_STAGE(PG8_SB(0, 0), b2, voffB); PG8_STAGE(PG8_SB(0, 1), b2 + hstep, voffB);
            PG8_WAIT_V(6); PG8_WAIT_L(0); PG8_BAR; PG8_MMA(1, 0, At, B0); PG8_MMA(1, 1, At, B1); PG8_BAR; PG8_SCHED;
            PG8_LDB(B0, 1, 0); PG8_LDB(B1, 1, 1); PG8_SCHED; PG8_LDA(At, 1, 0); PG8_STAGE(PG8_SA(0, 0), a2, voffA); PG8_STAGE(PG8_SA(0, 1), a2 + hstep, voffA);
            PG8_WAIT_V(8); PG8_WAIT_L(0); PG8_BAR; PG8_MMA(0, 0, At, B0); PG8_MMA(0, 1, At, B1); PG8_BAR; PG8_SCHED;
            PG8_LDA(At, 1, 1); PG8_STAGE(PG8_SB(1, 0), b3, voffB); PG8_STAGE(PG8_SB(1, 1), b3 + hstep, voffB);
            PG8_WAIT_V(6); PG8_WAIT_L(0); PG8_BAR; PG8_MMA(1, 0, At, B0); PG8_MMA(1, 1, At, B1); PG8_BAR; PG8_SCHED;
            } else {
            PG8_LDB(B0, 0, 0); PG8_SCHED; PG8_LDA(At, 0, 0); PG8_STAGE(PG8_SA(1, 1), a1 + hstep, voffA);
            PG8_WAIT_L(8); PG8_BAR; PG8_WAIT_L(0); PG8_MMA(0, 0, At, B0); PG8_BAR; PG8_SCHED;
            PG8_LDB(B1, 0, 1); PG8_STAGE(PG8_SB(0, 0), b2, voffB);
            PG8_BAR; PG8_WAIT_L(0); PG8_MMA(0, 1, At, B1); PG8_BAR;
            PG8_LDA(At, 0, 1); PG8_STAGE(PG8_SA(0, 0), a2, voffA);
            PG8_BAR; PG8_WAIT_L(0); PG8_MMA(1, 0, At, B0); PG8_BAR; PG8_SCHED;
            PG8_STAGE(PG8_SB(0, 1), b2 + hstep, voffB);
            PG8_WAIT_V(6); PG8_BAR; PG8_MMA(1, 1, At, B1); PG8_BAR;
            PG8_LDB(B0, 1, 0); PG8_SCHED; PG8_LDA(At, 1, 0); PG8_STAGE(PG8_SA(0, 1), a2 + hstep, voffA);
            PG8_WAIT_L(8); PG8_BAR; PG8_WAIT_L(0); PG8_MMA(0, 0, At, B0); PG8_BAR; PG8_SCHED;
            PG8_LDB(B1, 1, 1); PG8_STAGE(PG8_SB(1, 0), b3, voffB);
            PG8_BAR; PG8_WAIT_L(0); PG8_MMA(0, 1, At, B1); PG8_BAR;
            PG8_LDA(At, 1, 1); PG8_STAGE(PG8_SA(1, 0), a3, voffA);
            PG8_BAR; PG8_WAIT_L(0); PG8_MMA(1, 0, At, B0); PG8_BAR; PG8_SCHED;
            PG8_STAGE(PG8_SB(1, 1), b3 + hstep, voffB);
            PG8_WAIT_V(6); PG8_BAR; PG8_MMA(1, 1, At, B1); PG8_BAR;
            }
        }
        if constexpr (ALIGN_EPI) { if (wr == 0) PG8_BAR; }
        if constexpr (!Epi::AFTER_DRAIN) { E(acc, cur, wr, wc, fr, fq, est); S.done(cur); }
        if (!has_next) break;
        E.load(est, nxt, wr, fr);
#pragma unroll
        for (int a = 0; a < 2; ++a)
#pragma unroll
            for (int b = 0; b < 2; ++b)
#pragma unroll
                for (int m = 0; m < 4; ++m)
#pragma unroll
                    for (int n = 0; n < 2; ++n) acc[a][b][m][n] = (f32x4){0.f, 0.f, 0.f, 0.f};
        cur = nxt; cA = nA; cB = nB; ++ui;
        if constexpr (ALIGN_EPI) { if (wr == 1) PG8_BAR; }
    }
    PG8_WAIT_V(0);
    if constexpr (!ALIGN_EPI) { if (wr == 0) PG8_BAR; }
    PG8_BAR;
    if constexpr (Epi::AFTER_DRAIN) { E.fused(acc, cur, wr, wc, fr, fq, lds, wid, lane); S.done(cur); }
#undef PG8_SA
#undef PG8_SB
#undef PG8_STAGE
#undef PG8_LDA
#undef PG8_LDB
#undef PG8_MMA
#undef PG8_WAIT_V
#undef PG8_WAIT_L
#undef PG8_BAR
#undef PG8_SCHED
}
}

namespace attn_body {
using bf16=__hip_bfloat16;
using bf16x8=__attribute__((ext_vector_type(8)))short;
using s16x4=__attribute__((ext_vector_type(4)))short;
using f32x16=__attribute__((ext_vector_type(16)))float;
using u32x4=__attribute__((ext_vector_type(4)))unsigned;
constexpr int D=64,ZP=3072,OP=2048;
constexpr int NW=8,QBLK=32,QB=QBLK*NW,KVBLK=64;
constexpr int ATTN_UNIT_ROWS=QB;
__device__ __forceinline__ int crow(int r,int hi){return (r&3)+8*(r>>2)+4*hi;}
#define SBAR() __builtin_amdgcn_sched_barrier(0)
template<int MODE> __device__ __forceinline__ int trow(int t,int q0,int S){
  if constexpr(MODE!=1){ return 64*t; }
  else { const int j=(t+3)&7; const int kpos=q0-128+64*j; return (kpos>=0&&kpos<S)?kpos:(q0+64); }
}
template<int MODE> __device__ __forceinline__ void tmask(f32x16&p0,f32x16&p1,int t,int qrel,int hi,int q0,int S){
  if constexpr(MODE==1){
    const float NEG=-INFINITY; const int j=(t+3)&7; const int krel0=-128+64*j; const int kpos=q0+krel0;
    const int base=(kpos>=0&&kpos<S)?(krel0+4*hi-qrel+128):100000;
    #pragma unroll
    for(int r=0;r<16;++r){const int kv=base+(r&3)+8*(r>>2); if((unsigned)kv>256u)p0[r]=NEG; if((unsigned)(kv+32)>256u)p1[r]=NEG;}
  }
}

constexpr int NSLOT=3, SLOTB=8192;
constexpr int LDS_K=0, LDS_V=NSLOT*SLOTB, LDS_WS=2*NSLOT*SLOTB, LDS_OST=LDS_WS+NW*64*4, LDS_BYTES=LDS_OST+NW*4096;
constexpr float C2=0.125f*1.4426950408889634f;
__device__ __forceinline__ void glds16(const void*gsrc,unsigned lds_dst){unsigned keep;
  asm volatile("s_mov_b32 %0, m0\n\ts_mov_b32 m0, %2\n\ts_nop 0\n\tglobal_load_lds_dwordx4 %1, off\n\ts_mov_b32 m0, %0":"=&s"(keep):"v"(gsrc),"s"(lds_dst):"memory");}
__device__ __forceinline__ float max3f(float a,float b,float c){float r;asm("v_max3_f32 %0, %1, %2, %3":"=v"(r):"v"(a),"v"(b),"v"(c));return r;}
__device__ __forceinline__ float max2f(float a,float b){float r;asm("v_max_f32_e32 %0, %1, %2":"=v"(r):"v"(a),"v"(b));return r;}
__device__ __forceinline__ float fadd_s(float a,float b){float r;asm("v_add_f32_e32 %0, %1, %2":"=v"(r):"v"(a),"v"(b));return r;}
__device__ __forceinline__ float fsub_s(float a,float b){float r;asm("v_sub_f32_e32 %0, %1, %2":"=v"(r):"v"(a),"v"(b));return r;}
typedef float f32x2_t __attribute__((ext_vector_type(2))); typedef __bf16 bf16x2_t __attribute__((ext_vector_type(2)));
__device__ __forceinline__ unsigned cvtpk_s(float lo,float hi){f32x2_t v={lo,hi};bf16x2_t b=__builtin_convertvector(v,bf16x2_t);return __builtin_bit_cast(unsigned,b);}
#define WAIT_BAR(N) asm volatile("s_waitcnt vmcnt(" #N ") lgkmcnt(0)\n\ts_barrier":::"memory")
#define WAIT_BAR2W() WAIT_BAR(1)

typedef int v8i_t __attribute__((ext_vector_type(8))); typedef int v4i_t __attribute__((ext_vector_type(4)));
typedef __attribute__((address_space(3))) const char* lds_cptr;
typedef short v4i16_t __attribute__((ext_vector_type(4))); typedef short v2s16_t __attribute__((ext_vector_type(2)));
#define FP8_SC 0
__device__ __forceinline__ v8i_t kfrag(lds_cptr kp){ const v4i_t lo=*(const __attribute__((address_space(3))) v4i_t*)(kp), hi=*(const __attribute__((address_space(3))) v4i_t*)(kp+1024); return __builtin_shufflevector(lo,hi,0,1,2,3,4,5,6,7); }
#define QK8(KF,QF,C) __builtin_amdgcn_mfma_scale_f32_32x32x64_f8f6f4((KF),(QF),(C),0,0,0,FP8_SC,0,FP8_SC)
__device__ __forceinline__ void qkt(f32x16&p0,f32x16&p1,lds_cptr Kslot,const v8i_t qf,const f32x16&negm,int r32,int hi){
  const lds_cptr kb=Kslot+hi*2048+r32*16;
  p0=QK8(kfrag(kb),qf,negm); p1=QK8(kfrag(kb+512),qf,negm);
}
__device__ __forceinline__ s16x4 vtr(lds_cptr p){ return __builtin_bit_cast(s16x4,__builtin_amdgcn_ds_read_tr16_b64_v4i16((__attribute__((address_space(3))) v4i16_t*)p)); }
__device__ __forceinline__ float rowmax(const f32x16&p0,const f32x16&p1){
  float a=max3f(p0[0],p0[1],p1[0]),b=max3f(p0[2],p0[3],p1[1]);a=max3f(a,p1[2],p1[3]);
  #pragma unroll
  for(int r=4;r<16;r+=4){a=max3f(a,p0[r],p0[r+1]);b=max3f(b,p0[r+2],p0[r+3]);a=max3f(a,p1[r],p1[r+1]);b=max3f(b,p1[r+2],p1[r+3]);}
  const float m=max2f(a,b);
  auto rr=__builtin_amdgcn_permlane32_swap(__float_as_uint(m),__float_as_uint(m),false,false);
  return max2f(__uint_as_float(rr[0]),__uint_as_float(rr[1]));
}
__device__ __forceinline__ void pv(f32x16*o,int vb,bf16x8 pa0,bf16x8 pa1,bf16x8 pa2,bf16x8 pa3){
  #pragma unroll
  for(int d0=0;d0<2;++d0){s16x4 lo[4],hi[4];
    #pragma unroll
    for(int ks=0;ks<4;++ks){
      asm volatile("ds_read_b64_tr_b16 %0,%1 offset:%c2":"=&v"(lo[ks]):"v"(vb),"i"(d0*4096+ks*1024):"memory");
      asm volatile("ds_read_b64_tr_b16 %0,%1 offset:%c2":"=&v"(hi[ks]):"v"(vb),"i"(d0*4096+ks*1024+512):"memory");}
    asm volatile("s_waitcnt lgkmcnt(0)":::"memory");SBAR();
    #define PK(k) (bf16x8){lo[k][0],lo[k][1],lo[k][2],lo[k][3],hi[k][0],hi[k][1],hi[k][2],hi[k][3]}
    o[d0]=__builtin_amdgcn_mfma_f32_32x32x16_bf16(pa0,PK(0),o[d0],0,0,0);
    o[d0]=__builtin_amdgcn_mfma_f32_32x32x16_bf16(pa1,PK(1),o[d0],0,0,0);
    o[d0]=__builtin_amdgcn_mfma_f32_32x32x16_bf16(pa2,PK(2),o[d0],0,0,0);
    o[d0]=__builtin_amdgcn_mfma_f32_32x32x16_bf16(pa3,PK(3),o[d0],0,0,0);
    #undef PK
  }
}

template<int QT> __device__ __forceinline__ v8i_t q_transform(const bf16x8 (&qr)[4],const int t,const int hi,const float*gq){
  float x[4][8];
  #pragma unroll
  for(int d0=0;d0<4;++d0)
    #pragma unroll
    for(int e=0;e<8;++e)x[d0][e]=__uint_as_float(((unsigned)(unsigned short)qr[d0][e])<<16);
  if constexpr(QT==1){
    float ss=0.f;
    #pragma unroll
    for(int d0=0;d0<4;++d0)
      #pragma unroll
      for(int e=0;e<8;++e)ss+=x[d0][e]*x[d0][e];
    {auto rr=__builtin_amdgcn_permlane32_swap(__float_as_uint(ss),__float_as_uint(ss),false,false);ss=__uint_as_float(rr[0])+__uint_as_float(rr[1]);}
    const float r=rsqrtf(ss*(1.0f/64.0f)+1e-6f);
    #pragma unroll
    for(int d0=0;d0<4;++d0)
      #pragma unroll
      for(int e=0;e<8;++e)x[d0][e]=x[d0][e]*r*gq[16*d0+8*hi+e];
    const int pr=t>>6,pc=t&63;
    #pragma unroll
    for(int e=0;e<8;++e){ const float f=INVF[2*(8*hi+e)]; float sn,cs;
      sincos_f((float)pr*f,sn,cs); { const float a=x[0][e],b=x[1][e]; x[0][e]=a*cs-b*sn; x[1][e]=b*cs+a*sn; }
      sincos_f((float)pc*f,sn,cs); { const float a=x[2][e],b=x[3][e]; x[2][e]=a*cs-b*sn; x[3][e]=b*cs+a*sn; } }
  } else {
    #pragma unroll
    for(int e=0;e<8;++e){ float sn,cs;
      sincos_f((float)t*INVF[8*hi+e],sn,cs);    { const float a=x[0][e],b=x[2][e]; x[0][e]=a*cs-b*sn; x[2][e]=b*cs+a*sn; }
      sincos_f((float)t*INVF[16+8*hi+e],sn,cs); { const float a=x[1][e],b=x[3][e]; x[1][e]=a*cs-b*sn; x[3][e]=b*cs+a*sn; } }
  }
  v8i_t qf;
  #pragma unroll
  for(int d0=0;d0<4;++d0){ int w0=0,w1=0;
    w0=__builtin_amdgcn_cvt_pk_fp8_f32(x[d0][0]*C2,x[d0][1]*C2,w0,false); w0=__builtin_amdgcn_cvt_pk_fp8_f32(x[d0][2]*C2,x[d0][3]*C2,w0,true);
    w1=__builtin_amdgcn_cvt_pk_fp8_f32(x[d0][4]*C2,x[d0][5]*C2,w1,false); w1=__builtin_amdgcn_cvt_pk_fp8_f32(x[d0][6]*C2,x[d0][7]*C2,w1,true);
    qf[2*d0]=w0; qf[2*d0+1]=w1; }
  return qf;
}
#ifndef ATTN_STORE16
#define ATTN_STORE16(p,v) (*(u32x4*)(p)=(v))
#endif
template<int MODE,int THRL,int QT> __device__ __forceinline__ void attn_unit(const bf16*Qu,const char*__restrict__ Kt,const char*__restrict__ Vt,bf16*Ou,const int NT,const int q0,const int S,const float sink2,const int tq0,const float*gq,char*shm){
  int tid_=threadIdx.x; asm volatile("":"+v"(tid_)); const int tid=tid_,lane=tid&63,r32=lane&31,hi=lane>>5; const int wid=__builtin_amdgcn_readfirstlane(tid>>6);
  const bf16*Qw=Qu+(long)(wid*QBLK)*ZP;
  const unsigned lds0=(unsigned)(uintptr_t)shm;
  float*wsf=(float*)(shm+LDS_WS)+wid*64;
  const bool kw=wid<4; const char*psrc=(kw?Kt+wid*1024:Vt+(wid&3)*1024)+lane*16; const unsigned pdst=lds0+(kw?LDS_K+wid*1024:LDS_V+(wid&3)*1024);
  #define DMA_P(t,slot) glds16(psrc+((long)(trow<MODE>((t),q0,S)>>6)<<12),(unsigned)__builtin_amdgcn_readfirstlane(pdst+(slot)))
  #define DMA_K(t,slot) if(kw) DMA_P(t,slot)
  #define DMA_V(t,slot) if(!kw) DMA_P(t,slot)
  #define DMA_STEP(t,GK,GV) do{ if(kw?(GK):(GV)){ const int tt_=(t)+(kw?3:1); const int sl_=kw?sl_cur:sl_next; DMA_P(tt_,sl_); } }while(0)
  v8i_t kf[2];
  const lds_cptr shm3=(lds_cptr)shm; const lds_cptr kp0=shm3+LDS_K+hi*2048+r32*16; const lds_cptr vp0=shm3+LDS_V+hi*2048+r32*16;
  DMA_P(0,0);DMA_K(1,SLOTB);
  bf16x8 qr[4];
  #pragma unroll
  for(int d0=0;d0<4;++d0)qr[d0]=*reinterpret_cast<const bf16x8*>(&Qw[(long)r32*ZP+d0*16+hi*8]);
  const v8i_t qf=q_transform<QT>(qr,tq0+wid*QBLK+r32,hi,gq);
  float mhat=0.f;f32x16 o[2];o[0]=f32x16{};o[1]=f32x16{};f32x16 o2=f32x16{};
  v8i_t ones; _Pragma("unroll") for(int i=0;i<8;++i)ones[i]=0x38383838; asm volatile("":"+v"(ones));
  f32x16 negm=f32x16{};if constexpr(MODE!=2){asm volatile("":"+v"(negm));}
  const float pscl=(MODE==2)?sink2:1.0f;
  const int qrel=wid*QBLK+r32;
  #define CMASK(P0,P1,t) tmask<MODE>(P0,P1,(t),qrel,hi,q0,S)
  bool resc=false;
  #define START(P0,P1) do{ resc=false; if constexpr(MODE!=2) \
    { const float rm=rowmax(P0,P1); const float dl=rm; mhat=fadd_s(mhat,dl); \
      _Pragma("unroll") for(int r=0;r<16;++r){P0[r]=fsub_s(P0[r],dl);P1[r]=fsub_s(P1[r],dl);} \
      _Pragma("unroll") for(int r=0;r<16;++r)negm[r]=-mhat; asm volatile("":"+v"(negm)); } \
    _Pragma("unroll") for(int r=0;r<16;++r)P0[r]=__builtin_amdgcn_exp2f(P0[r]); }while(0)
  #define RESC() do{ if constexpr(MODE!=2) if(resc){ asm volatile("s_waitcnt lgkmcnt(0)":::"memory"); \
      _Pragma("unroll") for(int r=0;r<16;++r){ const float f_=wsf[crow(r,hi)]; o[0][r]*=f_; o[1][r]*=f_; o2[r]*=f_; } } }while(0)
  f32x16 pA0,pA1,pB0,pB1;
  int sl_prev=0,sl_cur=0,sl_next=SLOTB;
  #define ROT() do{sl_prev=sl_cur;sl_cur=sl_next;sl_next=(sl_next==(NSLOT-1)*SLOTB)?0:sl_next+SLOTB;}while(0)
  DMA_K(2,2*SLOTB);
  WAIT_BAR(3);
  qkt(pA0,pA1,shm3+LDS_K,qf,negm,r32,hi);asm volatile("s_nop 15\n\ts_nop 7":"+v"(pA0),"+v"(pA1));CMASK(pA0,pA1,0);
  START(pA0,pA1);
  _Pragma("unroll") for(int r=0;r<16;++r)pA1[r]=__builtin_amdgcn_exp2f(pA1[r]);
  WAIT_BAR(0);
  DMA_P(kw?3:1,kw?0:SLOTB);
  ROT();
  kf[0]=kfrag(kp0+sl_cur); kf[1]=kfrag(kp0+sl_cur+512);
  WAIT_BAR2W();
  v8i_t vf[2], pa;
  #define PK8(P,B,W) do{ v2s16_t w2_=__builtin_bit_cast(v2s16_t,W); w2_=__builtin_amdgcn_cvt_scalef32_pk_bf8_f32(w2_,P[B],P[(B)+1],pscl,false); w2_=__builtin_amdgcn_cvt_scalef32_pk_bf8_f32(w2_,P[(B)+2],P[(B)+3],pscl,true); W=__builtin_bit_cast(int,w2_); }while(0)
  #define PV8(A,B,C) __builtin_amdgcn_mfma_scale_f32_32x32x64_f8f6f4((A),(B),(C),1,0,0,FP8_SC,0,FP8_SC)
  #define PIN(x) asm volatile("":"+v"(x))
  #define MX3(a,b,c) __builtin_fmaxf(__builtin_fmaxf((a),(b)),(c))
  #define EX(v) __builtin_amdgcn_exp2f(v)
  #define KRD(G,j) do{ if(G){ kf[(j)]=kfrag(kp0+sl_next+(j)*512); } }while(0)
  #define HALFA(P,J0) do{ _Pragma("unroll") for(int j_=0;j_<4;++j_){ int w_; asm volatile("":"=v"(w_)); PK8(P,4*j_,w_); pa[(J0)+j_]=w_; } }while(0)
  #define STEP(C0,C1,P0,P1,t,GK,GV,GL) do{ SBAR(); \
    { const lds_cptr vp_=vp0+sl_prev; vf[0]=kfrag(vp_); vf[1]=kfrag(vp_+512); } \
    PIN(kf[0]); C0=QK8(kf[0],qf,negm); PIN(C0); \
    PIN(P0); PIN(P1); HALFA(P0,0); HALFA(P1,4); PIN(pa); \
    PIN(kf[1]); C1=QK8(kf[1],qf,negm); PIN(C1); KRD(GL,0); KRD(GL,1);     \
    DMA_STEP(t,GK,GV); \
    CMASK(C0,C1,t); \
    if constexpr(MODE!=2){ float a=MX3(C0[0],C0[1],C1[0]),b=MX3(C0[2],C0[3],C1[1]); a=MX3(a,C1[2],C1[3]); \
      _Pragma("unroll") for(int r=4;r<16;r+=4){a=MX3(a,C0[r],C0[r+1]);b=MX3(b,C0[r+2],C0[r+3]);a=MX3(a,C1[r],C1[r+1]);b=MX3(b,C1[r+2],C1[r+3]);} \
      float rm=__builtin_fmaxf(a,b); { auto rr=__builtin_amdgcn_permlane32_swap(__float_as_uint(rm),__float_as_uint(rm),false,false); rm=__builtin_fmaxf(__uint_as_float(rr[0]),__uint_as_float(rr[1])); } \
      resc=false; \
      if(__builtin_expect(__any(rm>(float)THRL),0)){ const float dl=__builtin_fmaxf(rm,0.f); mhat+=dl; \
        _Pragma("unroll") for(int r=0;r<16;++r){C0[r]-=dl;C1[r]-=dl;} \
        _Pragma("unroll") for(int r=0;r<16;++r)negm[r]=-mhat; asm volatile("":"+v"(negm)); \
        const float f=__builtin_amdgcn_exp2f(-dl); if(hi==0)wsf[r32]=f; resc=true; } } \
    PIN(pa); o[0]=PV8(pa,vf[0],o[0]); PIN(o[0]); \
    PIN(C0); _Pragma("unroll") for(int r=0;r<11;++r)C0[r]=EX(C0[r]); PIN(C0); \
    PIN(pa); o[1]=PV8(pa,vf[1],o[1]); PIN(o[1]); \
    PIN(C0); PIN(C1); _Pragma("unroll") for(int r=11;r<16;++r)C0[r]=EX(C0[r]); _Pragma("unroll") for(int r=0;r<6;++r)C1[r]=EX(C1[r]); PIN(C0); PIN(C1); \
    PIN(pa); o2=PV8(pa,ones,o2); PIN(o2); \
    PIN(C1); _Pragma("unroll") for(int r=6;r<16;++r)C1[r]=EX(C1[r]); PIN(C1); \
    SBAR(); \
    }while(0)
  int t=1;
  for(;t+5<NT;t+=2){
    STEP(pB0,pB1,pA0,pA1,t,true,true,true);     WAIT_BAR2W(); RESC(); ROT();
    STEP(pA0,pA1,pB0,pB1,t+1,true,true,true);   WAIT_BAR2W(); RESC(); ROT();
  }
  #define ENDW(tt) do{ if((tt)+3<NT){WAIT_BAR2W();} else if((tt)+2<NT){ if(wid<4){WAIT_BAR(0);} else {WAIT_BAR(1);} } else {WAIT_BAR(0);} }while(0)
  for(;t+1<NT;t+=2){
    STEP(pB0,pB1,pA0,pA1,t,(t+3<NT),(t+1<NT),(t+1<NT));       ENDW(t);   RESC(); ROT();
    STEP(pA0,pA1,pB0,pB1,t+1,(t+4<NT),(t+2<NT),(t+2<NT));     ENDW(t+1); RESC(); ROT();
  }
  STEP(pB0,pB1,pA0,pA1,NT-1,false,false,false); RESC();
  { HALFA(pB0,0); HALFA(pB1,4);
    { const lds_cptr vp_=vp0+sl_cur; vf[0]=kfrag(vp_); vf[1]=kfrag(vp_+512); }
    o[0]=PV8(pa,vf[0],o[0]); o[1]=PV8(pa,vf[1],o[1]); o2=PV8(pa,ones,o2); }
  #undef PK8
  #undef PV8
  #undef HALFA
  #undef PIN
  #undef MX3
  #undef EX
  #undef KRD
  #undef DMA_STEP
  #undef STEP
  #undef ENDW
  if constexpr(MODE==1){ if(hi==0)wsf[32+r32]=__builtin_amdgcn_exp2f(sink2-mhat); asm volatile("s_waitcnt lgkmcnt(0)":::"memory");
    _Pragma("unroll") for(int r=0;r<16;++r)o2[r]+=wsf[32+crow(r,hi)]; }
  float rli[16];
  #pragma unroll
  for(int r=0;r<16;++r)rli[r]=__builtin_amdgcn_rcpf(o2[r]);
  bf16*Ow=Ou+(long)(wid*QBLK)*OP;
  { bf16*stg=(bf16*)(shm+LDS_OST)+wid*2048;
    #pragma unroll
    for(int r=0;r<16;++r){const int orow=crow(r,hi);
      #pragma unroll
      for(int d0=0;d0<2;++d0)stg[orow*64+d0*32+r32]=__float2bfloat16(o[d0][r]*rli[r]);}
    asm volatile("s_waitcnt lgkmcnt(0)":::"memory");
    #pragma unroll
    for(int i=0;i<4;++i){const int row=i*8+(lane>>3),ch=lane&7; const u32x4 v=*(const u32x4*)(stg+row*64+ch*8); ATTN_STORE16(Ow+(long)row*OP+ch*8,v);} }
  asm volatile("s_waitcnt lgkmcnt(0)\n\ts_barrier":::"memory");
  #undef DMA_K
  #undef DMA_V
  #undef DMA_P
  #undef CMASK
  #undef START
  #undef RESC
  #undef ROT
}
constexpr int ATTN_LDS_BYTES=LDS_BYTES;
#undef SBAR
#undef WAIT_BAR
#undef WAIT_BAR2W
#undef QK8
}
#define GAS __attribute__((address_space(1)))
#define LAS __attribute__((address_space(3)))
typedef unsigned short bf16;
typedef unsigned v4u __attribute__((ext_vector_type(4)));
typedef float f32x4 __attribute__((ext_vector_type(4)));
typedef short bf16x8 __attribute__((ext_vector_type(8)));
typedef GAS unsigned gu32;
typedef GAS unsigned long long gu64;
#define RLX_AGENT __ATOMIC_RELAXED, __HIP_MEMORY_SCOPE_AGENT
#define LDS_WAIT() asm volatile("s_waitcnt lgkmcnt(0)" ::: "memory")
#define VM_WAIT() asm volatile("s_waitcnt vmcnt(0)" ::: "memory")
__device__ __forceinline__ unsigned long long rt() { return __builtin_amdgcn_s_memrealtime(); }
__device__ __forceinline__ unsigned f2bf(float f) { unsigned u = __builtin_bit_cast(unsigned, f); return (u + 0x7fffu + ((u >> 16) & 1u)) >> 16; }
__device__ __forceinline__ unsigned pk2(float lo, float hi) { return f2bf(lo) | (f2bf(hi) << 16); }

#define XB_TMO      128
#define XB_XCNT(j)  (256  + 64 * (j))
#define XB_XSUB(j)  (1280 + 64 * (j))
#define XB_XGEN(j)  (2304 + 64 * (j))
#define XB_TOP      3328
#define XB_TOPGEN   3392
#define XCD_BAR_WORDS 3456
#define XB_SPIN_CAP (1u << 18)

__device__ __forceinline__ unsigned xb_ld(unsigned* p)              { return __hip_atomic_load(p, __ATOMIC_RELAXED, __HIP_MEMORY_SCOPE_AGENT); }
__device__ __forceinline__ unsigned xb_add(unsigned* p, unsigned v) { return __hip_atomic_fetch_add(p, v, __ATOMIC_RELAXED, __HIP_MEMORY_SCOPE_AGENT); }
__device__ __forceinline__ unsigned xb_xcc_id() { return (unsigned)__builtin_amdgcn_s_getreg((3 << 11) | 20) & 0xFu; }
#define XB_SPIN(cond, bar) do { unsigned _sp = 0; while (cond) { __builtin_amdgcn_s_sleep(1); \
    if ((++_sp & 255u) == 0u) { if (xb_ld(&(bar)[XB_TMO])) break; if (_sp > XB_SPIN_CAP) { atomicAdd(&(bar)[XB_TMO], 1u); break; } } } } while (0)

struct XcdBarrier {
    unsigned* bar; unsigned x;
    volatile LAS unsigned* st;
};

__device__ __forceinline__ XcdBarrier xcd_barrier_post(unsigned* bar, volatile LAS unsigned* st) {
    XcdBarrier b; b.bar = bar; b.x = xb_xcc_id(); b.st = st;
    if (threadIdx.x == 0) (void)xb_add(&bar[XB_XCNT(b.x)], 1u);
    return b;
}
__device__ __forceinline__ void xcd_barrier_complete(unsigned* bar, unsigned x, unsigned& nloc, unsigned& nx) {
    const unsigned G = gridDim.x * gridDim.y * gridDim.z;
    unsigned sum, cnt, mine, sp = 0u;
    for (;;) {
        sum = 0u; cnt = 0u; mine = 0u;
#pragma unroll
        for (unsigned j = 0; j < 16; ++j) { const unsigned c = xb_ld(&bar[XB_XCNT(j)]); sum += c; cnt += (c > 0u) ? 1u : 0u; mine = (j == x) ? c : mine; }
        if (sum == G) break;
        __builtin_amdgcn_s_sleep(1);
        if ((++sp & 255u) == 0u) { if (xb_ld(&bar[XB_TMO])) break; if (sp > XB_SPIN_CAP) { atomicAdd(&bar[XB_TMO], 1u); break; } }
    }
    nloc = mine > 0u ? mine : 1u; nx = cnt > 0u ? cnt : 1u;
}

__device__ __forceinline__ void xcd_barrier(const XcdBarrier& b) {
    asm volatile("s_waitcnt vmcnt(0)" ::: "memory");
    __syncthreads();
    if (threadIdx.x == 0) {
        unsigned* bar = b.bar;
        __builtin_amdgcn_s_waitcnt(0);
        unsigned nloc = b.st[0], nx = b.st[1];
        if (nloc == 0u) { xcd_barrier_complete(bar, b.x, nloc, nx); b.st[0] = nloc; b.st[1] = nx; }
        const unsigned old = xb_add(&bar[XB_XSUB(b.x)], 1u);
        const unsigned gen = old / nloc;
        if (old + 1u == (gen + 1u) * nloc) {
            __builtin_amdgcn_fence(__ATOMIC_RELEASE, "agent");
            asm volatile("s_waitcnt vmcnt(0)" ::: "memory");
            const unsigned og = xb_add(&bar[XB_TOP], 1u);
            const unsigned tg = og / nx;
            if (og + 1u == (tg + 1u) * nx) xb_add(&bar[XB_TOPGEN], 1u);
            else XB_SPIN(xb_ld(&bar[XB_TOPGEN]) == tg, bar);
            __builtin_amdgcn_fence(__ATOMIC_ACQUIRE, "agent");
            xb_add(&bar[XB_XGEN(b.x)], 1u);
            asm volatile("s_waitcnt vmcnt(0)" ::: "memory");
        } else {
            XB_SPIN(xb_ld(&bar[XB_XGEN(b.x)]) == gen, bar);
            __builtin_amdgcn_fence(__ATOMIC_ACQUIRE, "agent");
            asm volatile("s_waitcnt vmcnt(0)" ::: "memory");
        }
    }
    __syncthreads();
}

constexpr int NWAVES = 8;
#ifndef MK_N_LAUNCHES
#define MK_N_LAUNCHES 1
#endif

constexpr int DM = 2048, INW = 4096, FF = 8192, DEPTH = 2;
constexpr int SP = 16384, SS = 2048;
constexpr int MP = 2 * SP, MS = 4 * SS, M = MP + MS;
constexpr int NCHUNK = 5, MC = M / NCHUNK;
constexpr int N_PHASES = 1 + DEPTH * (5 + (NCHUNK + 1) + 1);
constexpr float RMS_EPS = 1e-6f, LN_EPS = 1e-5f, LOG2E = 1.4426950408889634f;
constexpr int ZW = 3072, ZA_B = 0, Z_P = 512, ZB_Q = 1024, ZB_K = 1536, ZB_V = 1664, ZC_Q = 1792, ZC_K = 2304, ZC_V = 2432, Z_U = 2560;
constexpr int Y_A = 0, Y_B = 512, Y_C = 1024, Y_D = 1536;
static_assert(attn_body::ZP == ZW && attn_body::OP == DM, "attention body pitches");

constexpr size_t MiB = 1u << 20;
constexpr size_t WS_CTL = 0, CTL_ZERO_BYTES = 1 * MiB;
constexpr size_t WS_W = 2 * MiB, W_LAYER = 88 * MiB;
constexpr size_t WO_IN = 0, WO_OUT = 16 * MiB, WO_F1 = 24 * MiB, WO_F2 = 56 * MiB;
constexpr size_t WS_Z = WS_W + DEPTH * W_LAYER;
constexpr size_t WS_Y = WS_Z + (size_t)M * INW * 2;
constexpr size_t WS_U1 = WS_Z + (size_t)M * DM * 2;
static_assert(WS_U1 + (size_t)MC * FF * 2 <= WS_Y, "U1 fits above YP inside the z region");
constexpr size_t WS_H = WS_Y + (size_t)M * DM * 2;
constexpr size_t WS_RS = 1 * MiB;
constexpr size_t WS_KT = WS_H + (size_t)M * DM * 2;
constexpr size_t KV_IMG = (size_t)4 * (M / 64) * 8192;
constexpr size_t WS_VT = WS_KT + KV_IMG;
constexpr size_t WS_END = WS_VT + KV_IMG;
static_assert((size_t)MC * FF * 2 <= (size_t)M * DM * 2, "U chunk fits in the y region");
constexpr int CW_ATT = 8192;
constexpr int CW_BAR = 4096;

constexpr int RING_OFF = 0, RING_BYTES = 131072;
constexpr int LDSCTL_OFF = RING_BYTES, MISC_OFF = LDSCTL_OFF + 320;
constexpr int LDS_BYTES = 147456;
static_assert(MISC_OFF + 128 <= LDS_BYTES && attn_body::ATTN_LDS_BYTES <= RING_BYTES, "LDS map");

typedef unsigned u32x2 __attribute__((ext_vector_type(2)));
struct Frame {
    LAS unsigned char* lds;
    volatile LAS unsigned* MISC;
    int tid, lane, wave;
    int vcu, G;
    __device__ __forceinline__ const float* in(int i) const { asm volatile("" : "+s"(i)); return ((const float* const __attribute__((address_space(4)))*)__builtin_amdgcn_kernarg_segment_ptr())[i]; }
    __device__ __forceinline__ const float* xp() const { return in(0); }
    __device__ __forceinline__ const float* xs() const { return in(1); }
    __device__ __forceinline__ const float* pre_mix_g() const { return in(2); }
    __device__ __forceinline__ const float* w_in() const { return in(3); }
    __device__ __forceinline__ const float* conv_a_w() const { return in(4); }
    __device__ __forceinline__ const float* q_norm_g() const { return in(5); }
    __device__ __forceinline__ const float* k_norm_g() const { return in(6); }
    __device__ __forceinline__ const float* sink_c() const { return in(7); }
    __device__ __forceinline__ const float* conv_d_w() const { return in(8); }
    __device__ __forceinline__ const float* conv_d_b() const { return in(9); }
    __device__ __forceinline__ const float* ln_d_g() const { return in(10); }
    __device__ __forceinline__ const float* ln_d_b() const { return in(11); }
    __device__ __forceinline__ const float* w_out() const { return in(12); }
    __device__ __forceinline__ const float* post_mix_g() const { return in(13); }
    __device__ __forceinline__ const float* pre_ffn_g() const { return in(14); }
    __device__ __forceinline__ const float* w_ff1() const { return in(15); }
    __device__ __forceinline__ const float* w_ff2() const { return in(16); }
    __device__ __forceinline__ const float* post_ffn_g() const { return in(17); }
    float* out;
    unsigned char* ws;
    __device__ __forceinline__ bf16* Z() const { return (bf16*)(ws + WS_Z); }
    __device__ __forceinline__ bf16* Y() const { return (bf16*)(ws + WS_Y); }
    __device__ __forceinline__ bf16* H() const { return (bf16*)(ws + WS_H); }
    __device__ __forceinline__ float* RS() const { return (float*)(ws + WS_RS); }
    __device__ __forceinline__ char* KT() const { return (char*)(ws + WS_KT); }
    __device__ __forceinline__ char* VT() const { return (char*)(ws + WS_VT); }
    __device__ __forceinline__ gu32* ctl() const { return (gu32*)(ws + WS_CTL); }
};
__device__ __forceinline__ bf16* wt_ptr(Frame& F, int l, size_t off) { return (bf16*)(F.ws + WS_W + (size_t)l * W_LAYER + off); }

__device__ __forceinline__ float wave_sum(float v) {
#pragma unroll
    for (int o = 1; o < 64; o <<= 1) v += __shfl_xor(v, o);
    return v;
}
__device__ __forceinline__ unsigned cvtpk(float lo, float hi) { typedef float f2 __attribute__((ext_vector_type(2))); typedef __bf16 b2 __attribute__((ext_vector_type(2))); f2 v = {lo, hi}; b2 b = __builtin_convertvector(v, b2); return __builtin_bit_cast(unsigned, b); }
__device__ __forceinline__ float bflo(unsigned w) { return __uint_as_float(w << 16); }
__device__ __forceinline__ float bfhi(unsigned w) { return __uint_as_float(w & 0xffff0000u); }
__device__ __forceinline__ float sigmoidf_(float x) { return __builtin_amdgcn_rcpf(1.0f + __expf(-x)); }
__device__ __forceinline__ int win_dst_row(int ns) {
    if (ns >= 512 && ns < 1536) { const int v = ns >= 1024, r = ns - (v ? 1024 : 512); return 512 + 256 * (r >> 7) + 128 * v + (r & 127); }
    if (ns >= 3072) { const int v = ns >= 3584, r = ns - (v ? 3584 : 3072); return 3072 + 256 * (r >> 7) + 128 * v + (r & 127); }
    return ns;
}
template <bool WIN_ORDER>
__device__ __forceinline__ void p0_transpose_item(const float* W, int K, int N, bf16* WT, LAS unsigned char* scr, int item, int lane, const float* gk) {
    const int nblk = N / 64, kb = item / nblk, nb = item % nblk, k0 = 64 * kb, n0 = 64 * nb;
    const int sub = lane >> 4, nq = 4 * (lane & 15);
    f32x4 v[16]; float g[16];
#pragma unroll
    for (int i = 0; i < 16; ++i) v[i] = __builtin_nontemporal_load((const GAS f32x4*)(W + (size_t)(k0 + 4 * i + sub) * N + n0 + nq));
#pragma unroll
    for (int i = 0; i < 16; ++i) g[i] = gk ? gk[k0 + 4 * i + sub] : 1.0f;
#pragma unroll
    for (int i = 0; i < 16; ++i) { const int k = 4 * i + sub; const f32x4 x = v[i] * g[i]; const unsigned w01 = cvtpk(x.x, x.y), w23 = cvtpk(x.z, x.w);
        LAS unsigned short* t = (LAS unsigned short*)(scr + nq * 132 + 2 * k);
        t[0] = (unsigned short)w01; t[66] = (unsigned short)(w01 >> 16); t[132] = (unsigned short)w23; t[198] = (unsigned short)(w23 >> 16); }
    LDS_WAIT(); asm volatile("" ::: "memory");
    const int rbase = WIN_ORDER ? win_dst_row(n0) : n0, r16 = lane >> 2, cg = lane & 3;
#pragma unroll
    for (int j = 0; j < 8; ++j) { const int rbi = j >> 1, cbi = j & 1, p = 16 * rbi + r16, n = (p & ~31) + pg8::perm32(p & 31);
        const LAS unsigned* r = (const LAS unsigned*)(scr + n * 132 + (32 * cbi + 8 * cg) * 2);
        v4u o; o.x = r[0]; o.y = r[1]; o.z = r[2]; o.w = r[3];
        *(GAS v4u*)((char*)WT + pg8::tiled_off(rbase + p, k0 + 32 * cbi + 8 * cg, K)) = o; }
    LDS_WAIT(); asm volatile("" ::: "memory");
}
__device__ __forceinline__ const float* xin_row(Frame& F, int m) { return m < MP ? F.xp() + (size_t)m * DM : F.xs() + (size_t)(m - MP) * DM; }

__device__ __forceinline__ void p0_prologue(Frame& F) {
    LAS unsigned char* scr = F.lds + RING_OFF + F.wave * 16384;
    const int gw = F.vcu * NWAVES + F.wave, NGW = F.G * NWAVES;
    constexpr int I_IN = (DM / 64) * (INW / 64), I_OUT = (DM / 64) * (DM / 64), I_F1 = (DM / 64) * (FF / 64), I_F2 = (FF / 64) * (DM / 64), I_L = I_IN + I_OUT + I_F1 + I_F2;
    for (int it = gw; it < DEPTH * I_L; it += NGW) {
        const int l = it / I_L; int r = it % I_L;
        if (r < I_IN) { p0_transpose_item<true>(F.w_in() + (size_t)l * DM * INW, DM, INW, wt_ptr(F, l, WO_IN), scr, r, F.lane, F.pre_mix_g() + l * DM); continue; } r -= I_IN;
        if (r < I_OUT) { p0_transpose_item<false>(F.w_out() + (size_t)l * DM * DM, DM, DM, wt_ptr(F, l, WO_OUT), scr, r, F.lane, nullptr); continue; } r -= I_OUT;
        if (r < I_F1) { p0_transpose_item<false>(F.w_ff1() + (size_t)l * DM * FF, DM, FF, wt_ptr(F, l, WO_F1), scr, r, F.lane, F.pre_ffn_g() + l * DM); continue; } r -= I_F1;
        p0_transpose_item<false>(F.w_ff2() + (size_t)l * FF * DM, FF, DM, wt_ptr(F, l, WO_F2), scr, r, F.lane, nullptr);
    }
    for (int mb = gw; mb < M; mb += 4 * NGW) {
        f32x4 x[4][4][2];
#pragma unroll
        for (int k = 0; k < 4; ++k) { const int m = mb + k * NGW; if (m < M) { const float* xr = xin_row(F, m);
#pragma unroll
            for (int j = 0; j < 4; ++j) { x[k][j][0] = __builtin_nontemporal_load((const GAS f32x4*)(xr + j * 512 + F.lane * 8)); x[k][j][1] = __builtin_nontemporal_load((const GAS f32x4*)(xr + j * 512 + F.lane * 8 + 4)); } } }
#pragma unroll
        for (int k = 0; k < 4; ++k) { const int m = mb + k * NGW; if (m < M) { float ss = 0.f;
#pragma unroll
            for (int j = 0; j < 4; ++j) { const f32x4 a = x[k][j][0], b = x[k][j][1]; ss += (a.x * a.x + a.y * a.y) + (a.z * a.z + a.w * a.w) + (b.x * b.x + b.y * b.y) + (b.z * b.z + b.w * b.w);
                v4u o; o.x = cvtpk(a.x, a.y); o.y = cvtpk(a.z, a.w); o.z = cvtpk(b.x, b.y); o.w = cvtpk(b.z, b.w);
                *(GAS v4u*)(F.H() + (size_t)m * DM + j * 512 + F.lane * 8) = o; }
            const float r = rsqrtf(wave_sum(ss) * (1.0f / DM) + RMS_EPS);
            if (F.lane == 0) F.RS()[m] = r; } }
    }
}

template <bool FINAL, bool FIRSTX>
__device__ __forceinline__ void norm_pass(Frame& F, const bf16* YPb, const float* gpost) {
    constexpr int R = FIRSTX ? 2 : 4;
    const int gw = F.vcu * NWAVES + F.wave, NGW = F.G * NWAVES;
    f32x4 ga[4][2];
#pragma unroll
    for (int j = 0; j < 4; ++j) { ga[j][0] = *(const GAS f32x4*)(gpost + j * 512 + F.lane * 8); ga[j][1] = *(const GAS f32x4*)(gpost + j * 512 + F.lane * 8 + 4); }
    for (int mb = gw; mb < M; mb += R * NGW) {
        v4u y[R][4]; v4u xb[R][4]; f32x4 xf[FIRSTX ? R : 1][4][2];
#pragma unroll
        for (int k = 0; k < R; ++k) { const int m = mb + k * NGW; if (m < M) {
#pragma unroll
            for (int j = 0; j < 4; ++j) y[k][j] = __builtin_nontemporal_load((const GAS v4u*)(YPb + (size_t)m * DM + j * 512 + F.lane * 8));
            if constexpr (FIRSTX) { const float* xr = xin_row(F, m);
#pragma unroll
                for (int j = 0; j < 4; ++j) { xf[k][j][0] = __builtin_nontemporal_load((const GAS f32x4*)(xr + j * 512 + F.lane * 8)); xf[k][j][1] = __builtin_nontemporal_load((const GAS f32x4*)(xr + j * 512 + F.lane * 8 + 4)); }
            } else {
#pragma unroll
                for (int j = 0; j < 4; ++j) xb[k][j] = __builtin_nontemporal_load((const GAS v4u*)(F.H() + (size_t)m * DM + j * 512 + F.lane * 8));
            } } }
#pragma unroll
        for (int k = 0; k < R; ++k) { const int m = mb + k * NGW; if (m < M) {
            float ss = 0.f;
#pragma unroll
            for (int j = 0; j < 4; ++j) { const v4u w = y[k][j]; const float a0 = bflo(w.x), a1 = bfhi(w.x), a2 = bflo(w.y), a3 = bfhi(w.y), a4 = bflo(w.z), a5 = bfhi(w.z), a6 = bflo(w.w), a7 = bfhi(w.w);
                ss += (a0 * a0 + a1 * a1) + (a2 * a2 + a3 * a3) + (a4 * a4 + a5 * a5) + (a6 * a6 + a7 * a7); }
            const float r = rsqrtf(wave_sum(ss) * (1.0f / DM) + RMS_EPS);
            float s2 = 0.f;
#pragma unroll
            for (int j = 0; j < 4; ++j) { const v4u w = y[k][j];
                const f32x4 y0 = (f32x4){bflo(w.x), bfhi(w.x), bflo(w.y), bfhi(w.y)}, y1 = (f32x4){bflo(w.z), bfhi(w.z), bflo(w.w), bfhi(w.w)};
                f32x4 x0, x1;
                if constexpr (FIRSTX) { x0 = xf[k][j][0]; x1 = xf[k][j][1]; }
                else { const v4u q = xb[k][j]; x0 = (f32x4){bflo(q.x), bfhi(q.x), bflo(q.y), bfhi(q.y)}; x1 = (f32x4){bflo(q.z), bfhi(q.z), bflo(q.w), bfhi(q.w)}; }
                const f32x4 v0 = x0 + y0 * r * ga[j][0], v1 = x1 + y1 * r * ga[j][1];
                if constexpr (FINAL) { __builtin_nontemporal_store(v0, (GAS f32x4*)(F.out + (size_t)m * DM + j * 512 + F.lane * 8)); __builtin_nontemporal_store(v1, (GAS f32x4*)(F.out + (size_t)m * DM + j * 512 + F.lane * 8 + 4)); }
                else { s2 += (v0.x * v0.x + v0.y * v0.y) + (v0.z * v0.z + v0.w * v0.w) + (v1.x * v1.x + v1.y * v1.y) + (v1.z * v1.z + v1.w * v1.w);
                    v4u o; o.x = cvtpk(v0.x, v0.y); o.y = cvtpk(v0.z, v0.w); o.z = cvtpk(v1.x, v1.y); o.w = cvtpk(v1.z, v1.w);
                    *(GAS v4u*)(F.H() + (size_t)m * DM + j * 512 + F.lane * 8) = o; } }
            if constexpr (!FINAL) { const float r2 = rsqrtf(wave_sum(s2) * (1.0f / DM) + RMS_EPS); if (F.lane == 0) F.RS()[m] = r2; }
        } }
    }
}

constexpr int PREP_T = 32, PREP_U_ROWS = PREP_T + 30, PREP_TW = PREP_T / NWAVES;
constexpr int PREP_V_OFF = PREP_U_ROWS * 512 * 2;
static_assert(PREP_V_OFF % 16 == 0 && PREP_V_OFF + PREP_T * 512 * 4 <= RING_BYTES, "prep LDS");
__device__ __forceinline__ void rope_store4(bf16* p1, bf16* p2, const float (&a)[4], const float (&b)[4], const float (&c)[4], const float (&s)[4], float scale, bool pred) {
    float o1[4], o2[4];
#pragma unroll
    for (int k = 0; k < 4; ++k) { o1[k] = (a[k] * c[k] - b[k] * s[k]) * scale; o2[k] = (b[k] * c[k] + a[k] * s[k]) * scale; }
    if (pred) { u32x2 w1, w2; w1.x = cvtpk(o1[0], o1[1]); w1.y = cvtpk(o1[2], o1[3]); w2.x = cvtpk(o2[0], o2[1]); w2.y = cvtpk(o2[2], o2[3]);
        *(GAS u32x2*)p1 = w1; *(GAS u32x2*)p2 = w2; }
}
__device__ __forceinline__ void load4x2(const bf16* p1, const bf16* p2, float (&a)[4], float (&b)[4]) {
    const u32x2 w1 = *(const GAS u32x2*)p1, w2 = *(const GAS u32x2*)p2;
    a[0] = bflo(w1.x); a[1] = bfhi(w1.x); a[2] = bflo(w1.y); a[3] = bfhi(w1.y); b[0] = bflo(w2.x); b[1] = bfhi(w2.x); b[2] = bflo(w2.y); b[3] = bfhi(w2.y);
}
__device__ __forceinline__ void unpack8(const v4u w, float (&f)[8]) { f[0] = bflo(w.x); f[1] = bfhi(w.x); f[2] = bflo(w.y); f[3] = bfhi(w.y); f[4] = bflo(w.z); f[5] = bfhi(w.z); f[6] = bflo(w.w); f[7] = bfhi(w.w); }

__device__ __forceinline__ void prep_phase(Frame& F, const int l) {
    LAS bf16* Ub = (LAS bf16*)(F.lds + RING_OFF);
    LAS float* V = (LAS float*)(F.lds + RING_OFF + PREP_V_OFF);
    const int lane = F.lane, tid = F.tid, wave = F.wave;
    const float* cdw = F.conv_d_w() + (size_t)l * 31 * 512;
    float wd[31];
#pragma unroll
    for (int j = 0; j < 31; ++j) wd[j] = cdw[j * 512 + tid];
    const float cdb = F.conv_d_b()[l * 512 + tid];
    const float* caw = F.conv_a_w() + (size_t)l * 3 * 512;
    const float* gk = F.k_norm_g() + l * 64;
    const int c0 = lane * 8;
    f32x4 wa[3][2];
#pragma unroll
    for (int j = 0; j < 3; ++j) { wa[j][0] = *(const GAS f32x4*)(caw + j * 512 + c0); wa[j][1] = *(const GAS f32x4*)(caw + j * 512 + c0 + 4); }
    const f32x4 g0 = *(const GAS f32x4*)(F.ln_d_g() + l * 512 + c0), g1 = *(const GAS f32x4*)(F.ln_d_g() + l * 512 + c0 + 4), b0 = *(const GAS f32x4*)(F.ln_d_b() + l * 512 + c0), b1 = *(const GAS f32x4*)(F.ln_d_b() + l * 512 + c0 + 4);
    constexpr int NST = (PREP_U_ROWS * 64 + 511) / 512;
    for (int item = F.vcu; item < M / PREP_T; item += F.G) {
        const int m0 = item * PREP_T;
        int t0, S; if (m0 < MP) { t0 = m0 & (SP - 1); S = SP; } else { t0 = (m0 - MP) & (SS - 1); S = SS; }
        v4u stg[NST];
#pragma unroll
        for (int it = 0; it < NST; ++it) { const int id = it * 512 + tid, rr = id >> 6, ch = (id & 63) * 8, tp = t0 - 15 + rr;
            stg[it] = (v4u){0u, 0u, 0u, 0u};
            if (id < PREP_U_ROWS * 64 && tp >= 0 && tp < S) stg[it] = *(const GAS v4u*)(F.Z() + (size_t)(m0 - 15 + rr) * ZW + Z_U + ch); }
        const int ta = t0 + PREP_TW * wave, ma = m0 + PREP_TW * wave;
        v4u pr[PREP_TW + 2], ab[PREP_TW];
#pragma unroll
        for (int j = 0; j < PREP_TW + 2; ++j) { const int tp = ta + j - 1; pr[j] = (v4u){0u, 0u, 0u, 0u};
            if (tp >= 0 && tp < S) pr[j] = *(const GAS v4u*)(F.Z() + (size_t)(ma + j - 1) * ZW + Z_P + c0); }
#pragma unroll
        for (int j = 0; j < PREP_TW; ++j) ab[j] = *(const GAS v4u*)(F.Z() + (size_t)(ma + j) * ZW + ZA_B + c0);
        const int grp = lane >> 5, hk = (lane >> 3) & 1, sl = lane & 7, half = sl >> 2;
        const int i0 = grp ? 4 * sl : 4 * (sl & 3);
        const int koff = grp ? (ZC_K + hk * 64 + i0) : (ZB_K + hk * 64 + half * 32 + i0), kd = grp ? 32 : 16;
        u32x2 kw[PREP_TW / 2][2];
#pragma unroll
        for (int q = 0; q < PREP_TW / 2; ++q) { const bf16* p1 = F.Z() + (size_t)(ma + 2 * q + ((lane >> 4) & 1)) * ZW + koff; kw[q][0] = *(const GAS u32x2*)p1; kw[q][1] = *(const GAS u32x2*)(p1 + kd); }
        unsigned vld[2][4];
#pragma unroll
        for (int it = 0; it < 2; ++it) { const int id = it * 512 + tid, qd = id >> 7, cb = (id >> 5) & 3, dp = id & 31;
#pragma unroll
            for (int j = 0; j < 4; ++j) vld[it][j] = *(const GAS unsigned*)(F.Z() + (size_t)(m0 + 4 * qd + j) * ZW + ((cb >> 1) ? ZC_V : ZB_V) + (cb & 1) * 64 + 2 * dp); }
#pragma unroll
        for (int it = 0; it < NST; ++it) { const int id = it * 512 + tid, rr = id >> 6, ch = (id & 63) * 8;
            if (id < PREP_U_ROWS * 64) *(LAS v4u*)(Ub + rr * 512 + ch) = stg[it]; }
#pragma unroll
        for (int it = 0; it < 2; ++it) { const int id = it * 512 + tid, qd = id >> 7, cb = (id >> 5) & 3, dp = id & 31;
            int w0 = 0, w1 = 0;
            w0 = __builtin_amdgcn_cvt_pk_fp8_f32(bflo(vld[it][0]), bflo(vld[it][1]), w0, false); w0 = __builtin_amdgcn_cvt_pk_fp8_f32(bflo(vld[it][2]), bflo(vld[it][3]), w0, true);
            w1 = __builtin_amdgcn_cvt_pk_fp8_f32(bfhi(vld[it][0]), bfhi(vld[it][1]), w1, false); w1 = __builtin_amdgcn_cvt_pk_fp8_f32(bfhi(vld[it][2]), bfhi(vld[it][3]), w1, true);
            char* vt = F.VT() + ((size_t)(cb * (M / 64) + (m0 >> 6)) << 12) + (qd & 1) * 2048 + ((m0 >> 5) & 1) * 1024 + 4 * (qd >> 1);
            *(GAS int*)(vt + (2 * dp) * 16) = w0; *(GAS int*)(vt + (2 * dp + 1) * 16) = w1; }
#pragma unroll
        for (int q = 0; q < PREP_TW; ++q) { float acc[8], bb[8];
#pragma unroll
            for (int k = 0; k < 8; ++k) acc[k] = 0.f;
#pragma unroll
            for (int j = 0; j < 3; ++j) { float pp[8]; unpack8(pr[q + j], pp);
                acc[0] += wa[j][0].x * pp[0]; acc[1] += wa[j][0].y * pp[1]; acc[2] += wa[j][0].z * pp[2]; acc[3] += wa[j][0].w * pp[3];
                acc[4] += wa[j][1].x * pp[4]; acc[5] += wa[j][1].y * pp[5]; acc[6] += wa[j][1].z * pp[6]; acc[7] += wa[j][1].w * pp[7]; }
            unpack8(ab[q], bb);
            v4u o; o.x = cvtpk(bb[0] * acc[0], bb[1] * acc[1]); o.y = cvtpk(bb[2] * acc[2], bb[3] * acc[3]); o.z = cvtpk(bb[4] * acc[4], bb[5] * acc[5]); o.w = cvtpk(bb[6] * acc[6], bb[7] * acc[7]);
            *(GAS v4u*)(F.Y() + (size_t)(ma + q) * DM + Y_A + c0) = o; }
#pragma unroll
        for (int q = 0; q < PREP_TW / 2; ++q) {
            const int tk = PREP_TW * wave + 2 * q + ((lane >> 4) & 1), tpos = t0 + tk;
            const int pos = grp ? tpos : (half ? (tpos & 63) : (tpos >> 6));
            const int mr = m0 + tk, f1 = grp ? i0 : half * 32 + i0, f2 = f1 + kd;
            char* kt = F.KT() + ((size_t)((grp * 2 + hk) * (M / 64) + (mr >> 6)) << 12) + (mr & 63) * 16;
            int* p1 = (int*)(kt + ((f1 >> 3) & 1) * 2048 + (f1 >> 5) * 1024 + ((f1 >> 4) & 1) * 8 + (f1 & 7)); int* p2 = (int*)(kt + ((f2 >> 3) & 1) * 2048 + (f2 >> 5) * 1024 + ((f2 >> 4) & 1) * 8 + (f2 & 7));
            float cs[4], sn[4];
#pragma unroll
            for (int k = 0; k < 4; ++k) sincos_f((float)pos * INVF[grp ? (i0 + k) : 2 * (i0 + k)], sn[k], cs[k]);
            float a[4], b[4];
            a[0] = bflo(kw[q][0].x); a[1] = bfhi(kw[q][0].x); a[2] = bflo(kw[q][0].y); a[3] = bfhi(kw[q][0].y); b[0] = bflo(kw[q][1].x); b[1] = bfhi(kw[q][1].x); b[2] = bflo(kw[q][1].y); b[3] = bfhi(kw[q][1].y);
            float ss = (a[0] * a[0] + a[1] * a[1]) + (a[2] * a[2] + a[3] * a[3]) + (b[0] * b[0] + b[1] * b[1]) + (b[2] * b[2] + b[3] * b[3]);
            ss += __shfl_xor(ss, 1); ss += __shfl_xor(ss, 2); ss += __shfl_xor(ss, 4);
            const float r = grp ? 1.0f : rsqrtf(ss * (1.0f / 64.0f) + RMS_EPS);
#pragma unroll
            for (int k = 0; k < 4; ++k) { const int gi = grp ? 0 : (half * 32 + i0);
                const float g1k = grp ? 1.0f : gk[gi + k], g2k = grp ? 1.0f : gk[gi + 16 + k]; a[k] = a[k] * r * g1k; b[k] = b[k] * r * g2k; }
            {   float o1[4], o2[4];
#pragma unroll
                for (int k = 0; k < 4; ++k) { o1[k] = a[k] * cs[k] - b[k] * sn[k]; o2[k] = b[k] * cs[k] + a[k] * sn[k]; }
                int w1 = 0, w2 = 0;
                w1 = __builtin_amdgcn_cvt_pk_fp8_f32(o1[0], o1[1], w1, false); w1 = __builtin_amdgcn_cvt_pk_fp8_f32(o1[2], o1[3], w1, true);
                w2 = __builtin_amdgcn_cvt_pk_fp8_f32(o2[0], o2[1], w2, false); w2 = __builtin_amdgcn_cvt_pk_fp8_f32(o2[2], o2[3], w2, true);
                *(GAS int*)p1 = w1; *(GAS int*)p2 = w2; }
        }
        __syncthreads();
        {   float uu[PREP_U_ROWS];
#pragma unroll
            for (int rr = 0; rr < PREP_U_ROWS; ++rr) uu[rr] = __uint_as_float((unsigned)Ub[rr * 512 + tid] << 16);
#pragma unroll
            for (int tt = 0; tt < PREP_T; ++tt) { float a = cdb;
#pragma unroll
                for (int j = 0; j < 31; ++j) a += wd[j] * uu[tt + j];
                V[tt * 512 + tid] = a; } }
        __syncthreads();
        {   f32x4 v0[PREP_TW], v1[PREP_TW]; float sm[PREP_TW];
#pragma unroll
            for (int q = 0; q < PREP_TW; ++q) { const int tt = PREP_TW * wave + q; v0[q] = *(const LAS f32x4*)(V + tt * 512 + c0); v1[q] = *(const LAS f32x4*)(V + tt * 512 + c0 + 4);
                sm[q] = (v0[q].x + v0[q].y) + (v0[q].z + v0[q].w) + (v1[q].x + v1[q].y) + (v1[q].z + v1[q].w); }
#pragma unroll
            for (int o = 1; o < 64; o <<= 1)
#pragma unroll
                for (int q = 0; q < PREP_TW; ++q) sm[q] += __shfl_xor(sm[q], o);
#pragma unroll
            for (int q = 0; q < PREP_TW; ++q) { const float mean = sm[q] * (1.0f / 512.0f); v0[q] = v0[q] - mean; v1[q] = v1[q] - mean;
                sm[q] = (v0[q].x * v0[q].x + v0[q].y * v0[q].y) + (v0[q].z * v0[q].z + v0[q].w * v0[q].w) + (v1[q].x * v1[q].x + v1[q].y * v1[q].y) + (v1[q].z * v1[q].z + v1[q].w * v1[q].w); }
#pragma unroll
            for (int o = 1; o < 64; o <<= 1)
#pragma unroll
                for (int q = 0; q < PREP_TW; ++q) sm[q] += __shfl_xor(sm[q], o);
#pragma unroll
            for (int q = 0; q < PREP_TW; ++q) { const int m = m0 + PREP_TW * wave + q; const float r = rsqrtf(sm[q] * (1.0f / 512.0f) + LN_EPS);
                f32x4 y0 = v0[q] * r * g0 + b0, y1 = v1[q] * r * g1 + b1;
                y0 = (f32x4){y0.x * sigmoidf_(y0.x), y0.y * sigmoidf_(y0.y), y0.z * sigmoidf_(y0.z), y0.w * sigmoidf_(y0.w)};
                y1 = (f32x4){y1.x * sigmoidf_(y1.x), y1.y * sigmoidf_(y1.y), y1.z * sigmoidf_(y1.z), y1.w * sigmoidf_(y1.w)};
                v4u o; o.x = cvtpk(y0.x, y0.y); o.y = cvtpk(y0.z, y0.w); o.z = cvtpk(y1.x, y1.y); o.w = cvtpk(y1.z, y1.w);
                *(GAS v4u*)(F.Y() + (size_t)m * DM + Y_D + c0) = o; } }
        __syncthreads();
    }
}

__device__ __forceinline__ void attn_phase_all(Frame& F, const int l, char* shm) {
    typedef attn_body::bf16 abf;
    const abf* Z = (const abf*)F.Z(); abf* Y = (abf*)F.Y();
    float gqm = __builtin_fabsf(F.q_norm_g()[l * 64 + F.lane]), gkm = __builtin_fabsf(F.k_norm_g()[l * 64 + F.lane]);
#pragma unroll
    for (int o = 1; o < 64; o <<= 1) { gqm = __builtin_fmaxf(gqm, __shfl_xor(gqm, o)); gkm = __builtin_fmaxf(gkm, __shfl_xor(gkm, o)); }
    const int ref0 = __builtin_amdgcn_readfirstlane((int)__builtin_ceilf(__builtin_fminf(__builtin_fmaxf((8.0f * LOG2E) * gqm * gkm - 15.5f, 0.f), 100.f)));
    const bool fast = ref0 <= 6;
    const float pscale = PSCALE_EXPR;
    LAS int* const tkw = (LAS int*)(F.lds + LDSCTL_OFF + 64);
    unsigned* const ctrA = (unsigned*)(F.ctl() + CW_ATT + l * 128), * const ctrB = ctrA + 64;
#define ATT_BCAST(dst, v) do { if (F.tid == 0) *tkw = (v); asm volatile("s_waitcnt lgkmcnt(0)\n\ts_barrier" ::: "memory"); { const int r_ = *tkw; asm volatile("s_waitcnt lgkmcnt(0)\n\ts_barrier" ::: "memory"); (dst) = __builtin_amdgcn_readfirstlane(r_); } } while (0)
    {   int i = 0, tkt = -1;
        for (;;) {
            int idx;
            if (tkt < 0) { idx = i * F.G + F.vcu; ++i; if (idx >= 1024) { int t0 = 0; if (F.tid == 0) t0 = (int)__hip_atomic_fetch_add(ctrA, 1u, __ATOMIC_RELAXED, __HIP_MEMORY_SCOPE_AGENT); ATT_BCAST(tkt, t0); continue; } }
            else { if (tkt >= 256) break; idx = 1024 + tkt; }
            int tn = 0; if (tkt >= 0 && F.tid == 0) tn = (int)__hip_atomic_fetch_add(ctrA, 1u, __ATOMIC_RELAXED, __HIP_MEMORY_SCOPE_AGENT);
            const int r = idx >> 8, v = idx & 255, x = v >> 5, j = v & 31;
            int head, kv, qb, NT; long srow;
            if (r < 4) { const int sx = x >> 1; kv = sx & 1; head = kv * 4 + (x & 1) * 2 + (r >> 1); qb = (r & 1) * 32 + j; srow = (long)(sx >> 1) * SP; NT = SP / 64; }
            else { kv = x & 1; head = kv * 4 + (j >> 3); qb = j & 7; srow = (long)MP + (long)(x >> 1) * SS; NT = SS / 64; }
            const long qrow = srow + qb * 256;
            const size_t kvo = ((size_t)(kv * (M / 64)) + (size_t)(srow >> 6)) << 13;
            if (fast) attn_body::attn_unit<2, 8, 1>(Z + qrow * ZW + ZB_Q + head * 64, F.KT() + (kvo >> 1), F.VT() + (kvo >> 1), Y + qrow * DM + Y_B + head * 64, NT, 0, 0, pscale, qb * 256, F.q_norm_g() + l * 64, shm);
            else attn_body::attn_unit<0, 8, 1>(Z + qrow * ZW + ZB_Q + head * 64, F.KT() + (kvo >> 1), F.VT() + (kvo >> 1), Y + qrow * DM + Y_B + head * 64, NT, 0, 0, 0.f, qb * 256, F.q_norm_g() + l * 64, shm);
            if (tkt >= 0) ATT_BCAST(tkt, tn);
        }
    }
    {   int tkt, t0 = 0; if (F.tid == 0) t0 = (int)__hip_atomic_fetch_add(ctrB, 1u, __ATOMIC_RELAXED, __HIP_MEMORY_SCOPE_AGENT); ATT_BCAST(tkt, t0);
        while (tkt < 1280) {
            int tn = 0; if (F.tid == 0) tn = (int)__hip_atomic_fetch_add(ctrB, 1u, __ATOMIC_RELAXED, __HIP_MEMORY_SCOPE_AGENT);
            const int u = tkt, qblk = u >> 3, head = u & 7, kv = head >> 2; const long qrow = (long)qblk * 256;
            long srow; int S; if (qrow < MP) { srow = (qrow / SP) * SP; S = SP; } else { srow = MP + ((qrow - MP) / SS) * SS; S = SS; }
            const int q0 = (int)(qrow - srow);
            const float sink2 = F.sink_c()[l * 8 + head] * LOG2E;
            const size_t kvo = ((size_t)((2 + kv) * (M / 64)) + (size_t)(srow >> 6)) << 13;
            attn_body::attn_unit<1, 8, 2>(Z + qrow * ZW + ZC_Q + head * 64, F.KT() + (kvo >> 1), F.VT() + (kvo >> 1), Y + qrow * DM + Y_C + head * 64, 8, q0, S, sink2, q0, nullptr, shm);
            ATT_BCAST(tkt, tn);
        }
    }
#undef ATT_BCAST
}

struct Args { const float* in[18]; float* out; unsigned char* ws; int ph_lo, ph_hi, li, pad; };
__global__ void __launch_bounds__(NWAVES * 64, 2) fwd(Args args) {
    extern __shared__ __attribute__((aligned(16))) unsigned char lds[];
    Frame F;
    F.lds = (LAS unsigned char*)lds;
    F.MISC = (volatile LAS unsigned*)(F.lds + MISC_OFF);
    F.tid = threadIdx.x; F.lane = F.tid & 63; F.wave = __builtin_amdgcn_readfirstlane(F.tid >> 6);
    F.G = gridDim.x; { const int bx = blockIdx.x; F.vcu = (F.G % 8 == 0) ? (bx % 8) * (F.G / 8) + bx / 8 : bx; }
    unsigned char* ws = args.ws; F.ws = ws;
    F.out = args.out;
    bf16* const YPb = F.Z();
    bf16* const U0 = F.Y();
    bf16* const U1 = (bf16*)(ws + WS_U1);
    for (int u = F.tid; u < (LDS_BYTES - LDSCTL_OFF) / 4; u += NWAVES * 64) ((LAS unsigned*)(F.lds + LDSCTL_OFF))[u] = 0u;
    __syncthreads();
    XcdBarrier bar; bar.bar = (unsigned*)(F.ctl() + CW_BAR); bar.x = 0; bar.st = nullptr;
    if (MK_N_LAUNCHES == 1) bar = xcd_barrier_post((unsigned*)(F.ctl() + CW_BAR), F.MISC + 8);
    const int lo = args.ph_lo, hi = args.ph_hi; int ph = 0;
#define PH_BEGIN if (lo <= ph && ph < hi) { { int t_ = threadIdx.x; asm volatile("" : "+v"(t_)); F.tid = t_; F.lane = t_ & 63; F.wave = __builtin_amdgcn_readfirstlane(t_ >> 6); }
#define PH_END   if (ph + 1 < hi) xcd_barrier(bar); } ++ph;

    PH_BEGIN p0_prologue(F); PH_END

#pragma unroll 1
    for (int l = 0; l < DEPTH; ++l) {
        PH_BEGIN { pg8::Gemm g{F.H(), wt_ptr(F, l, WO_IN), M, INW, DM}; pg8::StaticOrder S; S.init(M, INW, F.G, (int)blockIdx.x);
            pg8::EpiIn E{F.Z(), ZW, F.RS()};
            pg8::gemm_phase<pg8::EpiIn, pg8::StaticOrder, true, true>(F.lds + RING_OFF, g, S, E); } PH_END
        PH_BEGIN prep_phase(F, l); PH_END
        PH_BEGIN attn_phase_all(F, l, (char*)lds + RING_OFF); PH_END
        PH_BEGIN { pg8::Gemm g{F.Y(), wt_ptr(F, l, WO_OUT), M, DM, DM}; pg8::StaticOrder S; S.init(M, DM, F.G, (int)blockIdx.x);
            pg8::EpiBf16<0, false> E{YPb, DM, nullptr};
            pg8::gemm_phase<pg8::EpiBf16<0, false>, pg8::StaticOrder, true, true>(F.lds + RING_OFF, g, S, E); } PH_END
        PH_BEGIN if (l == 0) norm_pass<false, true>(F, YPb, F.post_mix_g() + l * DM); else norm_pass<false, false>(F, YPb, F.post_mix_g() + l * DM); PH_END
        PH_BEGIN { pg8::Gemm g{F.H(), wt_ptr(F, l, WO_F1), MC, FF, DM}; pg8::StaticOrder S; S.init(MC, FF, F.G, (int)blockIdx.x);
            pg8::EpiBf16<2, true, true> E{U0, FF, F.RS()};
            pg8::gemm_phase<pg8::EpiBf16<2, true, true>, pg8::StaticOrder, true, true>(F.lds + RING_OFF, g, S, E); } PH_END
#pragma unroll 1
        for (int c = 0; c + 1 < NCHUNK; ++c) {
            PH_BEGIN {
                bf16* const Ur = (c & 1) ? U1 : U0; bf16* const Uw = (c & 1) ? U0 : U1;
                { pg8::Gemm g{Ur, wt_ptr(F, l, WO_F2), MC, DM, FF}; pg8::StaticOrder S; S.init(MC, DM, F.G, (int)blockIdx.x);
                  pg8::EpiBf16<0, false> E{YPb + (size_t)c * MC * DM, DM, nullptr};
                  pg8::gemm_phase<pg8::EpiBf16<0, false>, pg8::StaticOrder, true, true, true>(F.lds + RING_OFF, g, S, E); }
                __syncthreads();
                { pg8::Gemm g{F.H() + (size_t)(c + 1) * MC * DM, wt_ptr(F, l, WO_F1), MC, FF, DM}; pg8::StaticOrder S; S.init(MC, FF, F.G, (int)blockIdx.x);
                  pg8::EpiBf16<2, true, true> E{Uw, FF, F.RS() + (size_t)(c + 1) * MC};
                  pg8::gemm_phase<pg8::EpiBf16<2, true, true>, pg8::StaticOrder, true, true>(F.lds + RING_OFF, g, S, E); }
            } PH_END
        }
        PH_BEGIN { pg8::Gemm g{((NCHUNK - 1) & 1) ? U1 : U0, wt_ptr(F, l, WO_F2), MC, DM, FF}; pg8::StaticOrder S; S.init(MC, DM, F.G, (int)blockIdx.x);
            pg8::EpiBf16<0, false> E{YPb + (size_t)(NCHUNK - 1) * MC * DM, DM, nullptr};
            pg8::gemm_phase<pg8::EpiBf16<0, false>, pg8::StaticOrder, true, true, true>(F.lds + RING_OFF, g, S, E); } PH_END
        PH_BEGIN if (l + 1 < DEPTH) norm_pass<false, false>(F, YPb, F.post_ffn_g() + l * DM); else norm_pass<true, false>(F, YPb, F.post_ffn_g() + l * DM); PH_END
    }
#undef PH_BEGIN
#undef PH_END
}

extern "C" void kernel_launch(void* const* d_in, const int* in_sizes, int n_in, void* d_out, int out_size, void* d_ws, size_t ws_size, hipStream_t stream) {
    static int grid = 0;
    if (grid == 0) {
        if (n_in != 18 || in_sizes[0] != MP * DM || in_sizes[1] != MS * DM || out_size != M * DM || ws_size < WS_END) {
            fprintf(stderr, "kernel_launch: unexpected shapes (n_in %d, in0 %d, in1 %d, out %d, ws %zu; need ws >= %zu); nothing launched\n", n_in, n_in > 0 ? in_sizes[0] : -1, n_in > 1 ? in_sizes[1] : -1, out_size, ws_size, (size_t)WS_END); grid = -1; return; }
        int dev = 0, cus = 0, per_cu = 0;
        if (hipGetDevice(&dev) != hipSuccess || hipDeviceGetAttribute(&cus, hipDeviceAttributeMultiprocessorCount, dev) != hipSuccess) { fprintf(stderr, "kernel_launch: device query failed\n"); grid = -1; return; }
        if (hipFuncSetAttribute((const void*)fwd, hipFuncAttributeMaxDynamicSharedMemorySize, LDS_BYTES) != hipSuccess) { fprintf(stderr, "kernel_launch: hipFuncSetAttribute failed\n"); grid = -1; return; }
        if (hipOccupancyMaxActiveBlocksPerMultiprocessor(&per_cu, (const void*)fwd, NWAVES * 64, LDS_BYTES) != hipSuccess || per_cu < 1)
            fprintf(stderr, "kernel_launch: note: occupancy query reports %d workgroups per CU\n", per_cu);
        (void)hipGetLastError();
        grid = cus;
    }
    if (grid < 0) return;
    if (hipMemsetAsync((char*)d_ws + WS_CTL, 0, CTL_ZERO_BYTES, stream) != hipSuccess) { fprintf(stderr, "kernel_launch: memset failed\n"); return; }
    Args a{};
    for (int i = 0; i < 18; ++i) a.in[i] = (const float*)d_in[i];
    a.out = (float*)d_out; a.ws = (unsigned char*)d_ws;
    for (int li = 0; li < MK_N_LAUNCHES; ++li) {
        a.ph_lo = (MK_N_LAUNCHES == 1) ? 0 : li; a.ph_hi = (MK_N_LAUNCHES == 1) ? N_PHASES : li + 1; a.li = li; a.pad = 0;
        hipLaunchKernelGGL(fwd, dim3(grid), dim3(NWAVES * 64), LDS_BYTES, stream, a);
        const hipError_t le = hipPeekAtLastError();
        if (le != hipSuccess) { fprintf(stderr, "kernel_launch: launch %d failed: %s\n", li, hipGetErrorName(le)); break; }
    }
}
```

```cpp
#include <hip/hip_runtime.h>
#include <hip/hip_bf16.h>
#include <cstdio>
#include <cstdint>
#include <cmath>
__constant__ float INVF[32] = {
    1.000000000e+00f, 7.498942018e-01f, 5.623413324e-01f, 4.216965139e-01f, 3.162277639e-01f, 2.371373922e-01f, 1.778279394e-01f, 1.333521456e-01f,
    1.000000015e-01f, 7.498941571e-02f, 5.623412877e-02f, 4.216964915e-02f, 3.162277862e-02f, 2.371373586e-02f, 1.778279431e-02f, 1.333521493e-02f,
    9.999999776e-03f, 7.498942316e-03f, 5.623413250e-03f, 4.216964822e-03f, 3.162277862e-03f, 2.371373819e-03f, 1.778279431e-03f, 1.333521446e-03f,
    1.000000047e-03f, 7.498941850e-04f, 5.623413017e-04f, 4.216965463e-04f, 3.162277862e-04f, 2.371373848e-04f, 1.778279402e-04f, 1.333521504e-04f};

__device__ __forceinline__ void sincos_f(float ang, float& s, float& c) {
    const double rev = (double)ang * 0.15915494309189535; const float fr = (float)(rev - __builtin_rint(rev));
    s = __builtin_amdgcn_sinf(fr); c = __builtin_amdgcn_cosf(fr);
}

namespace pg8 {
#define PG8_LAS __attribute__((address_space(3)))
typedef unsigned short bf16_t;
typedef short bf16x8 __attribute__((ext_vector_type(8)));
typedef float f32x4 __attribute__((ext_vector_type(4)));
typedef unsigned u32x4 __attribute__((ext_vector_type(4)));
constexpr int BM = 256, BK = 64, HALF = 128, HTB = HALF * BK * 2  , STAGE_BYTES = 8 * HTB, NXCD = 8, WGM = 8;

__host__ __device__ __forceinline__ int lds_byte(int r, int c) { const int st = (r >> 4) * 2 + (c >> 5), rr = r & 15, cc = c & 31, ob = rr * 64 + cc * 2; return st * 1024 + (ob ^ (((ob >> 9) & 1) << 5)); }
__host__ __device__ __forceinline__ void stage_rc(int b, int& R, int& C) { const int st = b / 1024, sb = b % 1024, swz = sb ^ (((sb >> 9) & 1) << 5); R = (st >> 1) * 16 + swz / 64; C = (st & 1) * 32 + (swz % 64) / 2; }
__host__ __device__ __forceinline__ unsigned tiled_off(int r, int c, int kc) { return ((unsigned)((r >> 4) * (kc >> 5) + (c >> 5)) << 10) + (unsigned)((r & 15) * 64 + (c & 31) * 2); }
__host__ __device__ __forceinline__ int perm32(int rho) { const int n = rho >> 4, i = rho & 15; return 8 * (i >> 2) + 4 * n + (i & 3); }

struct Unit { int pm, pn; };
struct Gemm { const bf16_t* A; const bf16_t* Bt; int M, N, K; };

struct StaticOrder {
    int nM, nN, nwg, G, c;
    __host__ __device__ void init(int M, int N, int G_, int c_) { nM = M / BM; nN = N / BM; nwg = nM * nN; G = G_; c = c_; }
    __host__ __device__ bool next(int i, Unit& u) const {
        const long L = (long)i * G + c; if (L >= nwg) return false;
        int wgid = (int)L; { const int q = nwg / NXCD, r = nwg % NXCD, xcd = wgid % NXCD, off = wgid / NXCD; wgid = (xcd < r ? xcd * (q + 1) : r * (q + 1) + (xcd - r) * q) + off; }
        const int nig = WGM * nN, gid = wgid / nig, fm = gid * WGM, gsz = (nM - fm) < WGM ? (nM - fm) : WGM;
        u.pm = fm + ((wgid % nig) % gsz); u.pn = (wgid % nig) / gsz; return true;
    }
    __device__ __forceinline__ void a_ready(const Unit&) const {}
    __device__ __forceinline__ void done(const Unit&) const {}
};

__device__ __forceinline__ unsigned cvt_pk_bf16(float lo, float hi) { unsigned r; asm volatile("v_cvt_pk_bf16_f32 %0, %1, %2" : "=v"(r) : "v"(lo), "v"(hi)); return r; }
template <int ACT  , bool RS  , bool OTILED = false  > struct EpiBf16 {
    static constexpr bool PERM = true, AFTER_DRAIN = false; static_assert(ACT == 0 || ACT == 2, "EpiBf16: ACT is 0 (none) or 2 (squared relu)");
    bf16_t* O; int ldc; const float* rscale;
    struct State { float rs[2][4]; };
    __device__ __forceinline__ void load(State& st, const Unit& u, int wr, int fr) const {
        if constexpr (RS) { const int row0 = u.pm * BM + wr * 64 + fr;
#pragma unroll
            for (int ai = 0; ai < 2; ++ai)
#pragma unroll
                for (int m = 0; m < 4; ++m) st.rs[ai][m] = rscale[row0 + ai * HALF + m * 16]; }
    }
    __device__ __forceinline__ void operator()(const f32x4 (&acc)[2][2][4][2], const Unit& u, int wr, int wc, int fr, int fq, const State& st) const {
        const int row0 = u.pm * BM + wr * 64 + fr; const int col0 = u.pn * BM + wc * 32 + 8 * fq;
#pragma unroll
        for (int ai = 0; ai < 2; ++ai)
#pragma unroll
            for (int m = 0; m < 4; ++m) { bf16_t* rowp = OTILED ? (bf16_t*)((char*)O + tiled_off(row0 + ai * HALF + m * 16, col0, ldc)) : O + (size_t)(row0 + ai * HALF + m * 16) * ldc + col0;
#pragma unroll
                for (int bj = 0; bj < 2; ++bj) { f32x4 v0 = acc[ai][bj][m][0], v1 = acc[ai][bj][m][1];
                    if constexpr (RS) { v0 = v0 * st.rs[ai][m]; v1 = v1 * st.rs[ai][m]; }
                    if (ACT == 2) { const f32x4 z4 = (f32x4){0.f, 0.f, 0.f, 0.f}; v0 = __builtin_elementwise_max(v0, z4); v1 = __builtin_elementwise_max(v1, z4); v0 = v0 * v0; v1 = v1 * v1; }
                    u32x4 w; w.x = cvt_pk_bf16(v0[0], v0[1]); w.y = cvt_pk_bf16(v0[2], v0[3]); w.z = cvt_pk_bf16(v1[0], v1[1]); w.w = cvt_pk_bf16(v1[2], v1[3]);
                    *(u32x4*)(rowp + (OTILED ? bj * (HALF / 32) * 512 : bj * HALF)) = w; } }
    }
};

struct EpiIn {
    static constexpr bool PERM = true, AFTER_DRAIN = false;
    bf16_t* O; int ldc; const float* rscale;
    struct State { float rs[2][4]; };
    __device__ __forceinline__ void load(State& st, const Unit& u, int wr, int fr) const {
        const int row0 = u.pm * BM + wr * 64 + fr;
#pragma unroll
        for (int ai = 0; ai < 2; ++ai)
#pragma unroll
            for (int m = 0; m < 4; ++m) st.rs[ai][m] = rscale[row0 + ai * HALF + m * 16];
    }
    __device__ __forceinline__ void operator()(const f32x4 (&acc)[2][2][4][2], const Unit& u, int wr, int wc, int fr, int fq, const State& st) const {
        const int row0 = u.pm * BM + wr * 64 + fr, pn = u.pn;
        const int kind = (pn >= 2 && pn < 6) ? 1 : (pn >= 12 ? 2 : 0);
        const int colb = pn < 2 ? 256 * pn : (pn < 6 ? 512 + 128 * (pn - 2) : (pn < 12 ? 1024 + 256 * (pn - 6) : 2560 + 128 * (pn - 12)));
        const int col0 = colb + wc * 32 + 8 * fq;
        if (kind == 0) {
#pragma unroll
            for (int ai = 0; ai < 2; ++ai)
#pragma unroll
                for (int m = 0; m < 4; ++m) { bf16_t* rowp = O + (size_t)(row0 + ai * HALF + m * 16) * ldc + col0;
#pragma unroll
                    for (int bj = 0; bj < 2; ++bj) { const f32x4 v0 = acc[ai][bj][m][0] * st.rs[ai][m], v1 = acc[ai][bj][m][1] * st.rs[ai][m];
                        u32x4 w; w.x = cvt_pk_bf16(v0[0], v0[1]); w.y = cvt_pk_bf16(v0[2], v0[3]); w.z = cvt_pk_bf16(v1[0], v1[1]); w.w = cvt_pk_bf16(v1[2], v1[3]);
                        *(u32x4*)(rowp + bj * HALF) = w; } }
        } else {
#pragma unroll
            for (int ai = 0; ai < 2; ++ai)
#pragma unroll
                for (int m = 0; m < 4; ++m) { bf16_t* rowp = O + (size_t)(row0 + ai * HALF + m * 16) * ldc + col0; float o[8];
#pragma unroll
                    for (int n = 0; n < 2; ++n)
#pragma unroll
                        for (int e = 0; e < 4; ++e) { const float a = acc[ai][0][m][n][e] * st.rs[ai][m], b = acc[ai][1][m][n][e] * st.rs[ai][m];
                            o[4 * n + e] = kind == 1 ? a * b : a * __builtin_amdgcn_rcpf(1.0f + __expf(-b)); }
                    u32x4 w; w.x = cvt_pk_bf16(o[0], o[1]); w.y = cvt_pk_bf16(o[2], o[3]); w.z = cvt_pk_bf16(o[4], o[5]); w.w = cvt_pk_bf16(o[6], o[7]);
                    *(u32x4*)rowp = w; }
        }
    }
};

template <class Epi, class Sched, bool ALIGN_EPI = false, bool SP2 = false, bool ATILED = false>
__device__ __forceinline__ void gemm_phase(PG8_LAS unsigned char* lds, const Gemm g, const Sched& S, const Epi& E) {
    int tid_ = threadIdx.x; asm volatile("" : "+v"(tid_));
    const int tid = tid_, wid = __builtin_amdgcn_readfirstlane(tid >> 6), lane = tid & 63, wr = wid >> 2, wc = wid & 3, fr = lane & 15, fq = lane >> 4;
    const int K = g.K, nt = K / BK;
    unsigned voffA[2], voffB[2];
#pragma unroll
    for (int i = 0; i < 2; ++i) { int R, C; stage_rc(tid * 16 + i * 8192, R, C); static_assert(Epi::PERM, "the tiled weight copies are stored in PERM row order");
        voffA[i] = ATILED ? tiled_off(R, C, K) : (unsigned)(R * K + C) * 2u; voffB[i] = tiled_off(R, C, K); }
    const size_t kstepA = ATILED ? 2048 : (size_t)(BK * 2), kstepB = 2048;
    const size_t hstep = (size_t)HALF * K * 2;
    const size_t tstep = 2 * hstep;
    const unsigned ldsw = (unsigned)wid * 1024u;
    const int aoff = lds_byte(wr * 64 + fr, fq * 8), boff = lds_byte(wc * 32 + fr, fq * 8);
#define PG8_SA(b, h) (((b) * 2 + (h)) * HTB)
#define PG8_SB(b, h) ((4 + (b) * 2 + (h)) * HTB)
#define PG8_STAGE(bufoff, gbase, voff) do { _Pragma("unroll") for (int _i = 0; _i < 2; ++_i) \
        __builtin_amdgcn_global_load_lds((const unsigned*)((const char*)(gbase) + (voff)[_i]), (PG8_LAS unsigned*)(lds + (bufoff) + ldsw + _i * 8192), 16, 0, 0); } while (0)
#define PG8_LDA(dst, b, h) do { _Pragma("unroll") for (int m = 0; m < 4; ++m) _Pragma("unroll") for (int k = 0; k < 2; ++k) dst[m][k] = *(const PG8_LAS bf16x8*)(lds + PG8_SA(b, h) + aoff + m * 2048 + k * 1024); } while (0)
#define PG8_LDB(dst, b, h) do { _Pragma("unroll") for (int n = 0; n < 2; ++n) _Pragma("unroll") for (int k = 0; k < 2; ++k) dst[n][k] = *(const PG8_LAS bf16x8*)(lds + PG8_SB(b, h) + boff + n * 2048 + k * 1024); } while (0)
#define PG8_MMA(ai, bj, At, Bt) do { __builtin_amdgcn_s_setprio(1); _Pragma("unroll") for (int m = 0; m < 4; ++m) _Pragma("unroll") for (int n = 0; n < 2; ++n) _Pragma("unroll") for (int k = 0; k < 2; ++k) \
        acc[ai][bj][m][n] = __builtin_amdgcn_mfma_f32_16x16x32_bf16(Bt[n][k], At[m][k], acc[ai][bj][m][n], 0, 0, 0); __builtin_amdgcn_s_setprio(0); } while (0)
#define PG8_WAIT_V(n) asm volatile("s_waitcnt vmcnt(" #n ")" ::: "memory")
#define PG8_WAIT_L(n) asm volatile("s_waitcnt lgkmcnt(" #n ")" ::: "memory")
#define PG8_BAR __builtin_amdgcn_s_barrier()
#define PG8_SCHED __builtin_amdgcn_sched_barrier(0)
    Unit cur, nxt; int ui = 0;
    if (!S.next(0, cur)) return;
    typename Epi::State est; E.load(est, cur, wr, fr);
    f32x4 acc[2][2][4][2];
#pragma unroll
    for (int a = 0; a < 2; ++a)
#pragma unroll
        for (int b = 0; b < 2; ++b)
#pragma unroll
            for (int m = 0; m < 4; ++m)
#pragma unroll
                for (int n = 0; n < 2; ++n) acc[a][b][m][n] = (f32x4){0.f, 0.f, 0.f, 0.f};
    bf16x8 At[4][2], B0[2][2], B1[2][2];
    const char* cA = (const char*)g.A + (size_t)cur.pm * tstep; const char* cB = (const char*)g.Bt + (size_t)cur.pn * tstep;
    S.a_ready(cur);
    if constexpr (SP2) {
        PG8_STAGE(PG8_SB(0, 0), cB, voffB); PG8_STAGE(PG8_SB(0, 1), cB + hstep, voffB); PG8_STAGE(PG8_SA(0, 0), cA, voffA); PG8_STAGE(PG8_SA(0, 1), cA + hstep, voffA);
        if (wr == 1) PG8_BAR;
        PG8_WAIT_V(2); PG8_BAR;
        PG8_STAGE(PG8_SB(1, 0), cB + kstepB, voffB); PG8_STAGE(PG8_SB(1, 1), cB + hstep + kstepB, voffB);
        PG8_WAIT_V(4); PG8_BAR;
    } else {
        PG8_STAGE(PG8_SB(0, 0), cB, voffB); PG8_STAGE(PG8_SA(0, 0), cA, voffA); PG8_STAGE(PG8_SB(0, 1), cB + hstep, voffB); PG8_STAGE(PG8_SA(0, 1), cA + hstep, voffA);
        if (wr == 1) PG8_BAR;
        PG8_WAIT_V(4); PG8_BAR;
        PG8_STAGE(PG8_SB(1, 0), cB + kstepB, voffB); PG8_STAGE(PG8_SA(1, 0), cA + kstepA, voffA); PG8_STAGE(PG8_SB(1, 1), cB + hstep + kstepB, voffB);
        PG8_WAIT_V(6); PG8_BAR;
    }
    for (;;) {
        const bool has_next = S.next(ui + 1, nxt);
        const char* nA = has_next ? (const char*)g.A + (size_t)nxt.pm * tstep : cA; const char* nB = has_next ? (const char*)g.Bt + (size_t)nxt.pn * tstep : cB;
        for (int t = 0; t < nt; t += 2) {
            const bool last = (t == nt - 2);
            const char* a1 = cA + (size_t)(t + 1) * kstepA;
            const char* a2 = last ? nA : cA + (size_t)(t + 2) * kstepA; const char* b2 = last ? nB : cB + (size_t)(t + 2) * kstepB;
            const char* a3 = a2 + kstepA; const char* b3 = b2 + kstepB;
            if (last && has_next) S.a_ready(nxt);
            if constexpr (SP2) {
            PG8_LDB(B0, 0, 0); PG8_LDB(B1, 0, 1); PG8_SCHED; PG8_LDA(At, 0, 0); PG8_STAGE(PG8_SA(1, 0), a1, voffA); PG8_STAGE(PG8_SA(1, 1), a1 + hstep, voffA);
            PG8_WAIT_V(8); PG8_WAIT_L(0); PG8_BAR; PG8_MMA(0, 0, At, B0); PG8_MMA(0, 1, At, B1); PG8_BAR; PG8_SCHED;
            PG8_LDA(At, 0, 1); PG8_STAGE(PG8_SB(0, 0), b2, voffB); PG8_STAGE(PG8_SB(0, 1), b2 + hstep, voffB);
            PG8_WAIT_V(6); PG8_WAIT_L(0); PG8_BAR; PG8_MMA(1, 0, At, B0); PG8_MMA(1, 1, At, B1); PG8_BAR; PG8_SCHED;
            PG8_LDB(B0, 1, 0); PG8_LDB(B1, 1, 1); PG8_SCHED; PG8_LDA(At, 1, 0); PG8_STAGE(PG8_SA(0, 0), a2, voffA); PG8_STAGE(PG8_SA(0, 1), a2 + hstep, voffA);
            PG8_WAIT_V(8); PG8_WAIT_L(0); PG8_BAR; PG8_MMA(0, 0, At, B0); PG8_MMA(0, 1, At, B1); PG8_BAR; PG8_SCHED;
            PG8_LDA(At, 1, 1); PG8_STAGE(PG8_SB(1, 0), b3, voffB); PG8_STAGE(PG8_SB(1, 1), b3 + hstep, voffB);
            PG8_WAIT_V(6); PG8_WAIT_L(0); PG8_BAR; PG8_MMA(1, 0, At, B0); PG8_MMA(1, 1, At, B1); PG8_BAR; PG8_SCHED;
            } else {
            PG8_LDB(B0, 0, 0); PG8_SCHED; PG8_LDA(At, 0, 0); PG8_STAGE(PG8_SA(1, 1), a1 + hstep, voffA);
            PG8_WAIT_L(8); PG8_BAR; PG8_WAIT_L(0); PG8_MMA(0, 0, At, B0); PG8_BAR; PG8_SCHED;
            PG8_LDB(B1, 0, 1); PG8_STAGE(PG8_SB(0, 0), b2, voffB);
            PG8_BAR; PG8_WAIT_L(0); PG8_MMA(0, 1, At, B1); PG8_BAR;
            PG8_LDA(At, 0, 1); PG8_STAGE(PG8_SA(0, 0), a2, voffA);
            PG8_BAR; PG8_WAIT_L(0); PG8_MMA(1, 0, At, B0); PG8_BAR; PG8_SCHED;
            PG8_STAGE(PG8_SB(0, 1), b2 + hstep, voffB);
            PG8_WAIT_V(6); PG8_BAR; PG8_MMA(1, 1, At, B1); PG8_BAR;
            PG8_LDB(B0, 1, 0); PG8_SCHED; PG8_LDA(At, 1, 0); PG8_STAGE(PG8_SA(0, 1), a2 + hstep, voffA);
            PG8_WAIT_L(8); PG8_BAR; PG8_WAIT_L(0); PG8_MMA(0, 0, At, B0); PG8_BAR; PG8_SCHED;
            PG8_LDB(B1, 1, 1); PG8_STAGE(PG8_SB(1, 0), b3, voffB);
            PG8_BAR; PG8_WAIT_L(0); PG8_MMA(0, 1, At, B1); PG8_BAR;
            PG8_LDA(At, 1, 1); PG8_STAGE(PG8_SA(1, 0), a3, voffA);
            PG8_BAR; PG8_WAIT_L(0); PG8_MMA(1, 0, At, B0); PG8_BAR; PG8_SCHED;
            PG8_STAGE(PG8_SB(1, 1), b3 + hstep, voffB);
            PG8_WAIT_V(6); PG8_BAR; PG8_MMA(1, 1, At, B1); PG8_BAR;
            }
        }
        if constexpr (ALIGN_EPI) { if (wr == 0) PG8_BAR; }
        if constexpr (!Epi::AFTER_DRAIN) { E(acc, cur, wr, wc, fr, fq, est); S.done(cur); }
        if (!has_next) break;
        E.load(est, nxt, wr, fr);
#pragma unroll
        for (int a = 0; a < 2; ++a)
#pragma unroll
            for (int b = 0; b < 2; ++b)
#pragma unroll
                for (int m = 0; m < 4; ++m)
#pragma unroll
                    for (int n = 0; n < 2; ++n) acc[a][b][m][n] = (f32x4){0.f, 0.f, 0.f, 0.f};
        cur = nxt; cA = nA; cB = nB; ++ui;
        if constexpr (ALIGN_EPI) { if (wr == 1) PG8_BAR; }
    }
    PG8_WAIT_V(0);
    if constexpr (!ALIGN_EPI) { if (wr == 0) PG8_BAR; }
    PG8_BAR;
    if constexpr (Epi::AFTER_DRAIN) { E.fused(acc, cur, wr, wc, fr, fq, lds, wid, lane); S.done(cur); }
#undef PG8_SA
#undef PG8_SB
#undef PG8_STAGE
#undef PG8_LDA
#undef PG8_LDB
#undef PG8_MMA
#undef PG8_WAIT_V
#undef PG8_WAIT_L
#undef PG8_BAR
#undef PG8_SCHED
}
}

namespace attn_body {
using bf16=__hip_bfloat16;
using bf16x8=__attribute__((ext_vector_type(8)))short;
using s16x4=__attribute__((ext_vector_type(4)))short;
using f32x16=__attribute__((ext_vector_type(16)))float;
using u32x4=__attribute__((ext_vector_type(4)))unsigned;
constexpr int D=64,ZP=3072,OP=2048;
constexpr int NW=8,QBLK=32,QB=QBLK*NW,KVBLK=64;
constexpr int ATTN_UNIT_ROWS=QB;
__device__ __forceinline__ int crow(int r,int hi){return (r&3)+8*(r>>2)+4*hi;}
#define SBAR() __builtin_amdgcn_sched_barrier(0)
template<int MODE> __device__ __forceinline__ int trow(int t,int q0,int S){
  if constexpr(MODE!=1){ return 64*t; }
  else { const int j=(t+3)&7; const int kpos=q0-128+64*j; return (kpos>=0&&kpos<S)?kpos:(q0+64); }
}
template<int MODE> __device__ __forceinline__ void tmask(f32x16&p0,f32x16&p1,int t,int qrel,int hi,int q0,int S){
  if constexpr(MODE==1){
    const float NEG=-INFINITY; const int j=(t+3)&7; const int krel0=-128+64*j; const int kpos=q0+krel0;
    const int base=(kpos>=0&&kpos<S)?(krel0+4*hi-qrel+128):100000;
    #pragma unroll
    for(int r=0;r<16;++r){const int kv=base+(r&3)+8*(r>>2); if((unsigned)kv>256u)p0[r]=NEG; if((unsigned)(kv+32)>256u)p1[r]=NEG;}
  }
}

constexpr int NSLOT=3, SLOTB=8192;
constexpr int LDS_K=0, LDS_V=NSLOT*SLOTB, LDS_WS=2*NSLOT*SLOTB, LDS_OST=LDS_WS+NW*64*4, LDS_BYTES=LDS_OST+NW*4096;
constexpr float C2=0.125f*1.4426950408889634f;
__device__ __forceinline__ void glds16(const void*gsrc,unsigned lds_dst){unsigned keep;
  asm volatile("s_mov_b32 %0, m0\n\ts_mov_b32 m0, %2\n\ts_nop 0\n\tglobal_load_lds_dwordx4 %1, off\n\ts_mov_b32 m0, %0":"=&s"(keep):"v"(gsrc),"s"(lds_dst):"memory");}
__device__ __forceinline__ float max3f(float a,float b,float c){float r;asm("v_max3_f32 %0, %1, %2, %3":"=v"(r):"v"(a),"v"(b),"v"(c));return r;}
__device__ __forceinline__ float max2f(float a,float b){float r;asm("v_max_f32_e32 %0, %1, %2":"=v"(r):"v"(a),"v"(b));return r;}
__device__ __forceinline__ float fadd_s(float a,float b){float r;asm("v_add_f32_e32 %0, %1, %2":"=v"(r):"v"(a),"v"(b));return r;}
__device__ __forceinline__ float fsub_s(float a,float b){float r;asm("v_sub_f32_e32 %0, %1, %2":"=v"(r):"v"(a),"v"(b));return r;}
typedef float f32x2_t __attribute__((ext_vector_type(2))); typedef __bf16 bf16x2_t __attribute__((ext_vector_type(2)));
__device__ __forceinline__ unsigned cvtpk_s(float lo,float hi){f32x2_t v={lo,hi};bf16x2_t b=__builtin_convertvector(v,bf16x2_t);return __builtin_bit_cast(unsigned,b);}
#define WAIT_BAR(N) asm volatile("s_waitcnt vmcnt(" #N ") lgkmcnt(0)\n\ts_barrier":::"memory")
#define WAIT_BAR2W() WAIT_BAR(1)

typedef int v8i_t __attribute__((ext_vector_type(8))); typedef int v4i_t __attribute__((ext_vector_type(4)));
typedef __attribute__((address_space(3))) const char* lds_cptr;
typedef short v4i16_t __attribute__((ext_vector_type(4))); typedef short v2s16_t __attribute__((ext_vector_type(2)));
#define FP8_SC 0
__device__ __forceinline__ v8i_t kfrag(lds_cptr kp){ const v4i_t lo=*(const __attribute__((address_space(3))) v4i_t*)(kp), hi=*(const __attribute__((address_space(3))) v4i_t*)(kp+1024); return __builtin_shufflevector(lo,hi,0,1,2,3,4,5,6,7); }
#define QK8(KF,QF,C) __builtin_amdgcn_mfma_scale_f32_32x32x64_f8f6f4((KF),(QF),(C),0,0,0,FP8_SC,0,FP8_SC)
__device__ __forceinline__ void qkt(f32x16&p0,f32x16&p1,lds_cptr Kslot,const v8i_t qf,const f32x16&negm,int r32,int hi){
  const lds_cptr kb=Kslot+hi*2048+r32*16;
  p0=QK8(kfrag(kb),qf,negm); p1=QK8(kfrag(kb+512),qf,negm);
}
__device__ __forceinline__ s16x4 vtr(lds_cptr p){ return __builtin_bit_cast(s16x4,__builtin_amdgcn_ds_read_tr16_b64_v4i16((__attribute__((address_space(3))) v4i16_t*)p)); }
__device__ __forceinline__ float rowmax(const f32x16&p0,const f32x16&p1){
  float a=max3f(p0[0],p0[1],p1[0]),b=max3f(p0[2],p0[3],p1[1]);a=max3f(a,p1[2],p1[3]);
  #pragma unroll
  for(int r=4;r<16;r+=4){a=max3f(a,p0[r],p0[r+1]);b=max3f(b,p0[r+2],p0[r+3]);a=max3f(a,p1[r],p1[r+1]);b=max3f(b,p1[r+2],p1[r+3]);}
  const float m=max2f(a,b);
  auto rr=__builtin_amdgcn_permlane32_swap(__float_as_uint(m),__float_as_uint(m),false,false);
  return max2f(__uint_as_float(rr[0]),__uint_as_float(rr[1]));
}
__device__ __forceinline__ void pv(f32x16*o,int vb,bf16x8 pa0,bf16x8 pa1,bf16x8 pa2,bf16x8 pa3){
  #pragma unroll
  for(int d0=0;d0<2;++d0){s16x4 lo[4],hi[4];
    #pragma unroll
    for(int ks=0;ks<4;++ks){
      asm volatile("ds_read_b64_tr_b16 %0,%1 offset:%c2":"=&v"(lo[ks]):"v"(vb),"i"(d0*4096+ks*1024):"memory");
      asm volatile("ds_read_b64_tr_b16 %0,%1 offset:%c2":"=&v"(hi[ks]):"v"(vb),"i"(d0*4096+ks*1024+512):"memory");}
    asm volatile("s_waitcnt lgkmcnt(0)":::"memory");SBAR();
    #define PK(k) (bf16x8){lo[k][0],lo[k][1],lo[k][2],lo[k][3],hi[k][0],hi[k][1],hi[k][2],hi[k][3]}
    o[d0]=__builtin_amdgcn_mfma_f32_32x32x16_bf16(pa0,PK(0),o[d0],0,0,0);
    o[d0]=__builtin_amdgcn_mfma_f32_32x32x16_bf16(pa1,PK(1),o[d0],0,0,0);
    o[d0]=__builtin_amdgcn_mfma_f32_32x32x16_bf16(pa2,PK(2),o[d0],0,0,0);
    o[d0]=__builtin_amdgcn_mfma_f32_32x32x16_bf16(pa3,PK(3),o[d0],0,0,0);
    #undef PK
  }
}

template<int QT> __device__ __forceinline__ v8i_t q_transform(const bf16x8 (&qr)[4],const int t,const int hi,const float*gq){
  float x[4][8];
  #pragma unroll
  for(int d0=0;d0<4;++d0)
    #pragma unroll
    for(int e=0;e<8;++e)x[d0][e]=__uint_as_float(((unsigned)(unsigned short)qr[d0][e])<<16);
  if constexpr(QT==1){
    float ss=0.f;
    #pragma unroll
    for(int d0=0;d0<4;++d0)
      #pragma unroll
      for(int e=0;e<8;++e)ss+=x[d0][e]*x[d0][e];
    {auto rr=__builtin_amdgcn_permlane32_swap(__float_as_uint(ss),__float_as_uint(ss),false,false);ss=__uint_as_float(rr[0])+__uint_as_float(rr[1]);}
    const float r=rsqrtf(ss*(1.0f/64.0f)+1e-6f);
    #pragma unroll
    for(int d0=0;d0<4;++d0)
      #pragma unroll
      for(int e=0;e<8;++e)x[d0][e]=x[d0][e]*r*gq[16*d0+8*hi+e];
    const int pr=t>>6,pc=t&63;
    #pragma unroll
    for(int e=0;e<8;++e){ const float f=INVF[2*(8*hi+e)]; float sn,cs;
      sincos_f((float)pr*f,sn,cs); { const float a=x[0][e],b=x[1][e]; x[0][e]=a*cs-b*sn; x[1][e]=b*cs+a*sn; }
      sincos_f((float)pc*f,sn,cs); { const float a=x[2][e],b=x[3][e]; x[2][e]=a*cs-b*sn; x[3][e]=b*cs+a*sn; } }
  } else {
    #pragma unroll
    for(int e=0;e<8;++e){ float sn,cs;
      sincos_f((float)t*INVF[8*hi+e],sn,cs);    { const float a=x[0][e],b=x[2][e]; x[0][e]=a*cs-b*sn; x[2][e]=b*cs+a*sn; }
      sincos_f((float)t*INVF[16+8*hi+e],sn,cs); { const float a=x[1][e],b=x[3][e]; x[1][e]=a*cs-b*sn; x[3][e]=b*cs+a*sn; } }
  }
  v8i_t qf;
  #pragma unroll
  for(int d0=0;d0<4;++d0){ int w0=0,w1=0;
    w0=__builtin_amdgcn_cvt_pk_fp8_f32(x[d0][0]*C2,x[d0][1]*C2,w0,false); w0=__builtin_amdgcn_cvt_pk_fp8_f32(x[d0][2]*C2,x[d0][3]*C2,w0,true);
    w1=__builtin_amdgcn_cvt_pk_fp8_f32(x[d0][4]*C2,x[d0][5]*C2,w1,false); w1=__builtin_amdgcn_cvt_pk_fp8_f32(x[d0][6]*C2,x[d0][7]*C2,w1,true);
    qf[2*d0]=w0; qf[2*d0+1]=w1; }
  return qf;
}
#ifndef ATTN_STORE16
#define ATTN_STORE16(p,v) (*(u32x4*)(p)=(v))
#endif
template<int MODE,int THRL,int QT> __device__ __forceinline__ void attn_unit(const bf16*Qu,const char*__restrict__ Kt,const char*__restrict__ Vt,bf16*Ou,const int NT,const int q0,const int S,const float sink2,const int tq0,const float*gq,char*shm){
  int tid_=threadIdx.x; asm volatile("":"+v"(tid_)); const int tid=tid_,lane=tid&63,r32=lane&31,hi=lane>>5; const int wid=__builtin_amdgcn_readfirstlane(tid>>6);
  const bf16*Qw=Qu+(long)(wid*QBLK)*ZP;
  const unsigned lds0=(unsigned)(uintptr_t)shm;
  float*wsf=(float*)(shm+LDS_WS)+wid*64;
  const bool kw=wid<4; const char*psrc=(kw?Kt+wid*1024:Vt+(wid&3)*1024)+lane*16; const unsigned pdst=lds0+(kw?LDS_K+wid*1024:LDS_V+(wid&3)*1024);
  #define DMA_P(t,slot) glds16(psrc+((long)(trow<MODE>((t),q0,S)>>6)<<12),(unsigned)__builtin_amdgcn_readfirstlane(pdst+(slot)))
  #define DMA_K(t,slot) if(kw) DMA_P(t,slot)
  #define DMA_V(t,slot) if(!kw) DMA_P(t,slot)
  #define DMA_STEP(t,GK,GV) do{ if(kw?(GK):(GV)){ const int tt_=(t)+(kw?3:1); const int sl_=kw?sl_cur:sl_next; DMA_P(tt_,sl_); } }while(0)
  v8i_t kf[2];
  const lds_cptr shm3=(lds_cptr)shm; const lds_cptr kp0=shm3+LDS_K+hi*2048+r32*16; const lds_cptr vp0=shm3+LDS_V+hi*2048+r32*16;
  DMA_P(0,0);DMA_K(1,SLOTB);
  bf16x8 qr[4];
  #pragma unroll
  for(int d0=0;d0<4;++d0)qr[d0]=*reinterpret_cast<const bf16x8*>(&Qw[(long)r32*ZP+d0*16+hi*8]);
  const v8i_t qf=q_transform<QT>(qr,tq0+wid*QBLK+r32,hi,gq);
  float mhat=0.f;f32x16 o[2];o[0]=f32x16{};o[1]=f32x16{};f32x16 o2=f32x16{};
  v8i_t ones; _Pragma("unroll") for(int i=0;i<8;++i)ones[i]=0x38383838; asm volatile("":"+v"(ones));
  f32x16 negm=f32x16{};if constexpr(MODE!=2){asm volatile("":"+v"(negm));}
  const float pscl=(MODE==2)?sink2:1.0f;
  const int qrel=wid*QBLK+r32;
  #define CMASK(P0,P1,t) tmask<MODE>(P0,P1,(t),qrel,hi,q0,S)
  bool resc=false;
  #define START(P0,P1) do{ resc=false; if constexpr(MODE!=2) \
    { const float rm=rowmax(P0,P1); const float dl=rm; mhat=fadd_s(mhat,dl); \
      _Pragma("unroll") for(int r=0;r<16;++r){P0[r]=fsub_s(P0[r],dl);P1[r]=fsub_s(P1[r],dl);} \
      _Pragma("unroll") for(int r=0;r<16;++r)negm[r]=-mhat; asm volatile("":"+v"(negm)); } \
    _Pragma("unroll") for(int r=0;r<16;++r)P0[r]=__builtin_amdgcn_exp2f(P0[r]); }while(0)
  #define RESC() do{ if constexpr(MODE!=2) if(resc){ asm volatile("s_waitcnt lgkmcnt(0)":::"memory"); \
      _Pragma("unroll") for(int r=0;r<16;++r){ const float f_=wsf[crow(r,hi)]; o[0][r]*=f_; o[1][r]*=f_; o2[r]*=f_; } } }while(0)
  f32x16 pA0,pA1,pB0,pB1;
  int sl_prev=0,sl_cur=0,sl_next=SLOTB;
  #define ROT() do{sl_prev=sl_cur;sl_cur=sl_next;sl_next=(sl_next==(NSLOT-1)*SLOTB)?0:sl_next+SLOTB;}while(0)
  DMA_K(2,2*SLOTB);
  WAIT_BAR(3);
  qkt(pA0,pA1,shm3+LDS_K,qf,negm,r32,hi);asm volatile("s_nop 15\n\ts_nop 7":"+v"(pA0),"+v"(pA1));CMASK(pA0,pA1,0);
  START(pA0,pA1);
  _Pragma("unroll") for(int r=0;r<16;++r)pA1[r]=__builtin_amdgcn_exp2f(pA1[r]);
  WAIT_BAR(0);
  DMA_P(kw?3:1,kw?0:SLOTB);
  ROT();
  kf[0]=kfrag(kp0+sl_cur); kf[1]=kfrag(kp0+sl_cur+512);
  WAIT_BAR2W();
  v8i_t vf[2], pa;
  #define PK8(P,B,W) do{ v2s16_t w2_=__builtin_bit_cast(v2s16_t,W); w2_=__builtin_amdgcn_cvt_scalef32_pk_bf8_f32(w2_,P[B],P[(B)+1],pscl,false); w2_=__builtin_amdgcn_cvt_scalef32_pk_bf8_f32(w2_,P[(B)+2],P[(B)+3],pscl,true); W=__builtin_bit_cast(int,w2_); }while(0)
  #define PV8(A,B,C) __builtin_amdgcn_mfma_scale_f32_32x32x64_f8f6f4((A),(B),(C),1,0,0,FP8_SC,0,FP8_SC)
  #define PIN(x) asm volatile("":"+v"(x))
  #define MX3(a,b,c) __builtin_fmaxf(__builtin_fmaxf((a),(b)),(c))
  #define EX(v) __builtin_amdgcn_exp2f(v)
  #define KRD(G,j) do{ if(G){ kf[(j)]=kfrag(kp0+sl_next+(j)*512); } }while(0)
  #define HALFA(P,J0) do{ _Pragma("unroll") for(int j_=0;j_<4;++j_){ int w_; asm volatile("":"=v"(w_)); PK8(P,4*j_,w_); pa[(J0)+j_]=w_; } }while(0)
  #define STEP(C0,C1,P0,P1,t,GK,GV,GL) do{ SBAR(); \
    { const lds_cptr vp_=vp0+sl_prev; vf[0]=kfrag(vp_); vf[1]=kfrag(vp_+512); } \
    PIN(kf[0]); C0=QK8(kf[0],qf,negm); PIN(C0); \
    PIN(P0); PIN(P1); HALFA(P0,0); HALFA(P1,4); PIN(pa); \
    PIN(kf[1]); C1=QK8(kf[1],qf,negm); PIN(C1); KRD(GL,0); KRD(GL,1);     \
    DMA_STEP(t,GK,GV); \
    CMASK(C0,C1,t); \
    if constexpr(MODE!=2){ float a=MX3(C0[0],C0[1],C1[0]),b=MX3(C0[2],C0[3],C1[1]); a=MX3(a,C1[2],C1[3]); \
      _Pragma("unroll") for(int r=4;r<16;r+=4){a=MX3(a,C0[r],C0[r+1]);b=MX3(b,C0[r+2],C0[r+3]);a=MX3(a,C1[r],C1[r+1]);b=MX3(b,C1[r+2],C1[r+3]);} \
      float rm=__builtin_fmaxf(a,b); { auto rr=__builtin_amdgcn_permlane32_swap(__float_as_uint(rm),__float_as_uint(rm),false,false); rm=__builtin_fmaxf(__uint_as_float(rr[0]),__uint_as_float(rr[1])); } \
      resc=false; \
      if(__builtin_expect(__any(rm>(float)THRL),0)){ const float dl=__builtin_fmaxf(rm,0.f); mhat+=dl; \
        _Pragma("unroll") for(int r=0;r<16;++r){C0[r]-=dl;C1[r]-=dl;} \
        _Pragma("unroll") for(int r=0;r<16;++r)negm[r]=-mhat; asm volatile("":"+v"(negm)); \
        const float f=__builtin_amdgcn_exp2f(-dl); if(hi==0)wsf[r32]=f; resc=true; } } \
    PIN(pa); o[0]=PV8(pa,vf[0],o[0]); PIN(o[0]); \
    PIN(C0); _Pragma("unroll") for(int r=0;r<11;++r)C0[r]=EX(C0[r]); PIN(C0); \
    PIN(pa); o[1]=PV8(pa,vf[1],o[1]); PIN(o[1]); \
    PIN(C0); PIN(C1); _Pragma("unroll") for(int r=11;r<16;++r)C0[r]=EX(C0[r]); _Pragma("unroll") for(int r=0;r<6;++r)C1[r]=EX(C1[r]); PIN(C0); PIN(C1); \
    PIN(pa); o2=PV8(pa,ones,o2); PIN(o2); \
    PIN(C1); _Pragma("unroll") for(int r=6;r<16;++r)C1[r]=EX(C1[r]); PIN(C1); \
    SBAR(); \
    }while(0)
  int t=1;
  for(;t+5<NT;t+=2){
    STEP(pB0,pB1,pA0,pA1,t,true,true,true);     WAIT_BAR2W(); RESC(); ROT();
    STEP(pA0,pA1,pB0,pB1,t+1,true,true,true);   WAIT_BAR2W(); RESC(); ROT();
  }
  #define ENDW(tt) do{ if((tt)+3<NT){WAIT_BAR2W();} else if((tt)+2<NT){ if(wid<4){WAIT_BAR(0);} else {WAIT_BAR(1);} } else {WAIT_BAR(0);} }while(0)
  for(;t+1<NT;t+=2){
    STEP(pB0,pB1,pA0,pA1,t,(t+3<NT),(t+1<NT),(t+1<NT));       ENDW(t);   RESC(); ROT();
    STEP(pA0,pA1,pB0,pB1,t+1,(t+4<NT),(t+2<NT),(t+2<NT));     ENDW(t+1); RESC(); ROT();
  }
  STEP(pB0,pB1,pA0,pA1,NT-1,false,false,false); RESC();
  { HALFA(pB0,0); HALFA(pB1,4);
    { const lds_cptr vp_=vp0+sl_cur; vf[0]=kfrag(vp_); vf[1]=kfrag(vp_+512); }
    o[0]=PV8(pa,vf[0],o[0]); o[1]=PV8(pa,vf[1],o[1]); o2=PV8(pa,ones,o2); }
  #undef PK8
  #undef PV8
  #undef HALFA
  #undef PIN
  #undef MX3
  #undef EX
  #undef KRD
  #undef DMA_STEP
  #undef STEP
  #undef ENDW
  if constexpr(MODE==1){ if(hi==0)wsf[32+r32]=__builtin_amdgcn_exp2f(sink2-mhat); asm volatile("s_waitcnt lgkmcnt(0)":::"memory");
    _Pragma("unroll") for(int r=0;r<16;++r)o2[r]+=wsf[32+crow(r,hi)]; }
  float rli[16];
  #pragma unroll
  for(int r=0;r<16;++r)rli[r]=__builtin_amdgcn_rcpf(o2[r]);
  bf16*Ow=Ou+(long)(wid*QBLK)*OP;
  { bf16*stg=(bf16*)(shm+LDS_OST)+wid*2048;
    #pragma unroll
    for(int r=0;r<16;++r){const int orow=crow(r,hi);
      #pragma unroll
      for(int d0=0;d0<2;++d0)stg[orow*64+d0*32+r32]=__float2bfloat16(o[d0][r]*rli[r]);}
    asm volatile("s_waitcnt lgkmcnt(0)":::"memory");
    #pragma unroll
    for(int i=0;i<4;++i){const int row=i*8+(lane>>3),ch=lane&7; const u32x4 v=*(const u32x4*)(stg+row*64+ch*8); ATTN_STORE16(Ow+(long)row*OP+ch*8,v);} }
  asm volatile("s_waitcnt lgkmcnt(0)\n\ts_barrier":::"memory");
  #undef DMA_K
  #undef DMA_V
  #undef DMA_P
  #undef CMASK
  #undef START
  #undef RESC
  #undef ROT
}
constexpr int ATTN_LDS_BYTES=LDS_BYTES;
#undef SBAR
#undef WAIT_BAR
#undef WAIT_BAR2W
#undef QK8
}
#define GAS __attribute__((address_space(1)))
#define LAS __attribute__((address_space(3)))
typedef unsigned short bf16;
typedef unsigned v4u __attribute__((ext_vector_type(4)));
typedef float f32x4 __attribute__((ext_vector_type(4)));
typedef short bf16x8 __attribute__((ext_vector_type(8)));
typedef GAS unsigned gu32;
typedef GAS unsigned long long gu64;
#define RLX_AGENT __ATOMIC_RELAXED, __HIP_MEMORY_SCOPE_AGENT
#define LDS_WAIT() asm volatile("s_waitcnt lgkmcnt(0)" ::: "memory")
#define VM_WAIT() asm volatile("s_waitcnt vmcnt(0)" ::: "memory")
__device__ __forceinline__ unsigned long long rt() { return __builtin_amdgcn_s_memrealtime(); }
__device__ __forceinline__ unsigned f2bf(float f) { unsigned u = __builtin_bit_cast(unsigned, f); return (u + 0x7fffu + ((u >> 16) & 1u)) >> 16; }
__device__ __forceinline__ unsigned pk2(float lo, float hi) { return f2bf(lo) | (f2bf(hi) << 16); }

#define XB_TMO      128
#define XB_XCNT(j)  (256  + 64 * (j))
#define XB_XSUB(j)  (1280 + 64 * (j))
#define XB_XGEN(j)  (2304 + 64 * (j))
#define XB_TOP      3328
#define XB_TOPGEN   3392
#define XCD_BAR_WORDS 3456
#define XB_SPIN_CAP (1u << 18)

__device__ __forceinline__ unsigned xb_ld(unsigned* p)              { return __hip_atomic_load(p, __ATOMIC_RELAXED, __HIP_MEMORY_SCOPE_AGENT); }
__device__ __forceinline__ unsigned xb_add(unsigned* p, unsigned v) { return __hip_atomic_fetch_add(p, v, __ATOMIC_RELAXED, __HIP_MEMORY_SCOPE_AGENT); }
__device__ __forceinline__ unsigned xb_xcc_id() { return (unsigned)__builtin_amdgcn_s_getreg((3 << 11) | 20) & 0xFu; }
#define XB_SPIN(cond, bar) do { unsigned _sp = 0; while (cond) { __builtin_amdgcn_s_sleep(1); \
    if ((++_sp & 255u) == 0u) { if (xb_ld(&(bar)[XB_TMO])) break; if (_sp > XB_SPIN_CAP) { atomicAdd(&(bar)[XB_TMO], 1u); break; } } } } while (0)

struct XcdBarrier {
    unsigned* bar; unsigned x;
    volatile LAS unsigned* st;
};

__device__ __forceinline__ XcdBarrier xcd_barrier_post(unsigned* bar, volatile LAS unsigned* st) {
    XcdBarrier b; b.bar = bar; b.x = xb_xcc_id(); b.st = st;
    if (threadIdx.x == 0) (void)xb_add(&bar[XB_XCNT(b.x)], 1u);
    return b;
}
__device__ __forceinline__ void xcd_barrier_complete(unsigned* bar, unsigned x, unsigned& nloc, unsigned& nx) {
    const unsigned G = gridDim.x * gridDim.y * gridDim.z;
    unsigned sum, cnt, mine, sp = 0u;
    for (;;) {
        sum = 0u; cnt = 0u; mine = 0u;
#pragma unroll
        for (unsigned j = 0; j < 16; ++j) { const unsigned c = xb_ld(&bar[XB_XCNT(j)]); sum += c; cnt += (c > 0u) ? 1u : 0u; mine = (j == x) ? c : mine; }
        if (sum == G) break;
        __builtin_amdgcn_s_sleep(1);
        if ((++sp & 255u) == 0u) { if (xb_ld(&bar[XB_TMO])) break; if (sp > XB_SPIN_CAP) { atomicAdd(&bar[XB_TMO], 1u); break; } }
    }
    nloc = mine > 0u ? mine : 1u; nx = cnt > 0u ? cnt : 1u;
}

__device__ __forceinline__ void xcd_barrier(const XcdBarrier& b) {
    asm volatile("s_waitcnt vmcnt(0)" ::: "memory");
    __syncthreads();
    if (threadIdx.x == 0) {
        unsigned* bar = b.bar;
        __builtin_amdgcn_s_waitcnt(0);
        unsigned nloc = b.st[0], nx = b.st[1];
        if (nloc == 0u) { xcd_barrier_complete(bar, b.x, nloc, nx); b.st[0] = nloc; b.st[1] = nx; }
        const unsigned old = xb_add(&bar[XB_XSUB(b.x)], 1u);
        const unsigned gen = old / nloc;
        if (old + 1u == (gen + 1u) * nloc) {
            __builtin_amdgcn_fence(__ATOMIC_RELEASE, "agent");
            asm volatile("s_waitcnt vmcnt(0)" ::: "memory");
            const unsigned og = xb_add(&bar[XB_TOP], 1u);
            const unsigned tg = og / nx;
            if (og + 1u == (tg + 1u) * nx) xb_add(&bar[XB_TOPGEN], 1u);
            else XB_SPIN(xb_ld(&bar[XB_TOPGEN]) == tg, bar);
            __builtin_amdgcn_fence(__ATOMIC_ACQUIRE, "agent");
            xb_add(&bar[XB_XGEN(b.x)], 1u);
            asm volatile("s_waitcnt vmcnt(0)" ::: "memory");
        } else {
            XB_SPIN(xb_ld(&bar[XB_XGEN(b.x)]) == gen, bar);
            __builtin_amdgcn_fence(__ATOMIC_ACQUIRE, "agent");
            asm volatile("s_waitcnt vmcnt(0)" ::: "memory");
        }
    }
    __syncthreads();
}

constexpr int NWAVES = 8;
#ifndef MK_N_LAUNCHES
#define MK_N_LAUNCHES 1
#endif

constexpr int DM = 2048, INW = 4096, FF = 8192, DEPTH = 2;
constexpr int SP = 16384, SS = 2048;
constexpr int MP = 2 * SP, MS = 4 * SS, M = MP + MS;
constexpr int NCHUNK = 5, MC = M / NCHUNK;
constexpr int N_PHASES = 1 + DEPTH * (5 + (NCHUNK + 1) + 1);
constexpr float RMS_EPS = 1e-6f, LN_EPS = 1e-5f, LOG2E = 1.4426950408889634f;
constexpr int ZW = 3072, ZA_B = 0, Z_P = 512, ZB_Q = 1024, ZB_K = 1536, ZB_V = 1664, ZC_Q = 1792, ZC_K = 2304, ZC_V = 2432, Z_U = 2560;
constexpr int Y_A = 0, Y_B = 512, Y_C = 1024, Y_D = 1536;
static_assert(attn_body::ZP == ZW && attn_body::OP == DM, "attention body pitches");

constexpr size_t MiB = 1u << 20;
constexpr size_t WS_CTL = 0, CTL_ZERO_BYTES = 1 * MiB;
constexpr size_t WS_W = 2 * MiB, W_LAYER = 88 * MiB;
constexpr size_t WO_IN = 0, WO_OUT = 16 * MiB, WO_F1 = 24 * MiB, WO_F2 = 56 * MiB;
constexpr size_t WS_Z = WS_W + DEPTH * W_LAYER;
constexpr size_t WS_Y = WS_Z + (size_t)M * INW * 2;
constexpr size_t WS_U1 = WS_Z + (size_t)M * DM * 2;
static_assert(WS_U1 + (size_t)MC * FF * 2 <= WS_Y, "U1 fits above YP inside the z region");
constexpr size_t WS_H = WS_Y + (size_t)M * DM * 2;
constexpr size_t WS_RS = 1 * MiB;
constexpr size_t WS_KT = WS_H + (size_t)M * DM * 2;
constexpr size_t KV_IMG = (size_t)4 * (M / 64) * 8192;
constexpr size_t WS_VT = WS_KT + KV_IMG;
constexpr size_t WS_END = WS_VT + KV_IMG;
static_assert((size_t)MC * FF * 2 <= (size_t)M * DM * 2, "U chunk fits in the y region");
constexpr int CW_ATT = 8192;
constexpr int CW_BAR = 4096;

constexpr int RING_OFF = 0, RING_BYTES = 131072;
constexpr int LDSCTL_OFF = RING_BYTES, MISC_OFF = LDSCTL_OFF + 320;
constexpr int LDS_BYTES = 147456;
static_assert(MISC_OFF + 128 <= LDS_BYTES && attn_body::ATTN_LDS_BYTES <= RING_BYTES, "LDS map");

typedef unsigned u32x2 __attribute__((ext_vector_type(2)));
struct Frame {
    LAS unsigned char* lds;
    volatile LAS unsigned* MISC;
    int tid, lane, wave;
    int vcu, G;
    __device__ __forceinline__ const float* in(int i) const { asm volatile("" : "+s"(i)); return ((const float* const __attribute__((address_space(4)))*)__builtin_amdgcn_kernarg_segment_ptr())[i]; }
    __device__ __forceinline__ const float* xp() const { return in(0); }
    __device__ __forceinline__ const float* xs() const { return in(1); }
    __device__ __forceinline__ const float* pre_mix_g() const { return in(2); }
    __device__ __forceinline__ const float* w_in() const { return in(3); }
    __device__ __forceinline__ const float* conv_a_w() const { return in(4); }
    __device__ __forceinline__ const float* q_norm_g() const { return in(5); }
    __device__ __forceinline__ const float* k_norm_g() const { return in(6); }
    __device__ __forceinline__ const float* sink_c() const { return in(7); }
    __device__ __forceinline__ const float* conv_d_w() const { return in(8); }
    __device__ __forceinline__ const float* conv_d_b() const { return in(9); }
    __device__ __forceinline__ const float* ln_d_g() const { return in(10); }
    __device__ __forceinline__ const float* ln_d_b() const { return in(11); }
    __device__ __forceinline__ const float* w_out() const { return in(12); }
    __device__ __forceinline__ const float* post_mix_g() const { return in(13); }
    __device__ __forceinline__ const float* pre_ffn_g() const { return in(14); }
    __device__ __forceinline__ const float* w_ff1() const { return in(15); }
    __device__ __forceinline__ const float* w_ff2() const { return in(16); }
    __device__ __forceinline__ const float* post_ffn_g() const { return in(17); }
    float* out;
    unsigned char* ws;
    __device__ __forceinline__ bf16* Z() const { return (bf16*)(ws + WS_Z); }
    __device__ __forceinline__ bf16* Y() const { return (bf16*)(ws + WS_Y); }
    __device__ __forceinline__ bf16* H() const { return (bf16*)(ws + WS_H); }
    __device__ __forceinline__ float* RS() const { return (float*)(ws + WS_RS); }
    __device__ __forceinline__ char* KT() const { return (char*)(ws + WS_KT); }
    __device__ __forceinline__ char* VT() const { return (char*)(ws + WS_VT); }
    __device__ __forceinline__ gu32* ctl() const { return (gu32*)(ws + WS_CTL); }
};
__device__ __forceinline__ bf16* wt_ptr(Frame& F, int l, size_t off) { return (bf16*)(F.ws + WS_W + (size_t)l * W_LAYER + off); }

__device__ __forceinline__ float wave_sum(float v) {
#pragma unroll
    for (int o = 1; o < 64; o <<= 1) v += __shfl_xor(v, o);
    return v;
}
__device__ __forceinline__ unsigned cvtpk(float lo, float hi) { typedef float f2 __attribute__((ext_vector_type(2))); typedef __bf16 b2 __attribute__((ext_vector_type(2))); f2 v = {lo, hi}; b2 b = __builtin_convertvector(v, b2); return __builtin_bit_cast(unsigned, b); }
__device__ __forceinline__ float bflo(unsigned w) { return __uint_as_float(w << 16); }
__device__ __forceinline__ float bfhi(unsigned w) { return __uint_as_float(w & 0xffff0000u); }
__device__ __forceinline__ float sigmoidf_(float x) { return __builtin_amdgcn_rcpf(1.0f + __expf(-x)); }
__device__ __forceinline__ int win_dst_row(int ns) {
    if (ns >= 512 && ns < 1536) { const int v = ns >= 1024, r = ns - (v ? 1024 : 512); return 512 + 256 * (r >> 7) + 128 * v + (r & 127); }
    if (ns >= 3072) { const int v = ns >= 3584, r = ns - (v ? 3584 : 3072); return 3072 + 256 * (r >> 7) + 128 * v + (r & 127); }
    return ns;
}
template <bool WIN_ORDER>
__device__ __forceinline__ void p0_transpose_item(const float* W, int K, int N, bf16* WT, LAS unsigned char* scr, int item, int lane, const float* gk) {
    const int nblk = N / 64, kb = item / nblk, nb = item % nblk, k0 = 64 * kb, n0 = 64 * nb;
    const int sub = lane >> 4, nq = 4 * (lane & 15);
    f32x4 v[16]; float g[16];
#pragma unroll
    for (int i = 0; i < 16; ++i) v[i] = __builtin_nontemporal_load((const GAS f32x4*)(W + (size_t)(k0 + 4 * i + sub) * N + n0 + nq));
#pragma unroll
    for (int i = 0; i < 16; ++i) g[i] = gk ? gk[k0 + 4 * i + sub] : 1.0f;
#pragma unroll
    for (int i = 0; i < 16; ++i) { const int k = 4 * i + sub; const f32x4 x = v[i] * g[i]; const unsigned w01 = cvtpk(x.x, x.y), w23 = cvtpk(x.z, x.w);
        LAS unsigned short* t = (LAS unsigned short*)(scr + nq * 132 + 2 * k);
        t[0] = (unsigned short)w01; t[66] = (unsigned short)(w01 >> 16); t[132] = (unsigned short)w23; t[198] = (unsigned short)(w23 >> 16); }
    LDS_WAIT(); asm volatile("" ::: "memory");
    const int rbase = WIN_ORDER ? win_dst_row(n0) : n0, r16 = lane >> 2, cg = lane & 3;
#pragma unroll
    for (int j = 0; j < 8; ++j) { const int rbi = j >> 1, cbi = j & 1, p = 16 * rbi + r16, n = (p & ~31) + pg8::perm32(p & 31);
        const LAS unsigned* r = (const LAS unsigned*)(scr + n * 132 + (32 * cbi + 8 * cg) * 2);
        v4u o; o.x = r[0]; o.y = r[1]; o.z = r[2]; o.w = r[3];
        *(GAS v4u*)((char*)WT + pg8::tiled_off(rbase + p, k0 + 32 * cbi + 8 * cg, K)) = o; }
    LDS_WAIT(); asm volatile("" ::: "memory");
}
__device__ __forceinline__ const float* xin_row(Frame& F, int m) { return m < MP ? F.xp() + (size_t)m * DM : F.xs() + (size_t)(m - MP) * DM; }

__device__ __forceinline__ void p0_prologue(Frame& F) {
    LAS unsigned char* scr = F.lds + RING_OFF + F.wave * 16384;
    const int gw = F.vcu * NWAVES + F.wave, NGW = F.G * NWAVES;
    constexpr int I_IN = (DM / 64) * (INW / 64), I_OUT = (DM / 64) * (DM / 64), I_F1 = (DM / 64) * (FF / 64), I_F2 = (FF / 64) * (DM / 64), I_L = I_IN + I_OUT + I_F1 + I_F2;
    for (int it = gw; it < DEPTH * I_L; it += NGW) {
        const int l = it / I_L; int r = it % I_L;
        if (r < I_IN) { p0_transpose_item<true>(F.w_in() + (size_t)l * DM * INW, DM, INW, wt_ptr(F, l, WO_IN), scr, r, F.lane, F.pre_mix_g() + l * DM); continue; } r -= I_IN;
        if (r < I_OUT) { p0_transpose_item<false>(F.w_out() + (size_t)l * DM * DM, DM, DM, wt_ptr(F, l, WO_OUT), scr, r, F.lane, nullptr); continue; } r -= I_OUT;
        if (r < I_F1) { p0_transpose_item<false>(F.w_ff1() + (size_t)l * DM * FF, DM, FF, wt_ptr(F, l, WO_F1), scr, r, F.lane, F.pre_ffn_g() + l * DM); continue; } r -= I_F1;
        p0_transpose_item<false>(F.w_ff2() + (size_t)l * FF * DM, FF, DM, wt_ptr(F, l, WO_F2), scr, r, F.lane, nullptr);
    }
    for (int mb = gw; mb < M; mb += 4 * NGW) {
        f32x4 x[4][4][2];
#pragma unroll
        for (int k = 0; k < 4; ++k) { const int m = mb + k * NGW; if (m < M) { const float* xr = xin_row(F, m);
#pragma unroll
            for (int j = 0; j < 4; ++j) { x[k][j][0] = __builtin_nontemporal_load((const GAS f32x4*)(xr + j * 512 + F.lane * 8)); x[k][j][1] = __builtin_nontemporal_load((const GAS f32x4*)(xr + j * 512 + F.lane * 8 + 4)); } } }
#pragma unroll
        for (int k = 0; k < 4; ++k) { const int m = mb + k * NGW; if (m < M) { float ss = 0.f;
#pragma unroll
            for (int j = 0; j < 4; ++j) { const f32x4 a = x[k][j][0], b = x[k][j][1]; ss += (a.x * a.x + a.y * a.y) + (a.z * a.z + a.w * a.w) + (b.x * b.x + b.y * b.y) + (b.z * b.z + b.w * b.w);
                v4u o; o.x = cvtpk(a.x, a.y); o.y = cvtpk(a.z, a.w); o.z = cvtpk(b.x, b.y); o.w = cvtpk(b.z, b.w);
                *(GAS v4u*)(F.H() + (size_t)m * DM + j * 512 + F.lane * 8) = o; }
            const float r = rsqrtf(wave_sum(ss) * (1.0f / DM) + RMS_EPS);
            if (F.lane == 0) F.RS()[m] = r; } }
    }
}

template <bool FINAL, bool FIRSTX>
__device__ __forceinline__ void norm_pass(Frame& F, const bf16* YPb, const float* gpost) {
    constexpr int R = FIRSTX ? 2 : 4;
    const int gw = F.vcu * NWAVES + F.wave, NGW = F.G * NWAVES;
    f32x4 ga[4][2];
#pragma unroll
    for (int j = 0; j < 4; ++j) { ga[j][0] = *(const GAS f32x4*)(gpost + j * 512 + F.lane * 8); ga[j][1] = *(const GAS f32x4*)(gpost + j * 512 + F.lane * 8 + 4); }
    for (int mb = gw; mb < M; mb += R * NGW) {
        v4u y[R][4]; v4u xb[R][4]; f32x4 xf[FIRSTX ? R : 1][4][2];
#pragma unroll
        for (int k = 0; k < R; ++k) { const int m = mb + k * NGW; if (m < M) {
#pragma unroll
            for (int j = 0; j < 4; ++j) y[k][j] = __builtin_nontemporal_load((const GAS v4u*)(YPb + (size_t)m * DM + j * 512 + F.lane * 8));
            if constexpr (FIRSTX) { const float* xr = xin_row(F, m);
#pragma unroll
                for (int j = 0; j < 4; ++j) { xf[k][j][0] = __builtin_nontemporal_load((const GAS f32x4*)(xr + j * 512 + F.lane * 8)); xf[k][j][1] = __builtin_nontemporal_load((const GAS f32x4*)(xr + j * 512 + F.lane * 8 + 4)); }
            } else {
#pragma unroll
                for (int j = 0; j < 4; ++j) xb[k][j] = __builtin_nontemporal_load((const GAS v4u*)(F.H() + (size_t)m * DM + j * 512 + F.lane * 8));
            } } }
#pragma unroll
        for (int k = 0; k < R; ++k) { const int m = mb + k * NGW; if (m < M) {
            float ss = 0.f;
#pragma unroll
            for (int j = 0; j < 4; ++j) { const v4u w = y[k][j]; const float a0 = bflo(w.x), a1 = bfhi(w.x), a2 = bflo(w.y), a3 = bfhi(w.y), a4 = bflo(w.z), a5 = bfhi(w.z), a6 = bflo(w.w), a7 = bfhi(w.w);
                ss += (a0 * a0 + a1 * a1) + (a2 * a2 + a3 * a3) + (a4 * a4 + a5 * a5) + (a6 * a6 + a7 * a7); }
            const float r = rsqrtf(wave_sum(ss) * (1.0f / DM) + RMS_EPS);
            float s2 = 0.f;
#pragma unroll
            for (int j = 0; j < 4; ++j) { const v4u w = y[k][j];
                const f32x4 y0 = (f32x4){bflo(w.x), bfhi(w.x), bflo(w.y), bfhi(w.y)}, y1 = (f32x4){bflo(w.z), bfhi(w.z), bflo(w.w), bfhi(w.w)};
                f32x4 x0, x1;
                if constexpr (FIRSTX) { x0 = xf[k][j][0]; x1 = xf[k][j][1]; }
                else { const v4u q = xb[k][j]; x0 = (f32x4){bflo(q.x), bfhi(q.x), bflo(q.y), bfhi(q.y)}; x1 = (f32x4){bflo(q.z), bfhi(q.z), bflo(q.w), bfhi(q.w)}; }
                const f32x4 v0 = x0 + y0 * r * ga[j][0], v1 = x1 + y1 * r * ga[j][1];
                if constexpr (FINAL) { __builtin_nontemporal_store(v0, (GAS f32x4*)(F.out + (size_t)m * DM + j * 512 + F.lane * 8)); __builtin_nontemporal_store(v1, (GAS f32x4*)(F.out + (size_t)m * DM + j * 512 + F.lane * 8 + 4)); }
                else { s2 += (v0.x * v0.x + v0.y * v0.y) + (v0.z * v0.z + v0.w * v0.w) + (v1.x * v1.x + v1.y * v1.y) + (v1.z * v1.z + v1.w * v1.w);
                    v4u o; o.x = cvtpk(v0.x, v0.y); o.y = cvtpk(v0.z, v0.w); o.z = cvtpk(v1.x, v1.y); o.w = cvtpk(v1.z, v1.w);
                    *(GAS v4u*)(F.H() + (size_t)m * DM + j * 512 + F.lane * 8) = o; } }
            if constexpr (!FINAL) { const float r2 = rsqrtf(wave_sum(s2) * (1.0f / DM) + RMS_EPS); if (F.lane == 0) F.RS()[m] = r2; }
        } }
    }
}

constexpr int PREP_T = 32, PREP_U_ROWS = PREP_T + 30, PREP_TW = PREP_T / NWAVES;
constexpr int PREP_V_OFF = PREP_U_ROWS * 512 * 2;
static_assert(PREP_V_OFF % 16 == 0 && PREP_V_OFF + PREP_T * 512 * 4 <= RING_BYTES, "prep LDS");
__device__ __forceinline__ void rope_store4(bf16* p1, bf16* p2, const float (&a)[4], const float (&b)[4], const float (&c)[4], const float (&s)[4], float scale, bool pred) {
    float o1[4], o2[4];
#pragma unroll
    for (int k = 0; k < 4; ++k) { o1[k] = (a[k] * c[k] - b[k] * s[k]) * scale; o2[k] = (b[k] * c[k] + a[k] * s[k]) * scale; }
    if (pred) { u32x2 w1, w2; w1.x = cvtpk(o1[0], o1[1]); w1.y = cvtpk(o1[2], o1[3]); w2.x = cvtpk(o2[0], o2[1]); w2.y = cvtpk(o2[2], o2[3]);
        *(GAS u32x2*)p1 = w1; *(GAS u32x2*)p2 = w2; }
}
__device__ __forceinline__ void load4x2(const bf16* p1, const bf16* p2, float (&a)[4], float (&b)[4]) {
    const u32x2 w1 = *(const GAS u32x2*)p1, w2 = *(const GAS u32x2*)p2;
    a[0] = bflo(w1.x); a[1] = bfhi(w1.x); a[2] = bflo(w1.y); a[3] = bfhi(w1.y); b[0] = bflo(w2.x); b[1] = bfhi(w2.x); b[2] = bflo(w2.y); b[3] = bfhi(w2.y);
}
__device__ __forceinline__ void unpack8(const v4u w, float (&f)[8]) { f[0] = bflo(w.x); f[1] = bfhi(w.x); f[2] = bflo(w.y); f[3] = bfhi(w.y); f[4] = bflo(w.z); f[5] = bfhi(w.z); f[6] = bflo(w.w); f[7] = bfhi(w.w); }

__device__ __forceinline__ void prep_phase(Frame& F, const int l) {
    LAS bf16* Ub = (LAS bf16*)(F.lds + RING_OFF);
    LAS float* V = (LAS float*)(F.lds + RING_OFF + PREP_V_OFF);
    const int lane = F.lane, tid = F.tid, wave = F.wave;
    const float* cdw = F.conv_d_w() + (size_t)l * 31 * 512;
    float wd[31];
#pragma unroll
    for (int j = 0; j < 31; ++j) wd[j] = cdw[j * 512 + tid];
    const float cdb = F.conv_d_b()[l * 512 + tid];
    const float* caw = F.conv_a_w() + (size_t)l * 3 * 512;
    const float* gk = F.k_norm_g() + l * 64;
    const int c0 = lane * 8;
    f32x4 wa[3][2];
#pragma unroll
    for (int j = 0; j < 3; ++j) { wa[j][0] = *(const GAS f32x4*)(caw + j * 512 + c0); wa[j][1] = *(const GAS f32x4*)(caw + j * 512 + c0 + 4); }
    const f32x4 g0 = *(const GAS f32x4*)(F.ln_d_g() + l * 512 + c0), g1 = *(const GAS f32x4*)(F.ln_d_g() + l * 512 + c0 + 4), b0 = *(const GAS f32x4*)(F.ln_d_b() + l * 512 + c0), b1 = *(const GAS f32x4*)(F.ln_d_b() + l * 512 + c0 + 4);
    constexpr int NST = (PREP_U_ROWS * 64 + 511) / 512;
    for (int item = F.vcu; item < M / PREP_T; item += F.G) {
        const int m0 = item * PREP_T;
        int t0, S; if (m0 < MP) { t0 = m0 & (SP - 1); S = SP; } else { t0 = (m0 - MP) & (SS - 1); S = SS; }
        v4u stg[NST];
#pragma unroll
        for (int it = 0; it < NST; ++it) { const int id = it * 512 + tid, rr = id >> 6, ch = (id & 63) * 8, tp = t0 - 15 + rr;
            stg[it] = (v4u){0u, 0u, 0u, 0u};
            if (id < PREP_U_ROWS * 64 && tp >= 0 && tp < S) stg[it] = *(const GAS v4u*)(F.Z() + (size_t)(m0 - 15 + rr) * ZW + Z_U + ch); }
        const int ta = t0 + PREP_TW * wave, ma = m0 + PREP_TW * wave;
        v4u pr[PREP_TW + 2], ab[PREP_TW];
#pragma unroll
        for (int j = 0; j < PREP_TW + 2; ++j) { const int tp = ta + j - 1; pr[j] = (v4u){0u, 0u, 0u, 0u};
            if (tp >= 0 && tp < S) pr[j] = *(const GAS v4u*)(F.Z() + (size_t)(ma + j - 1) * ZW + Z_P + c0); }
#pragma unroll
        for (int j = 0; j < PREP_TW; ++j) ab[j] = *(const GAS v4u*)(F.Z() + (size_t)(ma + j) * ZW + ZA_B + c0);
        const int grp = lane >> 5, hk = (lane >> 3) & 1, sl = lane & 7, half = sl >> 2;
        const int i0 = grp ? 4 * sl : 4 * (sl & 3);
        const int koff = grp ? (ZC_K + hk * 64 + i0) : (ZB_K + hk * 64 + half * 32 + i0), kd = grp ? 32 : 16;
        u32x2 kw[PREP_TW / 2][2];
#pragma unroll
        for (int q = 0; q < PREP_TW / 2; ++q) { const bf16* p1 = F.Z() + (size_t)(ma + 2 * q + ((lane >> 4) & 1)) * ZW + koff; kw[q][0] = *(const GAS u32x2*)p1; kw[q][1] = *(const GAS u32x2*)(p1 + kd); }
        unsigned vld[2][4];
#pragma unroll
        for (int it = 0; it < 2; ++it) { const int id = it * 512 + tid, qd = id >> 7, cb = (id >> 5) & 3, dp = id & 31;
#pragma unroll
            for (int j = 0; j < 4; ++j) vld[it][j] = *(const GAS unsigned*)(F.Z() + (size_t)(m0 + 4 * qd + j) * ZW + ((cb >> 1) ? ZC_V : ZB_V) + (cb & 1) * 64 + 2 * dp); }
#pragma unroll
        for (int it = 0; it < NST; ++it) { const int id = it * 512 + tid, rr = id >> 6, ch = (id & 63) * 8;
            if (id < PREP_U_ROWS * 64) *(LAS v4u*)(Ub + rr * 512 + ch) = stg[it]; }
#pragma unroll
        for (int it = 0; it < 2; ++it) { const int id = it * 512 + tid, qd = id >> 7, cb = (id >> 5) & 3, dp = id & 31;
            int w0 = 0, w1 = 0;
            w0 = __builtin_amdgcn_cvt_pk_fp8_f32(bflo(vld[it][0]), bflo(vld[it][1]), w0, false); w0 = __builtin_amdgcn_cvt_pk_fp8_f32(bflo(vld[it][2]), bflo(vld[it][3]), w0, true);
            w1 = __builtin_amdgcn_cvt_pk_fp8_f32(bfhi(vld[it][0]), bfhi(vld[it][1]), w1, false); w1 = __builtin_amdgcn_cvt_pk_fp8_f32(bfhi(vld[it][2]), bfhi(vld[it][3]), w1, true);
            char* vt = F.VT() + ((size_t)(cb * (M / 64) + (m0 >> 6)) << 12) + (qd & 1) * 2048 + ((m0 >> 5) & 1) * 1024 + 4 * (qd >> 1);
            *(GAS int*)(vt + (2 * dp) * 16) = w0; *(GAS int*)(vt + (2 * dp + 1) * 16) = w1; }
#pragma unroll
        for (int q = 0; q < PREP_TW; ++q) { float acc[8], bb[8];
#pragma unroll
            for (int k = 0; k < 8; ++k) acc[k] = 0.f;
#pragma unroll
            for (int j = 0; j < 3; ++j) { float pp[8]; unpack8(pr[q + j], pp);
                acc[0] += wa[j][0].x * pp[0]; acc[1] += wa[j][0].y * pp[1]; acc[2] += wa[j][0].z * pp[2]; acc[3] += wa[j][0].w * pp[3];
                acc[4] += wa[j][1].x * pp[4]; acc[5] += wa[j][1].y * pp[5]; acc[6] += wa[j][1].z * pp[6]; acc[7] += wa[j][1].w * pp[7]; }
            unpack8(ab[q], bb);
            v4u o; o.x = cvtpk(bb[0] * acc[0], bb[1] * acc[1]); o.y = cvtpk(bb[2] * acc[2], bb[3] * acc[3]); o.z = cvtpk(bb[4] * acc[4], bb[5] * acc[5]); o.w = cvtpk(bb[6] * acc[6], bb[7] * acc[7]);
            *(GAS v4u*)(F.Y() + (size_t)(ma + q) * DM + Y_A + c0) = o; }
#pragma unroll
        for (int q = 0; q < PREP_TW / 2; ++q) {
            const int tk = PREP_TW * wave + 2 * q + ((lane >> 4) & 1), tpos = t0 + tk;
            const int pos = grp ? tpos : (half ? (tpos & 63) : (tpos >> 6));
            const int mr = m0 + tk, f1 = grp ? i0 : half * 32 + i0, f2 = f1 + kd;
            char* kt = F.KT() + ((size_t)((grp * 2 + hk) * (M / 64) + (mr >> 6)) << 12) + (mr & 63) * 16;
            int* p1 = (int*)(kt + ((f1 >> 3) & 1) * 2048 + (f1 >> 5) * 1024 + ((f1 >> 4) & 1) * 8 + (f1 & 7)); int* p2 = (int*)(kt + ((f2 >> 3) & 1) * 2048 + (f2 >> 5) * 1024 + ((f2 >> 4) & 1) * 8 + (f2 & 7));
            float cs[4], sn[4];
#pragma unroll
            for (int k = 0; k < 4; ++k) sincos_f((float)pos * INVF[grp ? (i0 + k) : 2 * (i0 + k)], sn[k], cs[k]);
            float a[4], b[4];
            a[0] = bflo(kw[q][0].x); a[1] = bfhi(kw[q][0].x); a[2] = bflo(kw[q][0].y); a[3] = bfhi(kw[q][0].y); b[0] = bflo(kw[q][1].x); b[1] = bfhi(kw[q][1].x); b[2] = bflo(kw[q][1].y); b[3] = bfhi(kw[q][1].y);
            float ss = (a[0] * a[0] + a[1] * a[1]) + (a[2] * a[2] + a[3] * a[3]) + (b[0] * b[0] + b[1] * b[1]) + (b[2] * b[2] + b[3] * b[3]);
            ss += __shfl_xor(ss, 1); ss += __shfl_xor(ss, 2); ss += __shfl_xor(ss, 4);
            const float r = grp ? 1.0f : rsqrtf(ss * (1.0f / 64.0f) + RMS_EPS);
#pragma unroll
            for (int k = 0; k < 4; ++k) { const int gi = grp ? 0 : (half * 32 + i0);
                const float g1k = grp ? 1.0f : gk[gi + k], g2k = grp ? 1.0f : gk[gi + 16 + k]; a[k] = a[k] * r * g1k; b[k] = b[k] * r * g2k; }
            {   float o1[4], o2[4];
#pragma unroll
                for (int k = 0; k < 4; ++k) { o1[k] = a[k] * cs[k] - b[k] * sn[k]; o2[k] = b[k] * cs[k] + a[k] * sn[k]; }
                int w1 = 0, w2 = 0;
                w1 = __builtin_amdgcn_cvt_pk_fp8_f32(o1[0], o1[1], w1, false); w1 = __builtin_amdgcn_cvt_pk_fp8_f32(o1[2], o1[3], w1, true);
                w2 = __builtin_amdgcn_cvt_pk_fp8_f32(o2[0], o2[1], w2, false); w2 = __builtin_amdgcn_cvt_pk_fp8_f32(o2[2], o2[3], w2, true);
                *(GAS int*)p1 = w1; *(GAS int*)p2 = w2; }
        }
        __syncthreads();
        {   float uu[PREP_U_ROWS];
#pragma unroll
            for (int rr = 0; rr < PREP_U_ROWS; ++rr) uu[rr] = __uint_as_float((unsigned)Ub[rr * 512 + tid] << 16);
#pragma unroll
            for (int tt = 0; tt < PREP_T; ++tt) { float a = cdb;
#pragma unroll
                for (int j = 0; j < 31; ++j) a += wd[j] * uu[tt + j];
                V[tt * 512 + tid] = a; } }
        __syncthreads();
        {   f32x4 v0[PREP_TW], v1[PREP_TW]; float sm[PREP_TW];
#pragma unroll
            for (int q = 0; q < PREP_TW; ++q) { const int tt = PREP_TW * wave + q; v0[q] = *(const LAS f32x4*)(V + tt * 512 + c0); v1[q] = *(const LAS f32x4*)(V + tt * 512 + c0 + 4);
                sm[q] = (v0[q].x + v0[q].y) + (v0[q].z + v0[q].w) + (v1[q].x + v1[q].y) + (v1[q].z + v1[q].w); }
#pragma unroll
            for (int o = 1; o < 64; o <<= 1)
#pragma unroll
                for (int q = 0; q < PREP_TW; ++q) sm[q] += __shfl_xor(sm[q], o);
#pragma unroll
            for (int q = 0; q < PREP_TW; ++q) { const float mean = sm[q] * (1.0f / 512.0f); v0[q] = v0[q] - mean; v1[q] = v1[q] - mean;
                sm[q] = (v0[q].x * v0[q].x + v0[q].y * v0[q].y) + (v0[q].z * v0[q].z + v0[q].w * v0[q].w) + (v1[q].x * v1[q].x + v1[q].y * v1[q].y) + (v1[q].z * v1[q].z + v1[q].w * v1[q].w); }
#pragma unroll
            for (int o = 1; o < 64; o <<= 1)
#pragma unroll
                for (int q = 0; q < PREP_TW; ++q) sm[q] += __shfl_xor(sm[q], o);
#pragma unroll
            for (int q = 0; q < PREP_TW; ++q) { const int m = m0 + PREP_TW * wave + q; const float r = rsqrtf(sm[q] * (1.0f / 512.0f) + LN_EPS);
                f32x4 y0 = v0[q] * r * g0 + b0, y1 = v1[q] * r * g1 + b1;
                y0 = (f32x4){y0.x * sigmoidf_(y0.x), y0.y * sigmoidf_(y0.y), y0.z * sigmoidf_(y0.z), y0.w * sigmoidf_(y0.w)};
                y1 = (f32x4){y1.x * sigmoidf_(y1.x), y1.y * sigmoidf_(y1.y), y1.z * sigmoidf_(y1.z), y1.w * sigmoidf_(y1.w)};
                v4u o; o.x = cvtpk(y0.x, y0.y); o.y = cvtpk(y0.z, y0.w); o.z = cvtpk(y1.x, y1.y); o.w = cvtpk(y1.z, y1.w);
                *(GAS v4u*)(F.Y() + (size_t)m * DM + Y_D + c0) = o; } }
        __syncthreads();
    }
}

__device__ __forceinline__ void attn_phase_all(Frame& F, const int l, char* shm) {
    typedef attn_body::bf16 abf;
    const abf* Z = (const abf*)F.Z(); abf* Y = (abf*)F.Y();
    float gqm = __builtin_fabsf(F.q_norm_g()[l * 64 + F.lane]), gkm = __builtin_fabsf(F.k_norm_g()[l * 64 + F.lane]);
#pragma unroll
    for (int o = 1; o < 64; o <<= 1) { gqm = __builtin_fmaxf(gqm, __shfl_xor(gqm, o)); gkm = __builtin_fmaxf(gkm, __shfl_xor(gkm, o)); }
    const int ref0 = __builtin_amdgcn_readfirstlane((int)__builtin_ceilf(__builtin_fminf(__builtin_fmaxf((8.0f * LOG2E) * gqm * gkm - 15.5f, 0.f), 100.f)));
    const bool fast = ref0 <= 6;
    const float pscale = __int_as_float((127 + ref0) << 23);
    LAS int* const tkw = (LAS int*)(F.lds + LDSCTL_OFF + 64);
    unsigned* const ctrA = (unsigned*)(F.ctl() + CW_ATT + l * 128), * const ctrB = ctrA + 64;
#define ATT_BCAST(dst, v) do { if (F.tid == 0) *tkw = (v); asm volatile("s_waitcnt lgkmcnt(0)\n\ts_barrier" ::: "memory"); { const int r_ = *tkw; asm volatile("s_waitcnt lgkmcnt(0)\n\ts_barrier" ::: "memory"); (dst) = __builtin_amdgcn_readfirstlane(r_); } } while (0)
    {   int i = 0, tkt = -1;
        for (;;) {
            int idx;
            if (tkt < 0) { idx = i * F.G + F.vcu; ++i; if (idx >= 1024) { int t0 = 0; if (F.tid == 0) t0 = (int)__hip_atomic_fetch_add(ctrA, 1u, __ATOMIC_RELAXED, __HIP_MEMORY_SCOPE_AGENT); ATT_BCAST(tkt, t0); continue; } }
            else { if (tkt >= 256) break; idx = 1024 + tkt; }
            int tn = 0; if (tkt >= 0 && F.tid == 0) tn = (int)__hip_atomic_fetch_add(ctrA, 1u, __ATOMIC_RELAXED, __HIP_MEMORY_SCOPE_AGENT);
            const int r = idx >> 8, v = idx & 255, x = v >> 5, j = v & 31;
            int head, kv, qb, NT; long srow;
            if (r < 4) { const int sx = x >> 1; kv = sx & 1; head = kv * 4 + (x & 1) * 2 + (r >> 1); qb = (r & 1) * 32 + j; srow = (long)(sx >> 1) * SP; NT = SP / 64; }
            else { kv = x & 1; head = kv * 4 + (j >> 3); qb = j & 7; srow = (long)MP + (long)(x >> 1) * SS; NT = SS / 64; }
            const long qrow = srow + qb * 256;
            const size_t kvo = ((size_t)(kv * (M / 64)) + (size_t)(srow >> 6)) << 13;
            if (fast) attn_body::attn_unit<2, 8, 1>(Z + qrow * ZW + ZB_Q + head * 64, F.KT() + (kvo >> 1), F.VT() + (kvo >> 1), Y + qrow * DM + Y_B + head * 64, NT, 0, 0, pscale, qb * 256, F.q_norm_g() + l * 64, shm);
            else attn_body::attn_unit<0, 8, 1>(Z + qrow * ZW + ZB_Q + head * 64, F.KT() + (kvo >> 1), F.VT() + (kvo >> 1), Y + qrow * DM + Y_B + head * 64, NT, 0, 0, 0.f, qb * 256, F.q_norm_g() + l * 64, shm);
            if (tkt >= 0) ATT_BCAST(tkt, tn);
        }
    }
    {   int tkt, t0 = 0; if (F.tid == 0) t0 = (int)__hip_atomic_fetch_add(ctrB, 1u, __ATOMIC_RELAXED, __HIP_MEMORY_SCOPE_AGENT); ATT_BCAST(tkt, t0);
        while (tkt < 1280) {
            int tn = 0; if (F.tid == 0) tn = (int)__hip_atomic_fetch_add(ctrB, 1u, __ATOMIC_RELAXED, __HIP_MEMORY_SCOPE_AGENT);
            const int u = tkt, qblk = u >> 3, head = u & 7, kv = head >> 2; const long qrow = (long)qblk * 256;
            long srow; int S; if (qrow < MP) { srow = (qrow / SP) * SP; S = SP; } else { srow = MP + ((qrow - MP) / SS) * SS; S = SS; }
            const int q0 = (int)(qrow - srow);
            const float sink2 = F.sink_c()[l * 8 + head] * LOG2E;
            const size_t kvo = ((size_t)((2 + kv) * (M / 64)) + (size_t)(srow >> 6)) << 13;
            attn_body::attn_unit<1, 8, 2>(Z + qrow * ZW + ZC_Q + head * 64, F.KT() + (kvo >> 1), F.VT() + (kvo >> 1), Y + qrow * DM + Y_C + head * 64, 8, q0, S, sink2, q0, nullptr, shm);
            ATT_BCAST(tkt, tn);
        }
    }
#undef ATT_BCAST
}

struct Args { const float* in[18]; float* out; unsigned char* ws; int ph_lo, ph_hi, li, pad; };
__global__ void __launch_bounds__(NWAVES * 64, 2) fwd(Args args) {
    extern __shared__ __attribute__((aligned(16))) unsigned char lds[];
    Frame F;
    F.lds = (LAS unsigned char*)lds;
    F.MISC = (volatile LAS unsigned*)(F.lds + MISC_OFF);
    F.tid = threadIdx.x; F.lane = F.tid & 63; F.wave = __builtin_amdgcn_readfirstlane(F.tid >> 6);
    F.G = gridDim.x; { const int bx = blockIdx.x; F.vcu = (F.G % 8 == 0) ? (bx % 8) * (F.G / 8) + bx / 8 : bx; }
    unsigned char* ws = args.ws; F.ws = ws;
    F.out = args.out;
    bf16* const YPb = F.Z();
    bf16* const U0 = F.Y();
    bf16* const U1 = (bf16*)(ws + WS_U1);
    for (int u = F.tid; u < (LDS_BYTES - LDSCTL_OFF) / 4; u += NWAVES * 64) ((LAS unsigned*)(F.lds + LDSCTL_OFF))[u] = 0u;
    __syncthreads();
    XcdBarrier bar; bar.bar = (unsigned*)(F.ctl() + CW_BAR); bar.x = 0; bar.st = nullptr;
    if (MK_N_LAUNCHES == 1) bar = xcd_barrier_post((unsigned*)(F.ctl() + CW_BAR), F.MISC + 8);
    const int lo = args.ph_lo, hi = args.ph_hi; int ph = 0;
#define PH_BEGIN if (lo <= ph && ph < hi) { { int t_ = threadIdx.x; asm volatile("" : "+v"(t_)); F.tid = t_; F.lane = t_ & 63; F.wave = __builtin_amdgcn_readfirstlane(t_ >> 6); }
#define PH_END   if (ph + 1 < hi) xcd_barrier(bar); } ++ph;

    PH_BEGIN p0_prologue(F); PH_END

#pragma unroll 1
    for (int l = 0; l < DEPTH; ++l) {
        PH_BEGIN { pg8::Gemm g{F.H(), wt_ptr(F, l, WO_IN), M, INW, DM}; pg8::StaticOrder S; S.init(M, INW, F.G, (int)blockIdx.x);
            pg8::EpiIn E{F.Z(), ZW, F.RS()};
            pg8::gemm_phase<pg8::EpiIn, pg8::StaticOrder, true, true>(F.lds + RING_OFF, g, S, E); } PH_END
        PH_BEGIN prep_phase(F, l); PH_END
        PH_BEGIN attn_phase_all(F, l, (char*)lds + RING_OFF); PH_END
        PH_BEGIN { pg8::Gemm g{F.Y(), wt_ptr(F, l, WO_OUT), M, DM, DM}; pg8::StaticOrder S; S.init(M, DM, F.G, (int)blockIdx.x);
            pg8::EpiBf16<0, false> E{YPb, DM, nullptr};
            pg8::gemm_phase<pg8::EpiBf16<0, false>, pg8::StaticOrder, true, true>(F.lds + RING_OFF, g, S, E); } PH_END
        PH_BEGIN if (l == 0) norm_pass<false, true>(F, YPb, F.post_mix_g() + l * DM); else norm_pass<false, false>(F, YPb, F.post_mix_g() + l * DM); PH_END
        PH_BEGIN { pg8::Gemm g{F.H(), wt_ptr(F, l, WO_F1), MC, FF, DM}; pg8::StaticOrder S; S.init(MC, FF, F.G, (int)blockIdx.x);
            pg8::EpiBf16<2, true, true> E{U0, FF, F.RS()};
            pg8::gemm_phase<pg8::EpiBf16<2, true, true>, pg8::StaticOrder, true, true>(F.lds + RING_OFF, g, S, E); } PH_END
#pragma unroll 1
        for (int c = 0; c + 1 < NCHUNK; ++c) {
            PH_BEGIN {
                bf16* const Ur = (c & 1) ? U1 : U0; bf16* const Uw = (c & 1) ? U0 : U1;
                { pg8::Gemm g{Ur, wt_ptr(F, l, WO_F2), MC, DM, FF}; pg8::StaticOrder S; S.init(MC, DM, F.G, (int)blockIdx.x);
                  pg8::EpiBf16<0, false> E{YPb + (size_t)c * MC * DM, DM, nullptr};
                  pg8::gemm_phase<pg8::EpiBf16<0, false>, pg8::StaticOrder, true, true, true>(F.lds + RING_OFF, g, S, E); }
                __syncthreads();
                { pg8::Gemm g{F.H() + (size_t)(c + 1) * MC * DM, wt_ptr(F, l, WO_F1), MC, FF, DM}; pg8::StaticOrder S; S.init(MC, FF, F.G, (int)blockIdx.x);
                  pg8::EpiBf16<2, true, true> E{Uw, FF, F.RS() + (size_t)(c + 1) * MC};
                  pg8::gemm_phase<pg8::EpiBf16<2, true, true>, pg8::StaticOrder, true, true>(F.lds + RING_OFF, g, S, E); }
            } PH_END
        }
        PH_BEGIN { pg8::Gemm g{((NCHUNK - 1) & 1) ? U1 : U0, wt_ptr(F, l, WO_F2), MC, DM, FF}; pg8::StaticOrder S; S.init(MC, DM, F.G, (int)blockIdx.x);
            pg8::EpiBf16<0, false> E{YPb + (size_t)(NCHUNK - 1) * MC * DM, DM, nullptr};
            pg8::gemm_phase<pg8::EpiBf16<0, false>, pg8::StaticOrder, true, true, true>(F.lds + RING_OFF, g, S, E); } PH_END
        PH_BEGIN if (l + 1 < DEPTH) norm_pass<false, false>(F, YPb, F.post_ffn_g() + l * DM); else norm_pass<true, false>(F, YPb, F.post_ffn_g() + l * DM); PH_END
    }
#undef PH_BEGIN
#undef PH_END
}

extern "C" void kernel_launch(void* const* d_in, const int* in_sizes, int n_in, void* d_out, int out_size, void* d_ws, size_t ws_size, hipStream_t stream) {
    static int grid = 0;
    if (grid == 0) {
        if (n_in != 18 || in_sizes[0] != MP * DM || in_sizes[1] != MS * DM || out_size != M * DM || ws_size < WS_END) {
            fprintf(stderr, "kernel_launch: unexpected shapes (n_in %d, in0 %d, in1 %d, out %d, ws %zu; need ws >= %zu); nothing launched\n", n_in, n_in > 0 ? in_sizes[0] : -1, n_in > 1 ? in_sizes[1] : -1, out_size, ws_size, (size_t)WS_END); grid = -1; return; }
        int dev = 0, cus = 0, per_cu = 0;
        if (hipGetDevice(&dev) != hipSuccess || hipDeviceGetAttribute(&cus, hipDeviceAttributeMultiprocessorCount, dev) != hipSuccess) { fprintf(stderr, "kernel_launch: device query failed\n"); grid = -1; return; }
        if (hipFuncSetAttribute((const void*)fwd, hipFuncAttributeMaxDynamicSharedMemorySize, LDS_BYTES) != hipSuccess) { fprintf(stderr, "kernel_launch: hipFuncSetAttribute failed\n"); grid = -1; return; }
        if (hipOccupancyMaxActiveBlocksPerMultiprocessor(&per_cu, (const void*)fwd, NWAVES * 64, LDS_BYTES) != hipSuccess || per_cu < 1)
            fprintf(stderr, "kernel_launch: note: occupancy query reports %d workgroups per CU\n", per_cu);
        (void)hipGetLastError();
        grid = cus;
    }
    if (grid < 0) return;
    if (hipMemsetAsync((char*)d_ws + WS_CTL, 0, CTL_ZERO_BYTES, stream) != hipSuccess) { fprintf(stderr, "kernel_launch: memset failed\n"); return; }
    Args a{};
    for (int i = 0; i < 18; ++i) a.in[i] = (const float*)d_in[i];
    a.out = (float*)d_out; a.ws = (unsigned char*)d_ws;
    for (int li = 0; li < MK_N_LAUNCHES; ++li) {
        a.ph_lo = (MK_N_LAUNCHES == 1) ? 0 : li; a.ph_hi = (MK_N_LAUNCHES == 1) ? N_PHASES : li + 1; a.li = li; a.pad = 0;
        hipLaunchKernelGGL(fwd, dim3(grid), dim3(NWAVES * 64), LDS_BYTES, stream, a);
        const hipError_t le = hipPeekAtLastError();
        if (le != hipSuccess) { fprintf(stderr, "kernel_launch: launch %d failed: %s\n", li, hipGetErrorName(le)); break; }
    }
}
```

```cpp
#include <hip/hip_runtime.h>
#include <hip/hip_bf16.h>
#include <cstdio>
#include <cstdint>
#include <cmath>
__constant__ float INVF[32] = {
    1.000000000e+00f, 7.498942018e-01f, 5.623413324e-01f, 4.216965139e-01f, 3.162277639e-01f, 2.371373922e-01f, 1.778279394e-01f, 1.333521456e-01f,
    1.000000015e-01f, 7.498941571e-02f, 5.623412877e-02f, 4.216964915e-02f, 3.162277862e-02f, 2.371373586e-02f, 1.778279431e-02f, 1.333521493e-02f,
    9.999999776e-03f, 7.498942316e-03f, 5.623413250e-03f, 4.216964822e-03f, 3.162277862e-03f, 2.371373819e-03f, 1.778279431e-03f, 1.333521446e-03f,
    1.000000047e-03f, 7.498941850e-04f, 5.623413017e-04f, 4.216965463e-04f, 3.162277862e-04f, 2.371373848e-04f, 1.778279402e-04f, 1.333521504e-04f};

__device__ __forceinline__ void sincos_f(float ang, float& s, float& c) {
    const double rev = (double)ang * 0.15915494309189535; const float fr = (float)(rev - __builtin_rint(rev));
    s = __builtin_amdgcn_sinf(fr); c = __builtin_amdgcn_cosf(fr);
}

namespace pg8 {
#define PG8_LAS __attribute__((address_space(3)))
typedef unsigned short bf16_t;
typedef short bf16x8 __attribute__((ext_vector_type(8)));
typedef float f32x4 __attribute__((ext_vector_type(4)));
typedef unsigned u32x4 __attribute__((ext_vector_type(4)));
constexpr int BM = 256, BK = 64, HALF = 128, HTB = HALF * BK * 2  , STAGE_BYTES = 8 * HTB, NXCD = 8, WGM = 8;

__host__ __device__ __forceinline__ int lds_byte(int r, int c) { const int st = (r >> 4) * 2 + (c >> 5), rr = r & 15, cc = c & 31, ob = rr * 64 + cc * 2; return st * 1024 + (ob ^ (((ob >> 9) & 1) << 5)); }
__host__ __device__ __forceinline__ void stage_rc(int b, int& R, int& C) { const int st = b / 1024, sb = b % 1024, swz = sb ^ (((sb >> 9) & 1) << 5); R = (st >> 1) * 16 + swz / 64; C = (st & 1) * 32 + (swz % 64) / 2; }
__host__ __device__ __forceinline__ unsigned tiled_off(int r, int c, int kc) { return ((unsigned)((r >> 4) * (kc >> 5) + (c >> 5)) << 10) + (unsigned)((r & 15) * 64 + (c & 31) * 2); }
__host__ __device__ __forceinline__ int perm32(int rho) { const int n = rho >> 4, i = rho & 15; return 8 * (i >> 2) + 4 * n + (i & 3); }

struct Unit { int pm, pn; };
struct Gemm { const bf16_t* A; const bf16_t* Bt; int M, N, K; };

struct StaticOrder {
    int nM, nN, nwg, G, c;
    __host__ __device__ void init(int M, int N, int G_, int c_) { nM = M / BM; nN = N / BM; nwg = nM * nN; G = G_; c = c_; }
    __host__ __device__ bool next(int i, Unit& u) const {
        const long L = (long)i * G + c; if (L >= nwg) return false;
        int wgid = (int)L; { const int q = nwg / NXCD, r = nwg % NXCD, xcd = wgid % NXCD, off = wgid / NXCD; wgid = (xcd < r ? xcd * (q + 1) : r * (q + 1) + (xcd - r) * q) + off; }
        const int nig = WGM * nN, gid = wgid / nig, fm = gid * WGM, gsz = (nM - fm) < WGM ? (nM - fm) : WGM;
        u.pm = fm + ((wgid % nig) % gsz); u.pn = (wgid % nig) / gsz; return true;
    }
    __device__ __forceinline__ void a_ready(const Unit&) const {}
    __device__ __forceinline__ void done(const Unit&) const {}
};

__device__ __forceinline__ unsigned cvt_pk_bf16(float lo, float hi) { unsigned r; asm volatile("v_cvt_pk_bf16_f32 %0, %1, %2" : "=v"(r) : "v"(lo), "v"(hi)); return r; }
template <int ACT  , bool RS  , bool OTILED = false  > struct EpiBf16 {
    static constexpr bool PERM = true, AFTER_DRAIN = false; static_assert(ACT == 0 || ACT == 2, "EpiBf16: ACT is 0 (none) or 2 (squared relu)");
    bf16_t* O; int ldc; const float* rscale;
    struct State { float rs[2][4]; };
    __device__ __forceinline__ void load(State& st, const Unit& u, int wr, int fr) const {
        if constexpr (RS) { const int row0 = u.pm * BM + wr * 64 + fr;
#pragma unroll
            for (int ai = 0; ai < 2; ++ai)
#pragma unroll
                for (int m = 0; m < 4; ++m) st.rs[ai][m] = rscale[row0 + ai * HALF + m * 16]; }
    }
    __device__ __forceinline__ void operator()(const f32x4 (&acc)[2][2][4][2], const Unit& u, int wr, int wc, int fr, int fq, const State& st) const {
        const int row0 = u.pm * BM + wr * 64 + fr; const int col0 = u.pn * BM + wc * 32 + 8 * fq;
#pragma unroll
        for (int ai = 0; ai < 2; ++ai)
#pragma unroll
            for (int m = 0; m < 4; ++m) { bf16_t* rowp = OTILED ? (bf16_t*)((char*)O + tiled_off(row0 + ai * HALF + m * 16, col0, ldc)) : O + (size_t)(row0 + ai * HALF + m * 16) * ldc + col0;
#pragma unroll
                for (int bj = 0; bj < 2; ++bj) { f32x4 v0 = acc[ai][bj][m][0], v1 = acc[ai][bj][m][1];
                    if constexpr (RS) { v0 = v0 * st.rs[ai][m]; v1 = v1 * st.rs[ai][m]; }
                    if (ACT == 2) { const f32x4 z4 = (f32x4){0.f, 0.f, 0.f, 0.f}; v0 = __builtin_elementwise_max(v0, z4); v1 = __builtin_elementwise_max(v1, z4); v0 = v0 * v0; v1 = v1 * v1; }
                    u32x4 w; w.x = cvt_pk_bf16(v0[0], v0[1]); w.y = cvt_pk_bf16(v0[2], v0[3]); w.z = cvt_pk_bf16(v1[0], v1[1]); w.w = cvt_pk_bf16(v1[2], v1[3]);
                    *(u32x4*)(rowp + (OTILED ? bj * (HALF / 32) * 512 : bj * HALF)) = w; } }
    }
};

struct EpiIn {
    static constexpr bool PERM = true, AFTER_DRAIN = false;
    bf16_t* O; int ldc; const float* rscale;
    struct State { float rs[2][4]; };
    __device__ __forceinline__ void load(State& st, const Unit& u, int wr, int fr) const {
        const int row0 = u.pm * BM + wr * 64 + fr;
#pragma unroll
        for (int ai = 0; ai < 2; ++ai)
#pragma unroll
            for (int m = 0; m < 4; ++m) st.rs[ai][m] = rscale[row0 + ai * HALF + m * 16];
    }
    __device__ __forceinline__ void operator()(const f32x4 (&acc)[2][2][4][2], const Unit& u, int wr, int wc, int fr, int fq, const State& st) const {
        const int row0 = u.pm * BM + wr * 64 + fr, pn = u.pn;
        const int kind = (pn >= 2 && pn < 6) ? 1 : (pn >= 12 ? 2 : 0);
        const int colb = pn < 2 ? 256 * pn : (pn < 6 ? 512 + 128 * (pn - 2) : (pn < 12 ? 1024 + 256 * (pn - 6) : 2560 + 128 * (pn - 12)));
        const int col0 = colb + wc * 32 + 8 * fq;
        if (kind == 0) {
#pragma unroll
            for (int ai = 0; ai < 2; ++ai)
#pragma unroll
                for (int m = 0; m < 4; ++m) { bf16_t* rowp = O + (size_t)(row0 + ai * HALF + m * 16) * ldc + col0;
#pragma unroll
                    for (int bj = 0; bj < 2; ++bj) { const f32x4 v0 = acc[ai][bj][m][0] * st.rs[ai][m], v1 = acc[ai][bj][m][1] * st.rs[ai][m];
                        u32x4 w; w.x = cvt_pk_bf16(v0[0], v0[1]); w.y = cvt_pk_bf16(v0[2], v0[3]); w.z = cvt_pk_bf16(v1[0], v1[1]); w.w = cvt_pk_bf16(v1[2], v1[3]);
                        *(u32x4*)(rowp + bj * HALF) = w; } }
        } else {
#pragma unroll
            for (int ai = 0; ai < 2; ++ai)
#pragma unroll
                for (int m = 0; m < 4; ++m) { bf16_t* rowp = O + (size_t)(row0 + ai * HALF + m * 16) * ldc + col0; float o[8];
#pragma unroll
                    for (int n = 0; n < 2; ++n)
#pragma unroll
                        for (int e = 0; e < 4; ++e) { const float a = acc[ai][0][m][n][e] * st.rs[ai][m], b = acc[ai][1][m][n][e] * st.rs[ai][m];
                            o[4 * n + e] = kind == 1 ? a * b : a * __builtin_amdgcn_rcpf(1.0f + __expf(-b)); }
                    u32x4 w; w.x = cvt_pk_bf16(o[0], o[1]); w.y = cvt_pk_bf16(o[2], o[3]); w.z = cvt_pk_bf16(o[4], o[5]); w.w = cvt_pk_bf16(o[6], o[7]);
                    *(u32x4*)rowp = w; }
        }
    }
};

template <class Epi, class Sched, bool ALIGN_EPI = false, bool SP2 = false, bool ATILED = false>
__device__ __forceinline__ void gemm_phase(PG8_LAS unsigned char* lds, const Gemm g, const Sched& S, const Epi& E) {
    int tid_ = threadIdx.x; asm volatile("" : "+v"(tid_));
    const int tid = tid_, wid = __builtin_amdgcn_readfirstlane(tid >> 6), lane = tid & 63, wr = wid >> 2, wc = wid & 3, fr = lane & 15, fq = lane >> 4;
    const int K = g.K, nt = K / BK;
    unsigned voffA[2], voffB[2];
#pragma unroll
    for (int i = 0; i < 2; ++i) { int R, C; stage_rc(tid * 16 + i * 8192, R, C); static_assert(Epi::PERM, "the tiled weight copies are stored in PERM row order");
        voffA[i] = ATILED ? tiled_off(R, C, K) : (unsigned)(R * K + C) * 2u; voffB[i] = tiled_off(R, C, K); }
    const size_t kstepA = ATILED ? 2048 : (size_t)(BK * 2), kstepB = 2048;
    const size_t hstep = (size_t)HALF * K * 2;
    const size_t tstep = 2 * hstep;
    const unsigned ldsw = (unsigned)wid * 1024u;
    const int aoff = lds_byte(wr * 64 + fr, fq * 8), boff = lds_byte(wc * 32 + fr, fq * 8);
#define PG8_SA(b, h) (((b) * 2 + (h)) * HTB)
#define PG8_SB(b, h) ((4 + (b) * 2 + (h)) * HTB)
#define PG8_STAGE(bufoff, gbase, voff) do { _Pragma("unroll") for (int _i = 0; _i < 2; ++_i) \
        __builtin_amdgcn_global_load_lds((const unsigned*)((const char*)(gbase) + (voff)[_i]), (PG8_LAS unsigned*)(lds + (bufoff) + ldsw + _i * 8192), 16, 0, 0); } while (0)
#define PG8_LDA(dst, b, h) do { _Pragma("unroll") for (int m = 0; m < 4; ++m) _Pragma("unroll") for (int k = 0; k < 2; ++k) dst[m][k] = *(const PG8_LAS bf16x8*)(lds + PG8_SA(b, h) + aoff + m * 2048 + k * 1024); } while (0)
#define PG8_LDB(dst, b, h) do { _Pragma("unroll") for (int n = 0; n < 2; ++n) _Pragma("unroll") for (int k = 0; k < 2; ++k) dst[n][k] = *(const PG8_LAS bf16x8*)(lds + PG8_SB(b, h) + boff + n * 2048 + k * 1024); } while (0)
#define PG8_MMA(ai, bj, At, Bt) do { __builtin_amdgcn_s_setprio(1); _Pragma("unroll") for (int m = 0; m < 4; ++m) _Pragma("unroll") for (int n = 0; n < 2; ++n) _Pragma("unroll") for (int k = 0; k < 2; ++k) \
        acc[ai][bj][m][n] = __builtin_amdgcn_mfma_f32_16x16x32_bf16(Bt[n][k], At[m][k], acc[ai][bj][m][n], 0, 0, 0); __builtin_amdgcn_s_setprio(0); } while (0)
#define PG8_WAIT_V(n) asm volatile("s_waitcnt vmcnt(" #n ")" ::: "memory")
#define PG8_WAIT_L(n) asm volatile("s_waitcnt lgkmcnt(" #n ")" ::: "memory")
#define PG8_BAR __builtin_amdgcn_s_barrier()
#define PG8_SCHED __builtin_amdgcn_sched_barrier(0)
    Unit cur, nxt; int ui = 0;
    if (!S.next(0, cur)) return;
    typename Epi::State est; E.load(est, cur, wr, fr);
    f32x4 acc[2][2][4][2];
#pragma unroll
    for (int a = 0; a < 2; ++a)
#pragma unroll
        for (int b = 0; b < 2; ++b)
#pragma unroll
            for (int m = 0; m < 4; ++m)
#pragma unroll
                for (int n = 0; n < 2; ++n) acc[a][b][m][n] = (f32x4){0.f, 0.f, 0.f, 0.f};
    bf16x8 At[4][2], B0[2][2], B1[2][2];
    const char* cA = (const char*)g.A + (size_t)cur.pm * tstep; const char* cB = (const char*)g.Bt + (size_t)cur.pn * tstep;
    S.a_ready(cur);
    if constexpr (SP2) {
        PG8_STAGE(PG8_SB(0, 0), cB, voffB); PG8_STAGE(PG8_SB(0, 1), cB + hstep, voffB); PG8_STAGE(PG8_SA(0, 0), cA, voffA); PG8_STAGE(PG8_SA(0, 1), cA + hstep, voffA);
        if (wr == 1) PG8_BAR;
        PG8_WAIT_V(2); PG8_BAR;
        PG8_STAGE(PG8_SB(1, 0), cB + kstepB, voffB); PG8_STAGE(PG8_SB(1, 1), cB + hstep + kstepB, voffB);
        PG8_WAIT_V(4); PG8_BAR;
    } else {
        PG8_STAGE(PG8_SB(0, 0), cB, voffB); PG8_STAGE(PG8_SA(0, 0), cA, voffA); PG8_STAGE(PG8_SB(0, 1), cB + hstep, voffB); PG8_STAGE(PG8_SA(0, 1), cA + hstep, voffA);
        if (wr == 1) PG8_BAR;
        PG8_WAIT_V(4); PG8_BAR;
        PG8_STAGE(PG8_SB(1, 0), cB + kstepB, voffB); PG8_STAGE(PG8_SA(1, 0), cA + kstepA, voffA); PG8_STAGE(PG8_SB(1, 1), cB + hstep + kstepB, voffB);
        PG8_WAIT_V(6); PG8_BAR;
    }
    for (;;) {
        const bool has_next = S.next(ui + 1, nxt);
        const char* nA = has_next ? (const char*)g.A + (size_t)nxt.pm * tstep : cA; const char* nB = has_next ? (const char*)g.Bt + (size_t)nxt.pn * tstep : cB;
        for (int t = 0; t < nt; t += 2) {
            const bool last = (t == nt - 2);
            const char* a1 = cA + (size_t)(t + 1) * kstepA;
            const char* a2 = last ? nA : cA + (size_t)(t + 2) * kstepA; const char* b2 = last ? nB : cB + (size_t)(t + 2) * kstepB;
            const char* a3 = a2 + kstepA; const char* b3 = b2 + kstepB;
            if (last && has_next) S.a_ready(nxt);
            if constexpr (SP2) {
            PG8_LDB(B0, 0, 0); PG8_LDB(B1, 0, 1); PG8_SCHED; PG8_LDA(At, 0, 0); PG8_STAGE(PG8_SA(1, 0), a1, voffA); PG8_STAGE(PG8_SA(1, 1), a1 + hstep, voffA);
            PG8_WAIT_V(8); PG8_WAIT_L(0); PG8_BAR; PG8_MMA(0, 0, At, B0); PG8_MMA(0, 1, At, B1); PG8_BAR; PG8_SCHED;
            PG8_LDA(At, 0, 1); PG8_STAGE(PG8_SB(0, 0), b2, voffB); PG8_STAGE(PG8_SB(0, 1), b2 + hstep, voffB);
            PG8_WAIT_V(6); PG8_WAIT_L(0); PG8_BAR; PG8_MMA(1, 0, At, B0); PG8_MMA(1, 1, At, B1); PG8_BAR; PG8_SCHED;
            PG8_LDB(B0, 1, 0); PG8_LDB(B1, 1, 1); PG8_SCHED; PG8_LDA(At, 1, 0); PG8_STAGE(PG8_SA(0, 0), a2, voffA); PG8_STAGE(PG8_SA(0, 1), a2 + hstep, voffA);
            PG8_WAIT_V(8); PG8_WAIT_L(0); PG8_BAR; PG8_MMA(0, 0, At, B0); PG8_MMA(0, 1, At, B1); PG8_BAR; PG8_SCHED;
            PG8_LDA(At, 1, 1); PG8_STAGE(PG8_SB(1, 0), b3, voffB); PG8_STAGE(PG8_SB(1, 1), b3 + hstep, voffB);
            PG8_WAIT_V(6); PG8_WAIT_L(0); PG8_BAR; PG8_MMA(1, 0, At, B0); PG8_MMA(1, 1, At, B1); PG8_BAR; PG8_SCHED;
            } else {
            PG8_LDB(B0, 0, 0); PG8_SCHED; PG8_LDA(At, 0, 0); PG8_STAGE(PG8_SA(1, 1), a1 + hstep, voffA);
            PG8_WAIT_L(8); PG8_BAR; PG8_WAIT_L(0); PG8_MMA(0, 0, At, B0); PG8_BAR; PG8_SCHED;
            PG8_LDB(B1, 0, 1); PG8_STAGE(PG8_SB(0, 0), b2, voffB);
            PG8_BAR; PG8_WAIT_L(0); PG8_MMA(0, 1, At, B1); PG8_BAR;
            PG8_LDA(At, 0, 1); PG8_STAGE(PG8_SA(0, 0), a2, voffA);
            PG8_BAR; PG8_WAIT_L(0); PG8_MMA(1, 0, At, B0); PG8_BAR; PG8_SCHED;
            PG8_STAGE(PG8_SB(0, 1), b2 + hstep, voffB);
            PG8_WAIT_V(6); PG8_BAR; PG8_MMA(1, 1, At, B1); PG8_BAR;
            PG8_LDB(B0, 1, 0); PG8_SCHED; PG8_LDA(At, 1, 0); PG8_STAGE(PG8_SA(0, 1), a2 + hstep, voffA);
            PG8_WAIT_L(8); PG8_BAR; PG8_WAIT_L(0); PG8_MMA(0, 0, At, B0); PG8_BAR; PG8_SCHED;
            PG8_LDB(B1, 1, 1); PG8_STAGE(PG8_SB(1, 0), b3, voffB);
            PG8_BAR; PG8_WAIT_L(0); PG8_MMA(0, 1, At, B1); PG8_BAR;
            PG8_LDA(At, 1, 1); PG8_STAGE(PG8_SA(1, 0), a3, voffA);
            PG8_BAR; PG8_WAIT_L(0); PG8_MMA(1, 0, At, B0); PG8_BAR; PG8_SCHED;
            PG8_STAGE(PG8_SB(1, 1), b3 + hstep, voffB);
            PG8_WAIT_V(6); PG8_BAR; PG8_MMA(1, 1, At, B1); PG8_BAR;
            }
        }
        if constexpr (ALIGN_EPI) { if (wr == 0) PG8_BAR; }
        if constexpr (!Epi::AFTER_DRAIN) { E(acc, cur, wr, wc, fr, fq, est); S.done(cur); }
        if (!has_next) break;
        E.load(est, nxt, wr, fr);
#pragma unroll
        for (int a = 0; a < 2; ++a)
#pragma unroll
            for (int b = 0; b < 2; ++b)
#pragma unroll
                for (int m = 0; m < 4; ++m)
#pragma unroll
                    for (int n = 0; n < 2; ++n) acc[a][b][m][n] = (f32x4){0.f, 0.f, 0.f, 0.f};
        cur = nxt; cA = nA; cB = nB; ++ui;
        if constexpr (ALIGN_EPI) { if (wr == 1) PG8_BAR; }
    }
    PG8_WAIT_V(0);
    if constexpr (!ALIGN_EPI) { if (wr == 0) PG8_BAR; }
    PG8_BAR;
    if constexpr (Epi::AFTER_DRAIN) { E.fused(acc, cur, wr, wc, fr, fq, lds, wid, lane); S.done(cur); }
#undef PG8_SA
#undef PG8_SB
#undef PG8_STAGE
#undef PG8_LDA
#undef PG8_LDB
#undef PG8_MMA
#undef PG8_WAIT_V
#undef PG8_WAIT_L
#undef PG8_BAR
#undef PG8_SCHED
}
}

namespace attn_body {
using bf16=__hip_bfloat16;
using bf16x8=__attribute__((ext_vector_type(8)))short;
using s16x4=__attribute__((ext_vector_type(4)))short;
using f32x16=__attribute__((ext_vector_type(16)))float;
using u32x4=__attribute__((ext_vector_type(4)))unsigned;
constexpr int D=64,ZP=3072,OP=2048;
constexpr int NW=8,QBLK=32,QB=QBLK*NW,KVBLK=64;
constexpr int ATTN_UNIT_ROWS=QB;
__device__ __forceinline__ int crow(int r,int hi){return (r&3)+8*(r>>2)+4*hi;}
#define SBAR() __builtin_amdgcn_sched_barrier(0)
template<int MODE> __device__ __forceinline__ int trow(int t,int q0,int S){
  if constexpr(MODE!=1){ return 64*t; }
  else { const int j=(t+3)&7; const int kpos=q0-128+64*j; return (kpos>=0&&kpos<S)?kpos:(q0+64); }
}
template<int MODE> __device__ __forceinline__ void tmask(f32x16&p0,f32x16&p1,int t,int qrel,int hi,int q0,int S){
  if constexpr(MODE==1){
    const float NEG=-INFINITY; const int j=(t+3)&7; const int krel0=-128+64*j; const int kpos=q0+krel0;
    const int base=(kpos>=0&&kpos<S)?(krel0+4*hi-qrel+128):100000;
    #pragma unroll
    for(int r=0;r<16;++r){const int kv=base+(r&3)+8*(r>>2); if((unsigned)kv>256u)p0[r]=NEG; if((unsigned)(kv+32)>256u)p1[r]=NEG;}
  }
}

constexpr int NSLOT=3, SLOTB=8192;
constexpr int LDS_K=0, LDS_V=NSLOT*SLOTB, LDS_WS=2*NSLOT*SLOTB, LDS_OST=LDS_WS+NW*64*4, LDS_BYTES=LDS_OST+NW*4096;
constexpr float C2=0.125f*1.4426950408889634f;
__device__ __forceinline__ void glds16(const void*gsrc,unsigned lds_dst){unsigned keep;
  asm volatile("s_mov_b32 %0, m0\n\ts_mov_b32 m0, %2\n\ts_nop 0\n\tglobal_load_lds_dwordx4 %1, off\n\ts_mov_b32 m0, %0":"=&s"(keep):"v"(gsrc),"s"(lds_dst):"memory");}
__device__ __forceinline__ float max3f(float a,float b,float c){float r;asm("v_max3_f32 %0, %1, %2, %3":"=v"(r):"v"(a),"v"(b),"v"(c));return r;}
__device__ __forceinline__ float max2f(float a,float b){float r;asm("v_max_f32_e32 %0, %1, %2":"=v"(r):"v"(a),"v"(b));return r;}
__device__ __forceinline__ float fadd_s(float a,float b){float r;asm("v_add_f32_e32 %0, %1, %2":"=v"(r):"v"(a),"v"(b));return r;}
__device__ __forceinline__ float fsub_s(float a,float b){float r;asm("v_sub_f32_e32 %0, %1, %2":"=v"(r):"v"(a),"v"(b));return r;}
typedef float f32x2_t __attribute__((ext_vector_type(2))); typedef __bf16 bf16x2_t __attribute__((ext_vector_type(2)));
__device__ __forceinline__ unsigned cvtpk_s(float lo,float hi){f32x2_t v={lo,hi};bf16x2_t b=__builtin_convertvector(v,bf16x2_t);return __builtin_bit_cast(unsigned,b);}
#define WAIT_BAR(N) asm volatile("s_waitcnt vmcnt(" #N ") lgkmcnt(0)\n\ts_barrier":::"memory")
#define WAIT_BAR2W() WAIT_BAR(1)

typedef int v8i_t __attribute__((ext_vector_type(8))); typedef int v4i_t __attribute__((ext_vector_type(4)));
typedef __attribute__((address_space(3))) const char* lds_cptr;
typedef short v4i16_t __attribute__((ext_vector_type(4))); typedef float f32x4d_t __attribute__((ext_vector_type(4))); typedef short v2s16_t __attribute__((ext_vector_type(2)));
#define FP8_SC 0
__device__ __forceinline__ v8i_t kfrag(lds_cptr kp){ const v4i_t lo=*(const __attribute__((address_space(3))) v4i_t*)(kp), hi=*(const __attribute__((address_space(3))) v4i_t*)(kp+1024); return __builtin_shufflevector(lo,hi,0,1,2,3,4,5,6,7); }
#define QK8(KF,QF,C) __builtin_amdgcn_mfma_scale_f32_32x32x64_f8f6f4((KF),(QF),(C),0,0,0,FP8_SC,0,FP8_SC)
__device__ __forceinline__ void qkt(f32x16&p0,f32x16&p1,lds_cptr Kslot,const v8i_t qf,const f32x16&negm,int r32,int hi){
  const lds_cptr kb=Kslot+hi*2048+r32*16;
  p0=QK8(kfrag(kb),qf,negm); p1=QK8(kfrag(kb+512),qf,negm);
}
__device__ __forceinline__ s16x4 vtr(lds_cptr p){ return __builtin_bit_cast(s16x4,__builtin_amdgcn_ds_read_tr16_b64_v4i16((__attribute__((address_space(3))) v4i16_t*)p)); }
__device__ __forceinline__ float rowmax(const f32x16&p0,const f32x16&p1){
  float a=max3f(p0[0],p0[1],p1[0]),b=max3f(p0[2],p0[3],p1[1]);a=max3f(a,p1[2],p1[3]);
  #pragma unroll
  for(int r=4;r<16;r+=4){a=max3f(a,p0[r],p0[r+1]);b=max3f(b,p0[r+2],p0[r+3]);a=max3f(a,p1[r],p1[r+1]);b=max3f(b,p1[r+2],p1[r+3]);}
  const float m=max2f(a,b);
  auto rr=__builtin_amdgcn_permlane32_swap(__float_as_uint(m),__float_as_uint(m),false,false);
  return max2f(__uint_as_float(rr[0]),__uint_as_float(rr[1]));
}
__device__ __forceinline__ void pv(f32x16*o,int vb,bf16x8 pa0,bf16x8 pa1,bf16x8 pa2,bf16x8 pa3){
  #pragma unroll
  for(int d0=0;d0<2;++d0){s16x4 lo[4],hi[4];
    #pragma unroll
    for(int ks=0;ks<4;++ks){
      asm volatile("ds_read_b64_tr_b16 %0,%1 offset:%c2":"=&v"(lo[ks]):"v"(vb),"i"(d0*4096+ks*1024):"memory");
      asm volatile("ds_read_b64_tr_b16 %0,%1 offset:%c2":"=&v"(hi[ks]):"v"(vb),"i"(d0*4096+ks*1024+512):"memory");}
    asm volatile("s_waitcnt lgkmcnt(0)":::"memory");SBAR();
    #define PK(k) (bf16x8){lo[k][0],lo[k][1],lo[k][2],lo[k][3],hi[k][0],hi[k][1],hi[k][2],hi[k][3]}
    o[d0]=__builtin_amdgcn_mfma_f32_32x32x16_bf16(pa0,PK(0),o[d0],0,0,0);
    o[d0]=__builtin_amdgcn_mfma_f32_32x32x16_bf16(pa1,PK(1),o[d0],0,0,0);
    o[d0]=__builtin_amdgcn_mfma_f32_32x32x16_bf16(pa2,PK(2),o[d0],0,0,0);
    o[d0]=__builtin_amdgcn_mfma_f32_32x32x16_bf16(pa3,PK(3),o[d0],0,0,0);
    #undef PK
  }
}

template<int QT> __device__ __forceinline__ v8i_t q_transform(const bf16x8 (&qr)[4],const int t,const int hi,const float*gq){
  float x[4][8];
  #pragma unroll
  for(int d0=0;d0<4;++d0)
    #pragma unroll
    for(int e=0;e<8;++e)x[d0][e]=__uint_as_float(((unsigned)(unsigned short)qr[d0][e])<<16);
  if constexpr(QT==1){
    float ss=0.f;
    #pragma unroll
    for(int d0=0;d0<4;++d0)
      #pragma unroll
      for(int e=0;e<8;++e)ss+=x[d0][e]*x[d0][e];
    {auto rr=__builtin_amdgcn_permlane32_swap(__float_as_uint(ss),__float_as_uint(ss),false,false);ss=__uint_as_float(rr[0])+__uint_as_float(rr[1]);}
    const float r=rsqrtf(ss*(1.0f/64.0f)+1e-6f);
    #pragma unroll
    for(int d0=0;d0<4;++d0)
      #pragma unroll
      for(int e=0;e<8;++e)x[d0][e]=x[d0][e]*r*gq[16*d0+8*hi+e];
    const int pr=t>>6,pc=t&63;
    #pragma unroll
    for(int e=0;e<8;++e){ const float f=INVF[2*(8*hi+e)]; float sn,cs;
      sincos_f((float)pr*f,sn,cs); { const float a=x[0][e],b=x[1][e]; x[0][e]=a*cs-b*sn; x[1][e]=b*cs+a*sn; }
      sincos_f((float)pc*f,sn,cs); { const float a=x[2][e],b=x[3][e]; x[2][e]=a*cs-b*sn; x[3][e]=b*cs+a*sn; } }
  } else {
    #pragma unroll
    for(int e=0;e<8;++e){ float sn,cs;
      sincos_f((float)t*INVF[8*hi+e],sn,cs);    { const float a=x[0][e],b=x[2][e]; x[0][e]=a*cs-b*sn; x[2][e]=b*cs+a*sn; }
      sincos_f((float)t*INVF[16+8*hi+e],sn,cs); { const float a=x[1][e],b=x[3][e]; x[1][e]=a*cs-b*sn; x[3][e]=b*cs+a*sn; } }
  }
  v8i_t qf;
  #pragma unroll
  for(int d0=0;d0<4;++d0){ int w0=0,w1=0;
    w0=__builtin_amdgcn_cvt_pk_fp8_f32(x[d0][0]*C2,x[d0][1]*C2,w0,false); w0=__builtin_amdgcn_cvt_pk_fp8_f32(x[d0][2]*C2,x[d0][3]*C2,w0,true);
    w1=__builtin_amdgcn_cvt_pk_fp8_f32(x[d0][4]*C2,x[d0][5]*C2,w1,false); w1=__builtin_amdgcn_cvt_pk_fp8_f32(x[d0][6]*C2,x[d0][7]*C2,w1,true);
    qf[2*d0]=w0; qf[2*d0+1]=w1; }
  return qf;
}
#ifndef ATTN_STORE16
#define ATTN_STORE16(p,v) (*(u32x4*)(p)=(v))
#endif
template<int MODE,int THRL,int QT> __device__ __forceinline__ void attn_unit(const bf16*Qu,const char*__restrict__ Kt,const char*__restrict__ Vt,bf16*Ou,const int NT,const int q0,const int S,const float sink2,const int tq0,const float*gq,char*shm){
  int tid_=threadIdx.x; asm volatile("":"+v"(tid_)); const int tid=tid_,lane=tid&63,r32=lane&31,hi=lane>>5; const int wid=__builtin_amdgcn_readfirstlane(tid>>6);
  const bf16*Qw=Qu+(long)(wid*QBLK)*ZP;
  const unsigned lds0=(unsigned)(uintptr_t)shm;
  float*wsf=(float*)(shm+LDS_WS)+wid*64;
  const bool kw=wid<4; const char*psrc=(kw?Kt+wid*1024:Vt+(wid&3)*1024)+lane*16; const unsigned pdst=lds0+(kw?LDS_K+wid*1024:LDS_V+(wid&3)*1024);
  #define DMA_P(t,slot) glds16(psrc+((long)(trow<MODE>((t),q0,S)>>6)<<12),(unsigned)__builtin_amdgcn_readfirstlane(pdst+(slot)))
  #define DMA_K(t,slot) if(kw) DMA_P(t,slot)
  #define DMA_V(t,slot) if(!kw) DMA_P(t,slot)
  #define DMA_STEP(t,GK,GV) do{ if(kw?(GK):(GV)){ const int tt_=(t)+(kw?3:1); const int sl_=kw?sl_cur:sl_next; DMA_P(tt_,sl_); } }while(0)
  v8i_t kf[2];
  const lds_cptr shm3=(lds_cptr)shm; const lds_cptr kp0=shm3+LDS_K+hi*2048+r32*16; const lds_cptr vp0=shm3+LDS_V+hi*2048+r32*16;
  DMA_P(0,0);DMA_K(1,SLOTB);
  bf16x8 qr[4];
  #pragma unroll
  for(int d0=0;d0<4;++d0)qr[d0]=*reinterpret_cast<const bf16x8*>(&Qw[(long)r32*ZP+d0*16+hi*8]);
  const v8i_t qf=q_transform<QT>(qr,tq0+wid*QBLK+r32,hi,gq);
  float mhat=0.f;f32x16 o[2];o[0]=f32x16{};o[1]=f32x16{};f32x4d_t o2={0.f,0.f,0.f,0.f};
  v8i_t ones; { const int sel_=((((lane>>4)&1)==0)==((lane&15)<8))?0x38383838:0; _Pragma("unroll") for(int i=0;i<8;++i)ones[i]=sel_; } asm volatile("":"+v"(ones));
  const int l2row=4*(lane>>4)+(((lane&15)>=8)?16:0);
  #define SUM8(A,C) __builtin_amdgcn_mfma_scale_f32_16x16x128_f8f6f4((A),ones,(C),1,0,0,FP8_SC,0,FP8_SC)
  f32x16 negm=f32x16{};if constexpr(MODE!=2){asm volatile("":"+v"(negm));}
  const float pscl=(MODE==2)?sink2:1.0f;
  const int qrel=wid*QBLK+r32;
  #define CMASK(P0,P1,t) tmask<MODE>(P0,P1,(t),qrel,hi,q0,S)
  bool resc=false;
  #define START(P0,P1) do{ resc=false; if constexpr(MODE!=2) \
    { const float rm=rowmax(P0,P1); const float dl=rm; mhat=fadd_s(mhat,dl); \
      _Pragma("unroll") for(int r=0;r<16;++r){P0[r]=fsub_s(P0[r],dl);P1[r]=fsub_s(P1[r],dl);} \
      _Pragma("unroll") for(int r=0;r<16;++r)negm[r]=-mhat; asm volatile("":"+v"(negm)); } \
    _Pragma("unroll") for(int r=0;r<16;++r)P0[r]=__builtin_amdgcn_exp2f(P0[r]); }while(0)
  #define RESC() do{ if constexpr(MODE!=2) if(resc){ asm volatile("s_waitcnt lgkmcnt(0)":::"memory"); \
      _Pragma("unroll") for(int r=0;r<16;++r){ const float f_=wsf[crow(r,hi)]; o[0][r]*=f_; o[1][r]*=f_; } _Pragma("unroll") for(int e=0;e<4;++e)o2[e]*=wsf[l2row+e]; } }while(0)
  f32x16 pA0,pA1,pB0,pB1;
  int sl_prev=0,sl_cur=0,sl_next=SLOTB;
  #define ROT() do{sl_prev=sl_cur;sl_cur=sl_next;sl_next=(sl_next==(NSLOT-1)*SLOTB)?0:sl_next+SLOTB;}while(0)
  DMA_K(2,2*SLOTB);
  WAIT_BAR(3);
  qkt(pA0,pA1,shm3+LDS_K,qf,negm,r32,hi);asm volatile("s_nop 15\n\ts_nop 7":"+v"(pA0),"+v"(pA1));CMASK(pA0,pA1,0);
  START(pA0,pA1);
  _Pragma("unroll") for(int r=0;r<16;++r)pA1[r]=__builtin_amdgcn_exp2f(pA1[r]);
  WAIT_BAR(0);
  DMA_P(kw?3:1,kw?0:SLOTB);
  ROT();
  kf[0]=kfrag(kp0+sl_cur); kf[1]=kfrag(kp0+sl_cur+512);
  WAIT_BAR2W();
  v8i_t vf[2], pa;
  #define PK8(P,B,W) do{ v2s16_t w2_=__builtin_bit_cast(v2s16_t,W); w2_=__builtin_amdgcn_cvt_scalef32_pk_bf8_f32(w2_,P[B],P[(B)+1],pscl,false); w2_=__builtin_amdgcn_cvt_scalef32_pk_bf8_f32(w2_,P[(B)+2],P[(B)+3],pscl,true); W=__builtin_bit_cast(int,w2_); }while(0)
  #define PV8(A,B,C) __builtin_amdgcn_mfma_scale_f32_32x32x64_f8f6f4((A),(B),(C),1,0,0,FP8_SC,0,FP8_SC)
  #define PIN(x) asm volatile("":"+v"(x))
  #define MX3(a,b,c) __builtin_fmaxf(__builtin_fmaxf((a),(b)),(c))
  #define EX(v) __builtin_amdgcn_exp2f(v)
  #define KRD(G,j) do{ if(G){ kf[(j)]=kfrag(kp0+sl_next+(j)*512); } }while(0)
  #define HALFA(P,J0) do{ _Pragma("unroll") for(int j_=0;j_<4;++j_){ int w_; asm volatile("":"=v"(w_)); PK8(P,4*j_,w_); pa[(J0)+j_]=w_; } }while(0)
  #define STEP(C0,C1,P0,P1,t,GK,GV,GL) do{ SBAR(); \
    { const lds_cptr vp_=vp0+sl_prev; vf[0]=kfrag(vp_); vf[1]=kfrag(vp_+512); } \
    PIN(kf[0]); C0=QK8(kf[0],qf,negm); PIN(C0); \
    PIN(P0); PIN(P1); HALFA(P0,0); HALFA(P1,4); PIN(pa); \
    PIN(kf[1]); C1=QK8(kf[1],qf,negm); PIN(C1); KRD(GL,0); KRD(GL,1);     \
    DMA_STEP(t,GK,GV); \
    CMASK(C0,C1,t); \
    if constexpr(MODE!=2){ float a=MX3(C0[0],C0[1],C1[0]),b=MX3(C0[2],C0[3],C1[1]); a=MX3(a,C1[2],C1[3]); \
      _Pragma("unroll") for(int r=4;r<16;r+=4){a=MX3(a,C0[r],C0[r+1]);b=MX3(b,C0[r+2],C0[r+3]);a=MX3(a,C1[r],C1[r+1]);b=MX3(b,C1[r+2],C1[r+3]);} \
      float rm=__builtin_fmaxf(a,b); { auto rr=__builtin_amdgcn_permlane32_swap(__float_as_uint(rm),__float_as_uint(rm),false,false); rm=__builtin_fmaxf(__uint_as_float(rr[0]),__uint_as_float(rr[1])); } \
      resc=false; \
      if(__builtin_expect(__any(rm>(float)THRL),0)){ const float dl=__builtin_fmaxf(rm,0.f); mhat+=dl; \
        _Pragma("unroll") for(int r=0;r<16;++r){C0[r]-=dl;C1[r]-=dl;} \
        _Pragma("unroll") for(int r=0;r<16;++r)negm[r]=-mhat; asm volatile("":"+v"(negm)); \
        const float f=__builtin_amdgcn_exp2f(-dl); if(hi==0)wsf[r32]=f; resc=true; } } \
    PIN(pa); o[0]=PV8(pa,vf[0],o[0]); PIN(o[0]); \
    PIN(C0); _Pragma("unroll") for(int r=0;r<11;++r)C0[r]=EX(C0[r]); PIN(C0); \
    PIN(pa); o[1]=PV8(pa,vf[1],o[1]); PIN(o[1]); \
    PIN(C0); PIN(C1); _Pragma("unroll") for(int r=11;r<16;++r)C0[r]=EX(C0[r]); _Pragma("unroll") for(int r=0;r<6;++r)C1[r]=EX(C1[r]); PIN(C0); PIN(C1); \
    PIN(pa); o2=SUM8(pa,o2); PIN(o2); \
    PIN(C1); _Pragma("unroll") for(int r=6;r<16;++r)C1[r]=EX(C1[r]); PIN(C1); \
    SBAR(); \
    }while(0)
  int t=1;
  for(;t+5<NT;t+=2){
    STEP(pB0,pB1,pA0,pA1,t,true,true,true);     WAIT_BAR2W(); RESC(); ROT();
    STEP(pA0,pA1,pB0,pB1,t+1,true,true,true);   WAIT_BAR2W(); RESC(); ROT();
  }
  #define ENDW(tt) do{ if((tt)+3<NT){WAIT_BAR2W();} else if((tt)+2<NT){ if(wid<4){WAIT_BAR(0);} else {WAIT_BAR(1);} } else {WAIT_BAR(0);} }while(0)
  for(;t+1<NT;t+=2){
    STEP(pB0,pB1,pA0,pA1,t,(t+3<NT),(t+1<NT),(t+1<NT));       ENDW(t);   RESC(); ROT();
    STEP(pA0,pA1,pB0,pB1,t+1,(t+4<NT),(t+2<NT),(t+2<NT));     ENDW(t+1); RESC(); ROT();
  }
  STEP(pB0,pB1,pA0,pA1,NT-1,false,false,false); RESC();
  { HALFA(pB0,0); HALFA(pB1,4);
    { const lds_cptr vp_=vp0+sl_cur; vf[0]=kfrag(vp_); vf[1]=kfrag(vp_+512); }
    o[0]=PV8(pa,vf[0],o[0]); o[1]=PV8(pa,vf[1],o[1]); o2=SUM8(pa,o2); }
  #undef PK8
  #undef SUM8
  #undef PV8
  #undef HALFA
  #undef PIN
  #undef MX3
  #undef EX
  #undef KRD
  #undef DMA_STEP
  #undef STEP
  #undef ENDW
  asm volatile("s_nop 15\n\ts_nop 7":"+v"(o2));
  if((lane&7)==0){ _Pragma("unroll") for(int e=0;e<4;++e)wsf[32+l2row+e]=o2[e]; }
  asm volatile("s_waitcnt lgkmcnt(0)":::"memory");
  if constexpr(MODE==1){ if(hi==0)wsf[32+r32]+=__builtin_amdgcn_exp2f(sink2-mhat); asm volatile("s_waitcnt lgkmcnt(0)":::"memory"); }
  float rli[16];
  #pragma unroll
  for(int r=0;r<16;++r)rli[r]=__builtin_amdgcn_rcpf(wsf[32+crow(r,hi)]);
  bf16*Ow=Ou+(long)(wid*QBLK)*OP;
  { bf16*stg=(bf16*)(shm+LDS_OST)+wid*2048;
    #pragma unroll
    for(int r=0;r<16;++r){const int orow=crow(r,hi);
      #pragma unroll
      for(int d0=0;d0<2;++d0)stg[orow*64+d0*32+r32]=__float2bfloat16(o[d0][r]*rli[r]);}
    asm volatile("s_waitcnt lgkmcnt(0)":::"memory");
    #pragma unroll
    for(int i=0;i<4;++i){const int row=i*8+(lane>>3),ch=lane&7; const u32x4 v=*(const u32x4*)(stg+row*64+ch*8); ATTN_STORE16(Ow+(long)row*OP+ch*8,v);} }
  asm volatile("s_waitcnt lgkmcnt(0)\n\ts_barrier":::"memory");
  #undef DMA_K
  #undef DMA_V
  #undef DMA_P
  #undef CMASK
  #undef START
  #undef RESC
  #undef ROT
}
constexpr int ATTN_LDS_BYTES=LDS_BYTES;
#undef SBAR
#undef WAIT_BAR
#undef WAIT_BAR2W
#undef QK8
}
#define GAS __attribute__((address_space(1)))
#define LAS __attribute__((address_space(3)))
typedef unsigned short bf16;
typedef unsigned v4u __attribute__((ext_vector_type(4)));
typedef float f32x4 __attribute__((ext_vector_type(4)));
typedef short bf16x8 __attribute__((ext_vector_type(8)));
typedef GAS unsigned gu32;
typedef GAS unsigned long long gu64;
#define RLX_AGENT __ATOMIC_RELAXED, __HIP_MEMORY_SCOPE_AGENT
#define LDS_WAIT() asm volatile("s_waitcnt lgkmcnt(0)" ::: "memory")
#define VM_WAIT() asm volatile("s_waitcnt vmcnt(0)" ::: "memory")
__device__ __forceinline__ unsigned long long rt() { return __builtin_amdgcn_s_memrealtime(); }
__device__ __forceinline__ unsigned f2bf(float f) { unsigned u = __builtin_bit_cast(unsigned, f); return (u + 0x7fffu + ((u >> 16) & 1u)) >> 16; }
__device__ __forceinline__ unsigned pk2(float lo, float hi) { return f2bf(lo) | (f2bf(hi) << 16); }

#define XB_TMO      128
#define XB_XCNT(j)  (256  + 64 * (j))
#define XB_XSUB(j)  (1280 + 64 * (j))
#define XB_XGEN(j)  (2304 + 64 * (j))
#define XB_TOP      3328
#define XB_TOPGEN   3392
#define XCD_BAR_WORDS 3456
#define XB_SPIN_CAP (1u << 18)

__device__ __forceinline__ unsigned xb_ld(unsigned* p)              { return __hip_atomic_load(p, __ATOMIC_RELAXED, __HIP_MEMORY_SCOPE_AGENT); }
__device__ __forceinline__ unsigned xb_add(unsigned* p, unsigned v) { return __hip_atomic_fetch_add(p, v, __ATOMIC_RELAXED, __HIP_MEMORY_SCOPE_AGENT); }
__device__ __forceinline__ unsigned xb_xcc_id() { return (unsigned)__builtin_amdgcn_s_getreg((3 << 11) | 20) & 0xFu; }
#define XB_SPIN(cond, bar) do { unsigned _sp = 0; while (cond) { __builtin_amdgcn_s_sleep(1); \
    if ((++_sp & 255u) == 0u) { if (xb_ld(&(bar)[XB_TMO])) break; if (_sp > XB_SPIN_CAP) { atomicAdd(&(bar)[XB_TMO], 1u); break; } } } } while (0)

struct XcdBarrier {
    unsigned* bar; unsigned x;
    volatile LAS unsigned* st;
};

__device__ __forceinline__ XcdBarrier xcd_barrier_post(unsigned* bar, volatile LAS unsigned* st) {
    XcdBarrier b; b.bar = bar; b.x = xb_xcc_id(); b.st = st;
    if (threadIdx.x == 0) (void)xb_add(&bar[XB_XCNT(b.x)], 1u);
    return b;
}
__device__ __forceinline__ void xcd_barrier_complete(unsigned* bar, unsigned x, unsigned& nloc, unsigned& nx) {
    const unsigned G = gridDim.x * gridDim.y * gridDim.z;
    unsigned sum, cnt, mine, sp = 0u;
    for (;;) {
        sum = 0u; cnt = 0u; mine = 0u;
#pragma unroll
        for (unsigned j = 0; j < 16; ++j) { const unsigned c = xb_ld(&bar[XB_XCNT(j)]); sum += c; cnt += (c > 0u) ? 1u : 0u; mine = (j == x) ? c : mine; }
        if (sum == G) break;
        __builtin_amdgcn_s_sleep(1);
        if ((++sp & 255u) == 0u) { if (xb_ld(&bar[XB_TMO])) break; if (sp > XB_SPIN_CAP) { atomicAdd(&bar[XB_TMO], 1u); break; } }
    }
    nloc = mine > 0u ? mine : 1u; nx = cnt > 0u ? cnt : 1u;
}

__device__ __forceinline__ void xcd_barrier(const XcdBarrier& b) {
    asm volatile("s_waitcnt vmcnt(0)" ::: "memory");
    __syncthreads();
    if (threadIdx.x == 0) {
        unsigned* bar = b.bar;
        __builtin_amdgcn_s_waitcnt(0);
        unsigned nloc = b.st[0], nx = b.st[1];
        if (nloc == 0u) { xcd_barrier_complete(bar, b.x, nloc, nx); b.st[0] = nloc; b.st[1] = nx; }
        const unsigned old = xb_add(&bar[XB_XSUB(b.x)], 1u);
        const unsigned gen = old / nloc;
        if (old + 1u == (gen + 1u) * nloc) {
            __builtin_amdgcn_fence(__ATOMIC_RELEASE, "agent");
            asm volatile("s_waitcnt vmcnt(0)" ::: "memory");
            const unsigned og = xb_add(&bar[XB_TOP], 1u);
            const unsigned tg = og / nx;
            if (og + 1u == (tg + 1u) * nx) xb_add(&bar[XB_TOPGEN], 1u);
            else XB_SPIN(xb_ld(&bar[XB_TOPGEN]) == tg, bar);
            __builtin_amdgcn_fence(__ATOMIC_ACQUIRE, "agent");
            xb_add(&bar[XB_XGEN(b.x)], 1u);
            asm volatile("s_waitcnt vmcnt(0)" ::: "memory");
        } else {
            XB_SPIN(xb_ld(&bar[XB_XGEN(b.x)]) == gen, bar);
            __builtin_amdgcn_fence(__ATOMIC_ACQUIRE, "agent");
            asm volatile("s_waitcnt vmcnt(0)" ::: "memory");
        }
    }
    __syncthreads();
}

constexpr int NWAVES = 8;
#ifndef MK_N_LAUNCHES
#define MK_N_LAUNCHES 1
#endif

constexpr int DM = 2048, INW = 4096, FF = 8192, DEPTH = 2;
constexpr int SP = 16384, SS = 2048;
constexpr int MP = 2 * SP, MS = 4 * SS, M = MP + MS;
constexpr int NCHUNK = 5, MC = M / NCHUNK;
constexpr int N_PHASES = 1 + DEPTH * (5 + (NCHUNK + 1) + 1);
constexpr float RMS_EPS = 1e-6f, LN_EPS = 1e-5f, LOG2E = 1.4426950408889634f;
constexpr int ZW = 3072, ZA_B = 0, Z_P = 512, ZB_Q = 1024, ZB_K = 1536, ZB_V = 1664, ZC_Q = 1792, ZC_K = 2304, ZC_V = 2432, Z_U = 2560;
constexpr int Y_A = 0, Y_B = 512, Y_C = 1024, Y_D = 1536;
static_assert(attn_body::ZP == ZW && attn_body::OP == DM, "attention body pitches");

constexpr size_t MiB = 1u << 20;
constexpr size_t WS_CTL = 0, CTL_ZERO_BYTES = 1 * MiB;
constexpr size_t WS_W = 2 * MiB, W_LAYER = 88 * MiB;
constexpr size_t WO_IN = 0, WO_OUT = 16 * MiB, WO_F1 = 24 * MiB, WO_F2 = 56 * MiB;
constexpr size_t WS_Z = WS_W + DEPTH * W_LAYER;
constexpr size_t WS_Y = WS_Z + (size_t)M * INW * 2;
constexpr size_t WS_U1 = WS_Z + (size_t)M * DM * 2;
static_assert(WS_U1 + (size_t)MC * FF * 2 <= WS_Y, "U1 fits above YP inside the z region");
constexpr size_t WS_H = WS_Y + (size_t)M * DM * 2;
constexpr size_t WS_RS = 1 * MiB;
constexpr size_t WS_KT = WS_H + (size_t)M * DM * 2;
constexpr size_t KV_IMG = (size_t)4 * (M / 64) * 8192;
constexpr size_t WS_VT = WS_KT + KV_IMG;
constexpr size_t WS_END = WS_VT + KV_IMG;
static_assert((size_t)MC * FF * 2 <= (size_t)M * DM * 2, "U chunk fits in the y region");
constexpr int CW_ATT = 8192;
constexpr int CW_BAR = 4096;

constexpr int RING_OFF = 0, RING_BYTES = 131072;
constexpr int LDSCTL_OFF = RING_BYTES, MISC_OFF = LDSCTL_OFF + 320;
constexpr int LDS_BYTES = 147456;
static_assert(MISC_OFF + 128 <= LDS_BYTES && attn_body::ATTN_LDS_BYTES <= RING_BYTES, "LDS map");

typedef unsigned u32x2 __attribute__((ext_vector_type(2)));
struct Frame {
    LAS unsigned char* lds;
    volatile LAS unsigned* MISC;
    int tid, lane, wave;
    int vcu, G;
    __device__ __forceinline__ const float* in(int i) const { asm volatile("" : "+s"(i)); return ((const float* const __attribute__((address_space(4)))*)__builtin_amdgcn_kernarg_segment_ptr())[i]; }
    __device__ __forceinline__ const float* xp() const { return in(0); }
    __device__ __forceinline__ const float* xs() const { return in(1); }
    __device__ __forceinline__ const float* pre_mix_g() const { return in(2); }
    __device__ __forceinline__ const float* w_in() const { return in(3); }
    __device__ __forceinline__ const float* conv_a_w() const { return in(4); }
    __device__ __forceinline__ const float* q_norm_g() const { return in(5); }
    __device__ __forceinline__ const float* k_norm_g() const { return in(6); }
    __device__ __forceinline__ const float* sink_c() const { return in(7); }
    __device__ __forceinline__ const float* conv_d_w() const { return in(8); }
    __device__ __forceinline__ const float* conv_d_b() const { return in(9); }
    __device__ __forceinline__ const float* ln_d_g() const { return in(10); }
    __device__ __forceinline__ const float* ln_d_b() const { return in(11); }
    __device__ __forceinline__ const float* w_out() const { return in(12); }
    __device__ __forceinline__ const float* post_mix_g() const { return in(13); }
    __device__ __forceinline__ const float* pre_ffn_g() const { return in(14); }
    __device__ __forceinline__ const float* w_ff1() const { return in(15); }
    __device__ __forceinline__ const float* w_ff2() const { return in(16); }
    __device__ __forceinline__ const float* post_ffn_g() const { return in(17); }
    float* out;
    unsigned char* ws;
    __device__ __forceinline__ bf16* Z() const { return (bf16*)(ws + WS_Z); }
    __device__ __forceinline__ bf16* Y() const { return (bf16*)(ws + WS_Y); }
    __device__ __forceinline__ bf16* H() const { return (bf16*)(ws + WS_H); }
    __device__ __forceinline__ float* RS() const { return (float*)(ws + WS_RS); }
    __device__ __forceinline__ char* KT() const { return (char*)(ws + WS_KT); }
    __device__ __forceinline__ char* VT() const { return (char*)(ws + WS_VT); }
    __device__ __forceinline__ gu32* ctl() const { return (gu32*)(ws + WS_CTL); }
};
__device__ __forceinline__ bf16* wt_ptr(Frame& F, int l, size_t off) { return (bf16*)(F.ws + WS_W + (size_t)l * W_LAYER + off); }

__device__ __forceinline__ float wave_sum(float v) {
#pragma unroll
    for (int o = 1; o < 64; o <<= 1) v += __shfl_xor(v, o);
    return v;
}
__device__ __forceinline__ unsigned cvtpk(float lo, float hi) { typedef float f2 __attribute__((ext_vector_type(2))); typedef __bf16 b2 __attribute__((ext_vector_type(2))); f2 v = {lo, hi}; b2 b = __builtin_convertvector(v, b2); return __builtin_bit_cast(unsigned, b); }
__device__ __forceinline__ float bflo(unsigned w) { return __uint_as_float(w << 16); }
__device__ __forceinline__ float bfhi(unsigned w) { return __uint_as_float(w & 0xffff0000u); }
__device__ __forceinline__ float sigmoidf_(float x) { return __builtin_amdgcn_rcpf(1.0f + __expf(-x)); }
__device__ __forceinline__ int win_dst_row(int ns) {
    if (ns >= 512 && ns < 1536) { const int v = ns >= 1024, r = ns - (v ? 1024 : 512); return 512 + 256 * (r >> 7) + 128 * v + (r & 127); }
    if (ns >= 3072) { const int v = ns >= 3584, r = ns - (v ? 3584 : 3072); return 3072 + 256 * (r >> 7) + 128 * v + (r & 127); }
    return ns;
}
template <bool WIN_ORDER>
__device__ __forceinline__ void p0_transpose_item(const float* W, int K, int N, bf16* WT, LAS unsigned char* scr, int item, int lane, const float* gk) {
    const int nblk = N / 64, kb = item / nblk, nb = item % nblk, k0 = 64 * kb, n0 = 64 * nb;
    const int sub = lane >> 4, nq = 4 * (lane & 15);
    f32x4 v[16]; float g[16];
#pragma unroll
    for (int i = 0; i < 16; ++i) v[i] = __builtin_nontemporal_load((const GAS f32x4*)(W + (size_t)(k0 + 4 * i + sub) * N + n0 + nq));
#pragma unroll
    for (int i = 0; i < 16; ++i) g[i] = gk ? gk[k0 + 4 * i + sub] : 1.0f;
#pragma unroll
    for (int i = 0; i < 16; ++i) { const int k = 4 * i + sub; const f32x4 x = v[i] * g[i]; const unsigned w01 = cvtpk(x.x, x.y), w23 = cvtpk(x.z, x.w);
        LAS unsigned short* t = (LAS unsigned short*)(scr + nq * 132 + 2 * k);
        t[0] = (unsigned short)w01; t[66] = (unsigned short)(w01 >> 16); t[132] = (unsigned short)w23; t[198] = (unsigned short)(w23 >> 16); }
    LDS_WAIT(); asm volatile("" ::: "memory");
    const int rbase = WIN_ORDER ? win_dst_row(n0) : n0, r16 = lane >> 2, cg = lane & 3;
#pragma unroll
    for (int j = 0; j < 8; ++j) { const int rbi = j >> 1, cbi = j & 1, p = 16 * rbi + r16, n = (p & ~31) + pg8::perm32(p & 31);
        const LAS unsigned* r = (const LAS unsigned*)(scr + n * 132 + (32 * cbi + 8 * cg) * 2);
        v4u o; o.x = r[0]; o.y = r[1]; o.z = r[2]; o.w = r[3];
        *(GAS v4u*)((char*)WT + pg8::tiled_off(rbase + p, k0 + 32 * cbi + 8 * cg, K)) = o; }
    LDS_WAIT(); asm volatile("" ::: "memory");
}
__device__ __forceinline__ const float* xin_row(Frame& F, int m) { return m < MP ? F.xp() + (size_t)m * DM : F.xs() + (size_t)(m - MP) * DM; }

__device__ __forceinline__ void p0_prologue(Frame& F) {
    LAS unsigned char* scr = F.lds + RING_OFF + F.wave * 16384;
    const int gw = F.vcu * NWAVES + F.wave, NGW = F.G * NWAVES;
    constexpr int I_IN = (DM / 64) * (INW / 64), I_OUT = (DM / 64) * (DM / 64), I_F1 = (DM / 64) * (FF / 64), I_F2 = (FF / 64) * (DM / 64), I_L = I_IN + I_OUT + I_F1 + I_F2;
    for (int it = gw; it < DEPTH * I_L; it += NGW) {
        const int l = it / I_L; int r = it % I_L;
        if (r < I_IN) { p0_transpose_item<true>(F.w_in() + (size_t)l * DM * INW, DM, INW, wt_ptr(F, l, WO_IN), scr, r, F.lane, F.pre_mix_g() + l * DM); continue; } r -= I_IN;
        if (r < I_OUT) { p0_transpose_item<false>(F.w_out() + (size_t)l * DM * DM, DM, DM, wt_ptr(F, l, WO_OUT), scr, r, F.lane, nullptr); continue; } r -= I_OUT;
        if (r < I_F1) { p0_transpose_item<false>(F.w_ff1() + (size_t)l * DM * FF, DM, FF, wt_ptr(F, l, WO_F1), scr, r, F.lane, F.pre_ffn_g() + l * DM); continue; } r -= I_F1;
        p0_transpose_item<false>(F.w_ff2() + (size_t)l * FF * DM, FF, DM, wt_ptr(F, l, WO_F2), scr, r, F.lane, nullptr);
    }
    for (int mb = gw; mb < M; mb += 4 * NGW) {
        f32x4 x[4][4][2];
#pragma unroll
        for (int k = 0; k < 4; ++k) { const int m = mb + k * NGW; if (m < M) { const float* xr = xin_row(F, m);
#pragma unroll
            for (int j = 0; j < 4; ++j) { x[k][j][0] = __builtin_nontemporal_load((const GAS f32x4*)(xr + j * 512 + F.lane * 8)); x[k][j][1] = __builtin_nontemporal_load((const GAS f32x4*)(xr + j * 512 + F.lane * 8 + 4)); } } }
#pragma unroll
        for (int k = 0; k < 4; ++k) { const int m = mb + k * NGW; if (m < M) { float ss = 0.f;
#pragma unroll
            for (int j = 0; j < 4; ++j) { const f32x4 a = x[k][j][0], b = x[k][j][1]; ss += (a.x * a.x + a.y * a.y) + (a.z * a.z + a.w * a.w) + (b.x * b.x + b.y * b.y) + (b.z * b.z + b.w * b.w);
                v4u o; o.x = cvtpk(a.x, a.y); o.y = cvtpk(a.z, a.w); o.z = cvtpk(b.x, b.y); o.w = cvtpk(b.z, b.w);
                *(GAS v4u*)(F.H() + (size_t)m * DM + j * 512 + F.lane * 8) = o; }
            const float r = rsqrtf(wave_sum(ss) * (1.0f / DM) + RMS_EPS);
            if (F.lane == 0) F.RS()[m] = r; } }
    }
}

template <bool FINAL, bool FIRSTX>
__device__ __forceinline__ void norm_pass(Frame& F, const bf16* YPb, const float* gpost) {
    constexpr int R = FIRSTX ? 2 : 4;
    const int gw = F.vcu * NWAVES + F.wave, NGW = F.G * NWAVES;
    f32x4 ga[4][2];
#pragma unroll
    for (int j = 0; j < 4; ++j) { ga[j][0] = *(const GAS f32x4*)(gpost + j * 512 + F.lane * 8); ga[j][1] = *(const GAS f32x4*)(gpost + j * 512 + F.lane * 8 + 4); }
    for (int mb = gw; mb < M; mb += R * NGW) {
        v4u y[R][4]; v4u xb[R][4]; f32x4 xf[FIRSTX ? R : 1][4][2];
#pragma unroll
        for (int k = 0; k < R; ++k) { const int m = mb + k * NGW; if (m < M) {
#pragma unroll
            for (int j = 0; j < 4; ++j) y[k][j] = __builtin_nontemporal_load((const GAS v4u*)(YPb + (size_t)m * DM + j * 512 + F.lane * 8));
            if constexpr (FIRSTX) { const float* xr = xin_row(F, m);
#pragma unroll
                for (int j = 0; j < 4; ++j) { xf[k][j][0] = __builtin_nontemporal_load((const GAS f32x4*)(xr + j * 512 + F.lane * 8)); xf[k][j][1] = __builtin_nontemporal_load((const GAS f32x4*)(xr + j * 512 + F.lane * 8 + 4)); }
            } else {
#pragma unroll
                for (int j = 0; j < 4; ++j) xb[k][j] = __builtin_nontemporal_load((const GAS v4u*)(F.H() + (size_t)m * DM + j * 512 + F.lane * 8));
            } } }
#pragma unroll
        for (int k = 0; k < R; ++k) { const int m = mb + k * NGW; if (m < M) {
            float ss = 0.f;
#pragma unroll
            for (int j = 0; j < 4; ++j) { const v4u w = y[k][j]; const float a0 = bflo(w.x), a1 = bfhi(w.x), a2 = bflo(w.y), a3 = bfhi(w.y), a4 = bflo(w.z), a5 = bfhi(w.z), a6 = bflo(w.w), a7 = bfhi(w.w);
                ss += (a0 * a0 + a1 * a1) + (a2 * a2 + a3 * a3) + (a4 * a4 + a5 * a5) + (a6 * a6 + a7 * a7); }
            const float r = rsqrtf(wave_sum(ss) * (1.0f / DM) + RMS_EPS);
            float s2 = 0.f;
#pragma unroll
            for (int j = 0; j < 4; ++j) { const v4u w = y[k][j];
                const f32x4 y0 = (f32x4){bflo(w.x), bfhi(w.x), bflo(w.y), bfhi(w.y)}, y1 = (f32x4){bflo(w.z), bfhi(w.z), bflo(w.w), bfhi(w.w)};
                f32x4 x0, x1;
                if constexpr (FIRSTX) { x0 = xf[k][j][0]; x1 = xf[k][j][1]; }
                else { const v4u q = xb[k][j]; x0 = (f32x4){bflo(q.x), bfhi(q.x), bflo(q.y), bfhi(q.y)}; x1 = (f32x4){bflo(q.z), bfhi(q.z), bflo(q.w), bfhi(q.w)}; }
                const f32x4 v0 = x0 + y0 * r * ga[j][0], v1 = x1 + y1 * r * ga[j][1];
                if constexpr (FINAL) { __builtin_nontemporal_store(v0, (GAS f32x4*)(F.out + (size_t)m * DM + j * 512 + F.lane * 8)); __builtin_nontemporal_store(v1, (GAS f32x4*)(F.out + (size_t)m * DM + j * 512 + F.lane * 8 + 4)); }
                else { s2 += (v0.x * v0.x + v0.y * v0.y) + (v0.z * v0.z + v0.w * v0.w) + (v1.x * v1.x + v1.y * v1.y) + (v1.z * v1.z + v1.w * v1.w);
                    v4u o; o.x = cvtpk(v0.x, v0.y); o.y = cvtpk(v0.z, v0.w); o.z = cvtpk(v1.x, v1.y); o.w = cvtpk(v1.z, v1.w);
                    *(GAS v4u*)(F.H() + (size_t)m * DM + j * 512 + F.lane * 8) = o; } }
            if constexpr (!FINAL) { const float r2 = rsqrtf(wave_sum(s2) * (1.0f / DM) + RMS_EPS); if (F.lane == 0) F.RS()[m] = r2; }
        } }
    }
}

constexpr int PREP_T = 32, PREP_U_ROWS = PREP_T + 30, PREP_TW = PREP_T / NWAVES;
constexpr int PREP_V_OFF = PREP_U_ROWS * 512 * 2;
static_assert(PREP_V_OFF % 16 == 0 && PREP_V_OFF + PREP_T * 512 * 4 <= RING_BYTES, "prep LDS");
__device__ __forceinline__ void rope_store4(bf16* p1, bf16* p2, const float (&a)[4], const float (&b)[4], const float (&c)[4], const float (&s)[4], float scale, bool pred) {
    float o1[4], o2[4];
#pragma unroll
    for (int k = 0; k < 4; ++k) { o1[k] = (a[k] * c[k] - b[k] * s[k]) * scale; o2[k] = (b[k] * c[k] + a[k] * s[k]) * scale; }
    if (pred) { u32x2 w1, w2; w1.x = cvtpk(o1[0], o1[1]); w1.y = cvtpk(o1[2], o1[3]); w2.x = cvtpk(o2[0], o2[1]); w2.y = cvtpk(o2[2], o2[3]);
        *(GAS u32x2*)p1 = w1; *(GAS u32x2*)p2 = w2; }
}
__device__ __forceinline__ void load4x2(const bf16* p1, const bf16* p2, float (&a)[4], float (&b)[4]) {
    const u32x2 w1 = *(const GAS u32x2*)p1, w2 = *(const GAS u32x2*)p2;
    a[0] = bflo(w1.x); a[1] = bfhi(w1.x); a[2] = bflo(w1.y); a[3] = bfhi(w1.y); b[0] = bflo(w2.x); b[1] = bfhi(w2.x); b[2] = bflo(w2.y); b[3] = bfhi(w2.y);
}
__device__ __forceinline__ void unpack8(const v4u w, float (&f)[8]) { f[0] = bflo(w.x); f[1] = bfhi(w.x); f[2] = bflo(w.y); f[3] = bfhi(w.y); f[4] = bflo(w.z); f[5] = bfhi(w.z); f[6] = bflo(w.w); f[7] = bfhi(w.w); }

__device__ __forceinline__ void prep_phase(Frame& F, const int l) {
    LAS bf16* Ub = (LAS bf16*)(F.lds + RING_OFF);
    LAS float* V = (LAS float*)(F.lds + RING_OFF + PREP_V_OFF);
    const int lane = F.lane, tid = F.tid, wave = F.wave;
    const float* cdw = F.conv_d_w() + (size_t)l * 31 * 512;
    float wd[31];
#pragma unroll
    for (int j = 0; j < 31; ++j) wd[j] = cdw[j * 512 + tid];
    const float cdb = F.conv_d_b()[l * 512 + tid];
    const float* caw = F.conv_a_w() + (size_t)l * 3 * 512;
    const float* gk = F.k_norm_g() + l * 64;
    const int c0 = lane * 8;
    f32x4 wa[3][2];
#pragma unroll
    for (int j = 0; j < 3; ++j) { wa[j][0] = *(const GAS f32x4*)(caw + j * 512 + c0); wa[j][1] = *(const GAS f32x4*)(caw + j * 512 + c0 + 4); }
    const f32x4 g0 = *(const GAS f32x4*)(F.ln_d_g() + l * 512 + c0), g1 = *(const GAS f32x4*)(F.ln_d_g() + l * 512 + c0 + 4), b0 = *(const GAS f32x4*)(F.ln_d_b() + l * 512 + c0), b1 = *(const GAS f32x4*)(F.ln_d_b() + l * 512 + c0 + 4);
    constexpr int NST = (PREP_U_ROWS * 64 + 511) / 512;
    for (int item = F.vcu; item < M / PREP_T; item += F.G) {
        const int m0 = item * PREP_T;
        int t0, S; if (m0 < MP) { t0 = m0 & (SP - 1); S = SP; } else { t0 = (m0 - MP) & (SS - 1); S = SS; }
        v4u stg[NST];
#pragma unroll
        for (int it = 0; it < NST; ++it) { const int id = it * 512 + tid, rr = id >> 6, ch = (id & 63) * 8, tp = t0 - 15 + rr;
            stg[it] = (v4u){0u, 0u, 0u, 0u};
            if (id < PREP_U_ROWS * 64 && tp >= 0 && tp < S) stg[it] = *(const GAS v4u*)(F.Z() + (size_t)(m0 - 15 + rr) * ZW + Z_U + ch); }
        const int ta = t0 + PREP_TW * wave, ma = m0 + PREP_TW * wave;
        v4u pr[PREP_TW + 2], ab[PREP_TW];
#pragma unroll
        for (int j = 0; j < PREP_TW + 2; ++j) { const int tp = ta + j - 1; pr[j] = (v4u){0u, 0u, 0u, 0u};
            if (tp >= 0 && tp < S) pr[j] = *(const GAS v4u*)(F.Z() + (size_t)(ma + j - 1) * ZW + Z_P + c0); }
#pragma unroll
        for (int j = 0; j < PREP_TW; ++j) ab[j] = *(const GAS v4u*)(F.Z() + (size_t)(ma + j) * ZW + ZA_B + c0);
        const int grp = lane >> 5, hk = (lane >> 3) & 1, sl = lane & 7, half = sl >> 2;
        const int i0 = grp ? 4 * sl : 4 * (sl & 3);
        const int koff = grp ? (ZC_K + hk * 64 + i0) : (ZB_K + hk * 64 + half * 32 + i0), kd = grp ? 32 : 16;
        u32x2 kw[PREP_TW / 2][2];
#pragma unroll
        for (int q = 0; q < PREP_TW / 2; ++q) { const bf16* p1 = F.Z() + (size_t)(ma + 2 * q + ((lane >> 4) & 1)) * ZW + koff; kw[q][0] = *(const GAS u32x2*)p1; kw[q][1] = *(const GAS u32x2*)(p1 + kd); }
        unsigned vld[2][4];
#pragma unroll
        for (int it = 0; it < 2; ++it) { const int id = it * 512 + tid, qd = id >> 7, cb = (id >> 5) & 3, dp = id & 31;
#pragma unroll
            for (int j = 0; j < 4; ++j) vld[it][j] = *(const GAS unsigned*)(F.Z() + (size_t)(m0 + 4 * qd + j) * ZW + ((cb >> 1) ? ZC_V : ZB_V) + (cb & 1) * 64 + 2 * dp); }
#pragma unroll
        for (int it = 0; it < NST; ++it) { const int id = it * 512 + tid, rr = id >> 6, ch = (id & 63) * 8;
            if (id < PREP_U_ROWS * 64) *(LAS v4u*)(Ub + rr * 512 + ch) = stg[it]; }
#pragma unroll
        for (int it = 0; it < 2; ++it) { const int id = it * 512 + tid, qd = id >> 7, cb = (id >> 5) & 3, dp = id & 31;
            int w0 = 0, w1 = 0;
            w0 = __builtin_amdgcn_cvt_pk_fp8_f32(bflo(vld[it][0]), bflo(vld[it][1]), w0, false); w0 = __builtin_amdgcn_cvt_pk_fp8_f32(bflo(vld[it][2]), bflo(vld[it][3]), w0, true);
            w1 = __builtin_amdgcn_cvt_pk_fp8_f32(bfhi(vld[it][0]), bfhi(vld[it][1]), w1, false); w1 = __builtin_amdgcn_cvt_pk_fp8_f32(bfhi(vld[it][2]), bfhi(vld[it][3]), w1, true);
            char* vt = F.VT() + ((size_t)(cb * (M / 64) + (m0 >> 6)) << 12) + (qd & 1) * 2048 + ((m0 >> 5) & 1) * 1024 + 4 * (qd >> 1);
            *(GAS int*)(vt + (2 * dp) * 16) = w0; *(GAS int*)(vt + (2 * dp + 1) * 16) = w1; }
#pragma unroll
        for (int q = 0; q < PREP_TW; ++q) { float acc[8], bb[8];
#pragma unroll
            for (int k = 0; k < 8; ++k) acc[k] = 0.f;
#pragma unroll
            for (int j = 0; j < 3; ++j) { float pp[8]; unpack8(pr[q + j], pp);
                acc[0] += wa[j][0].x * pp[0]; acc[1] += wa[j][0].y * pp[1]; acc[2] += wa[j][0].z * pp[2]; acc[3] += wa[j][0].w * pp[3];
                acc[4] += wa[j][1].x * pp[4]; acc[5] += wa[j][1].y * pp[5]; acc[6] += wa[j][1].z * pp[6]; acc[7] += wa[j][1].w * pp[7]; }
            unpack8(ab[q], bb);
            v4u o; o.x = cvtpk(bb[0] * acc[0], bb[1] * acc[1]); o.y = cvtpk(bb[2] * acc[2], bb[3] * acc[3]); o.z = cvtpk(bb[4] * acc[4], bb[5] * acc[5]); o.w = cvtpk(bb[6] * acc[6], bb[7] * acc[7]);
            *(GAS v4u*)(F.Y() + (size_t)(ma + q) * DM + Y_A + c0) = o; }
#pragma unroll
        for (int q = 0; q < PREP_TW / 2; ++q) {
            const int tk = PREP_TW * wave + 2 * q + ((lane >> 4) & 1), tpos = t0 + tk;
            const int pos = grp ? tpos : (half ? (tpos & 63) : (tpos >> 6));
            const int mr = m0 + tk, f1 = grp ? i0 : half * 32 + i0, f2 = f1 + kd;
            char* kt = F.KT() + ((size_t)((grp * 2 + hk) * (M / 64) + (mr >> 6)) << 12) + (mr & 63) * 16;
            int* p1 = (int*)(kt + ((f1 >> 3) & 1) * 2048 + (f1 >> 5) * 1024 + ((f1 >> 4) & 1) * 8 + (f1 & 7)); int* p2 = (int*)(kt + ((f2 >> 3) & 1) * 2048 + (f2 >> 5) * 1024 + ((f2 >> 4) & 1) * 8 + (f2 & 7));
            float cs[4], sn[4];
#pragma unroll
            for (int k = 0; k < 4; ++k) sincos_f((float)pos * INVF[grp ? (i0 + k) : 2 * (i0 + k)], sn[k], cs[k]);
            float a[4], b[4];
            a[0] = bflo(kw[q][0].x); a[1] = bfhi(kw[q][0].x); a[2] = bflo(kw[q][0].y); a[3] = bfhi(kw[q][0].y); b[0] = bflo(kw[q][1].x); b[1] = bfhi(kw[q][1].x); b[2] = bflo(kw[q][1].y); b[3] = bfhi(kw[q][1].y);
            float ss = (a[0] * a[0] + a[1] * a[1]) + (a[2] * a[2] + a[3] * a[3]) + (b[0] * b[0] + b[1] * b[1]) + (b[2] * b[2] + b[3] * b[3]);
            ss += __shfl_xor(ss, 1); ss += __shfl_xor(ss, 2); ss += __shfl_xor(ss, 4);
            const float r = grp ? 1.0f : rsqrtf(ss * (1.0f / 64.0f) + RMS_EPS);
#pragma unroll
            for (int k = 0; k < 4; ++k) { const int gi = grp ? 0 : (half * 32 + i0);
                const float g1k = grp ? 1.0f : gk[gi + k], g2k = grp ? 1.0f : gk[gi + 16 + k]; a[k] = a[k] * r * g1k; b[k] = b[k] * r * g2k; }
            {   float o1[4], o2[4];
#pragma unroll
                for (int k = 0; k < 4; ++k) { o1[k] = a[k] * cs[k] - b[k] * sn[k]; o2[k] = b[k] * cs[k] + a[k] * sn[k]; }
                int w1 = 0, w2 = 0;
                w1 = __builtin_amdgcn_cvt_pk_fp8_f32(o1[0], o1[1], w1, false); w1 = __builtin_amdgcn_cvt_pk_fp8_f32(o1[2], o1[3], w1, true);
                w2 = __builtin_amdgcn_cvt_pk_fp8_f32(o2[0], o2[1], w2, false); w2 = __builtin_amdgcn_cvt_pk_fp8_f32(o2[2], o2[3], w2, true);
                *(GAS int*)p1 = w1; *(GAS int*)p2 = w2; }
        }
        __syncthreads();
        {   float uu[PREP_U_ROWS];
#pragma unroll
            for (int rr = 0; rr < PREP_U_ROWS; ++rr) uu[rr] = __uint_as_float((unsigned)Ub[rr * 512 + tid] << 16);
#pragma unroll
            for (int tt = 0; tt < PREP_T; ++tt) { float a = cdb;
#pragma unroll
                for (int j = 0; j < 31; ++j) a += wd[j] * uu[tt + j];
                V[tt * 512 + tid] = a; } }
        __syncthreads();
        {   f32x4 v0[PREP_TW], v1[PREP_TW]; float sm[PREP_TW];
#pragma unroll
            for (int q = 0; q < PREP_TW; ++q) { const int tt = PREP_TW * wave + q; v0[q] = *(const LAS f32x4*)(V + tt * 512 + c0); v1[q] = *(const LAS f32x4*)(V + tt * 512 + c0 + 4);
                sm[q] = (v0[q].x + v0[q].y) + (v0[q].z + v0[q].w) + (v1[q].x + v1[q].y) + (v1[q].z + v1[q].w); }
#pragma unroll
            for (int o = 1; o < 64; o <<= 1)
#pragma unroll
                for (int q = 0; q < PREP_TW; ++q) sm[q] += __shfl_xor(sm[q], o);
#pragma unroll
            for (int q = 0; q < PREP_TW; ++q) { const float mean = sm[q] * (1.0f / 512.0f); v0[q] = v0[q] - mean; v1[q] = v1[q] - mean;
                sm[q] = (v0[q].x * v0[q].x + v0[q].y * v0[q].y) + (v0[q].z * v0[q].z + v0[q].w * v0[q].w) + (v1[q].x * v1[q].x + v1[q].y * v1[q].y) + (v1[q].z * v1[q].z + v1[q].w * v1[q].w); }
#pragma unroll
            for (int o = 1; o < 64; o <<= 1)
#pragma unroll
                for (int q = 0; q < PREP_TW; ++q) sm[q] += __shfl_xor(sm[q], o);
#pragma unroll
            for (int q = 0; q < PREP_TW; ++q) { const int m = m0 + PREP_TW * wave + q; const float r = rsqrtf(sm[q] * (1.0f / 512.0f) + LN_EPS);
                f32x4 y0 = v0[q] * r * g0 + b0, y1 = v1[q] * r * g1 + b1;
                y0 = (f32x4){y0.x * sigmoidf_(y0.x), y0.y * sigmoidf_(y0.y), y0.z * sigmoidf_(y0.z), y0.w * sigmoidf_(y0.w)};
                y1 = (f32x4){y1.x * sigmoidf_(y1.x), y1.y * sigmoidf_(y1.y), y1.z * sigmoidf_(y1.z), y1.w * sigmoidf_(y1.w)};
                v4u o; o.x = cvtpk(y0.x, y0.y); o.y = cvtpk(y0.z, y0.w); o.z = cvtpk(y1.x, y1.y); o.w = cvtpk(y1.z, y1.w);
                *(GAS v4u*)(F.Y() + (size_t)m * DM + Y_D + c0) = o; } }
        __syncthreads();
    }
}

__device__ __forceinline__ void attn_phase_all(Frame& F, const int l, char* shm) {
    typedef attn_body::bf16 abf;
    const abf* Z = (const abf*)F.Z(); abf* Y = (abf*)F.Y();
    float gqm = __builtin_fabsf(F.q_norm_g()[l * 64 + F.lane]), gkm = __builtin_fabsf(F.k_norm_g()[l * 64 + F.lane]);
#pragma unroll
    for (int o = 1; o < 64; o <<= 1) { gqm = __builtin_fmaxf(gqm, __shfl_xor(gqm, o)); gkm = __builtin_fmaxf(gkm, __shfl_xor(gkm, o)); }
    const int ref0 = __builtin_amdgcn_readfirstlane((int)__builtin_ceilf(__builtin_fminf(__builtin_fmaxf((8.0f * LOG2E) * gqm * gkm - 15.5f, 0.f), 100.f)));
    const bool fast = ref0 <= 6;
    const float pscale = __int_as_float((127 + ref0) << 23);
    LAS int* const tkw = (LAS int*)(F.lds + LDSCTL_OFF + 64);
    unsigned* const ctrA = (unsigned*)(F.ctl() + CW_ATT + l * 128), * const ctrB = ctrA + 64;
#define ATT_BCAST(dst, v) do { if (F.tid == 0) *tkw = (v); asm volatile("s_waitcnt lgkmcnt(0)\n\ts_barrier" ::: "memory"); { const int r_ = *tkw; asm volatile("s_waitcnt lgkmcnt(0)\n\ts_barrier" ::: "memory"); (dst) = __builtin_amdgcn_readfirstlane(r_); } } while (0)
    {   int i = 0, tkt = -1;
        for (;;) {
            int idx;
            if (tkt < 0) { idx = i * F.G + F.vcu; ++i; if (idx >= 1024) { int t0 = 0; if (F.tid == 0) t0 = (int)__hip_atomic_fetch_add(ctrA, 1u, __ATOMIC_RELAXED, __HIP_MEMORY_SCOPE_AGENT); ATT_BCAST(tkt, t0); continue; } }
            else { if (tkt >= 256) break; idx = 1024 + tkt; }
            int tn = 0; if (tkt >= 0 && F.tid == 0) tn = (int)__hip_atomic_fetch_add(ctrA, 1u, __ATOMIC_RELAXED, __HIP_MEMORY_SCOPE_AGENT);
            const int r = idx >> 8, v = idx & 255, x = v >> 5, j = v & 31;
            int head, kv, qb, NT; long srow;
            if (r < 4) { const int sx = x >> 1; kv = sx & 1; head = kv * 4 + (x & 1) * 2 + (r >> 1); qb = (r & 1) * 32 + j; srow = (long)(sx >> 1) * SP; NT = SP / 64; }
            else { kv = x & 1; head = kv * 4 + (j >> 3); qb = j & 7; srow = (long)MP + (long)(x >> 1) * SS; NT = SS / 64; }
            const long qrow = srow + qb * 256;
            const size_t kvo = ((size_t)(kv * (M / 64)) + (size_t)(srow >> 6)) << 13;
            if (fast) attn_body::attn_unit<2, 8, 1>(Z + qrow * ZW + ZB_Q + head * 64, F.KT() + (kvo >> 1), F.VT() + (kvo >> 1), Y + qrow * DM + Y_B + head * 64, NT, 0, 0, pscale, qb * 256, F.q_norm_g() + l * 64, shm);
            else attn_body::attn_unit<0, 8, 1>(Z + qrow * ZW + ZB_Q + head * 64, F.KT() + (kvo >> 1), F.VT() + (kvo >> 1), Y + qrow * DM + Y_B + head * 64, NT, 0, 0, 0.f, qb * 256, F.q_norm_g() + l * 64, shm);
            if (tkt >= 0) ATT_BCAST(tkt, tn);
        }
    }
    {   int tkt, t0 = 0; if (F.tid == 0) t0 = (int)__hip_atomic_fetch_add(ctrB, 1u, __ATOMIC_RELAXED, __HIP_MEMORY_SCOPE_AGENT); ATT_BCAST(tkt, t0);
        while (tkt < 1280) {
            int tn = 0; if (F.tid == 0) tn = (int)__hip_atomic_fetch_add(ctrB, 1u, __ATOMIC_RELAXED, __HIP_MEMORY_SCOPE_AGENT);
            const int u = tkt, qblk = u >> 3, head = u & 7, kv = head >> 2; const long qrow = (long)qblk * 256;
            long srow; int S; if (qrow < MP) { srow = (qrow / SP) * SP; S = SP; } else { srow = MP + ((qrow - MP) / SS) * SS; S = SS; }
            const int q0 = (int)(qrow - srow);
            const float sink2 = F.sink_c()[l * 8 + head] * LOG2E;
            const size_t kvo = ((size_t)((2 + kv) * (M / 64)) + (size_t)(srow >> 6)) << 13;
            attn_body::attn_unit<1, 8, 2>(Z + qrow * ZW + ZC_Q + head * 64, F.KT() + (kvo >> 1), F.VT() + (kvo >> 1), Y + qrow * DM + Y_C + head * 64, 8, q0, S, sink2, q0, nullptr, shm);
            ATT_BCAST(tkt, tn);
        }
    }
#undef ATT_BCAST
}

struct Args { const float* in[18]; float* out; unsigned char* ws; int ph_lo, ph_hi, li, pad; };
__global__ void __launch_bounds__(NWAVES * 64, 2) fwd(Args args) {
    extern __shared__ __attribute__((aligned(16))) unsigned char lds[];
    Frame F;
    F.lds = (LAS unsigned char*)lds;
    F.MISC = (volatile LAS unsigned*)(F.lds + MISC_OFF);
    F.tid = threadIdx.x; F.lane = F.tid & 63; F.wave = __builtin_amdgcn_readfirstlane(F.tid >> 6);
    F.G = gridDim.x; { const int bx = blockIdx.x; F.vcu = (F.G % 8 == 0) ? (bx % 8) * (F.G / 8) + bx / 8 : bx; }
    unsigned char* ws = args.ws; F.ws = ws;
    F.out = args.out;
    bf16* const YPb = F.Z();
    bf16* const U0 = F.Y();
    bf16* const U1 = (bf16*)(ws + WS_U1);
    for (int u = F.tid; u < (LDS_BYTES - LDSCTL_OFF) / 4; u += NWAVES * 64) ((LAS unsigned*)(F.lds + LDSCTL_OFF))[u] = 0u;
    __syncthreads();
    XcdBarrier bar; bar.bar = (unsigned*)(F.ctl() + CW_BAR); bar.x = 0; bar.st = nullptr;
    if (MK_N_LAUNCHES == 1) bar = xcd_barrier_post((unsigned*)(F.ctl() + CW_BAR), F.MISC + 8);
    const int lo = args.ph_lo, hi = args.ph_hi; int ph = 0;
#define PH_BEGIN if (lo <= ph && ph < hi) { { int t_ = threadIdx.x; asm volatile("" : "+v"(t_)); F.tid = t_; F.lane = t_ & 63; F.wave = __builtin_amdgcn_readfirstlane(t_ >> 6); }
#define PH_END   if (ph + 1 < hi) xcd_barrier(bar); } ++ph;

    PH_BEGIN p0_prologue(F); PH_END

#pragma unroll 1
    for (int l = 0; l < DEPTH; ++l) {
        PH_BEGIN { pg8::Gemm g{F.H(), wt_ptr(F, l, WO_IN), M, INW, DM}; pg8::StaticOrder S; S.init(M, INW, F.G, (int)blockIdx.x);
            pg8::EpiIn E{F.Z(), ZW, F.RS()};
            pg8::gemm_phase<pg8::EpiIn, pg8::StaticOrder, true, true>(F.lds + RING_OFF, g, S, E); } PH_END
        PH_BEGIN prep_phase(F, l); PH_END
        PH_BEGIN attn_phase_all(F, l, (char*)lds + RING_OFF); PH_END
        PH_BEGIN { pg8::Gemm g{F.Y(), wt_ptr(F, l, WO_OUT), M, DM, DM}; pg8::StaticOrder S; S.init(M, DM, F.G, (int)blockIdx.x);
            pg8::EpiBf16<0, false> E{YPb, DM, nullptr};
            pg8::gemm_phase<pg8::EpiBf16<0, false>, pg8::StaticOrder, true, true>(F.lds + RING_OFF, g, S, E); } PH_END
        PH_BEGIN if (l == 0) norm_pass<false, true>(F, YPb, F.post_mix_g() + l * DM); else norm_pass<false, false>(F, YPb, F.post_mix_g() + l * DM); PH_END
        PH_BEGIN { pg8::Gemm g{F.H(), wt_ptr(F, l, WO_F1), MC, FF, DM}; pg8::StaticOrder S; S.init(MC, FF, F.G, (int)blockIdx.x);
            pg8::EpiBf16<2, true, true> E{U0, FF, F.RS()};
            pg8::gemm_phase<pg8::EpiBf16<2, true, true>, pg8::StaticOrder, true, true>(F.lds + RING_OFF, g, S, E); } PH_END
#pragma unroll 1
        for (int c = 0; c + 1 < NCHUNK; ++c) {
            PH_BEGIN {
                bf16* const Ur = (c & 1) ? U1 : U0; bf16* const Uw = (c & 1) ? U0 : U1;
                { pg8::Gemm g{Ur, wt_ptr(F, l, WO_F2), MC, DM, FF}; pg8::StaticOrder S; S.init(MC, DM, F.G, (int)blockIdx.x);
                  pg8::EpiBf16<0, false> E{YPb + (size_t)c * MC * DM, DM, nullptr};
                  pg8::gemm_phase<pg8::EpiBf16<0, false>, pg8::StaticOrder, true, true, true>(F.lds + RING_OFF, g, S, E); }
                __syncthreads();
                { pg8::Gemm g{F.H() + (size_t)(c + 1) * MC * DM, wt_ptr(F, l, WO_F1), MC, FF, DM}; pg8::StaticOrder S; S.init(MC, FF, F.G, (int)blockIdx.x);
                  pg8::EpiBf16<2, true, true> E{Uw, FF, F.RS() + (size_t)(c + 1) * MC};
                  pg8::gemm_phase<pg8::EpiBf16<2, true, true>, pg8::StaticOrder, true, true>(F.lds + RING_OFF, g, S, E); }
            } PH_END
        }
        PH_BEGIN { pg8::Gemm g{((NCHUNK - 1) & 1) ? U1 : U0, wt_ptr(F, l, WO_F2), MC, DM, FF}; pg8::StaticOrder S; S.init(MC, DM, F.G, (int)blockIdx.x);
            pg8::EpiBf16<0, false> E{YPb + (size_t)(NCHUNK - 1) * MC * DM, DM, nullptr};
            pg8::gemm_phase<pg8::EpiBf16<0, false>, pg8::StaticOrder, true, true, true>(F.lds + RING_OFF, g, S, E); } PH_END
        PH_BEGIN if (l + 1 < DEPTH) norm_pass<false, false>(F, YPb, F.post_ffn_g() + l * DM); else norm_pass<true, false>(F, YPb, F.post_ffn_g() + l * DM); PH_END
    }
#undef PH_BEGIN
#undef PH_END
}

extern "C" void kernel_launch(void* const* d_in, const int* in_sizes, int n_in, void* d_out, int out_size, void* d_ws, size_t ws_size, hipStream_t stream) {
    static int grid = 0;
    if (grid == 0) {
        if (n_in != 18 || in_sizes[0] != MP * DM || in_sizes[1] != MS * DM || out_size != M * DM || ws_size < WS_END) {
            fprintf(stderr, "kernel_launch: unexpected shapes (n_in %d, in0 %d, in1 %d, out %d, ws %zu; need ws >= %zu); nothing launched\n", n_in, n_in > 0 ? in_sizes[0] : -1, n_in > 1 ? in_sizes[1] : -1, out_size, ws_size, (size_t)WS_END); grid = -1; return; }
        int dev = 0, cus = 0, per_cu = 0;
        if (hipGetDevice(&dev) != hipSuccess || hipDeviceGetAttribute(&cus, hipDeviceAttributeMultiprocessorCount, dev) != hipSuccess) { fprintf(stderr, "kernel_launch: device query failed\n"); grid = -1; return; }
        if (hipFuncSetAttribute((const void*)fwd, hipFuncAttributeMaxDynamicSharedMemorySize, LDS_BYTES) != hipSuccess) { fprintf(stderr, "kernel_launch: hipFuncSetAttribute failed\n"); grid = -1; return; }
        if (hipOccupancyMaxActiveBlocksPerMultiprocessor(&per_cu, (const void*)fwd, NWAVES * 64, LDS_BYTES) != hipSuccess || per_cu < 1)
            fprintf(stderr, "kernel_launch: note: occupancy query reports %d workgroups per CU\n", per_cu);
        (void)hipGetLastError();
        grid = cus;
    }
    if (grid < 0) return;
    if (hipMemsetAsync((char*)d_ws + WS_CTL, 0, CTL_ZERO_BYTES, stream) != hipSuccess) { fprintf(stderr, "kernel_launch: memset failed\n"); return; }
    Args a{};
    for (int i = 0; i < 18; ++i) a.in[i] = (const float*)d_in[i];
    a.out = (float*)d_out; a.ws = (unsigned char*)d_ws;
    for (int li = 0; li < MK_N_LAUNCHES; ++li) {
        a.ph_lo = (MK_N_LAUNCHES == 1) ? 0 : li; a.ph_hi = (MK_N_LAUNCHES == 1) ? N_PHASES : li + 1; a.li = li; a.pad = 0;
        hipLaunchKernelGGL(fwd, dim3(grid), dim3(NWAVES * 64), LDS_BYTES, stream, a);
        const hipError_t le = hipPeekAtLastError();
        if (le != hipSuccess) { fprintf(stderr, "kernel_launch: launch %d failed: %s\n", li, hipGetErrorName(le)); break; }
    }
}
```

```cpp
#include <hip/hip_runtime.h>
#include <hip/hip_bf16.h>
#include <cstdio>
#include <cstdint>
#include <cmath>
__constant__ float INVF[32] = {
    1.000000000e+00f, 7.498942018e-01f, 5.623413324e-01f, 4.216965139e-01f, 3.162277639e-01f, 2.371373922e-01f, 1.778279394e-01f, 1.333521456e-01f,
    1.000000015e-01f, 7.498941571e-02f, 5.623412877e-02f, 4.216964915e-02f, 3.162277862e-02f, 2.371373586e-02f, 1.778279431e-02f, 1.333521493e-02f,
    9.999999776e-03f, 7.498942316e-03f, 5.623413250e-03f, 4.216964822e-03f, 3.162277862e-03f, 2.371373819e-03f, 1.778279431e-03f, 1.333521446e-03f,
    1.000000047e-03f, 7.498941850e-04f, 5.623413017e-04f, 4.216965463e-04f, 3.162277862e-04f, 2.371373848e-04f, 1.778279402e-04f, 1.333521504e-04f};

__device__ __forceinline__ void sincos_f(float ang, float& s, float& c) {
    const double rev = (double)ang * 0.15915494309189535; const float fr = (float)(rev - __builtin_rint(rev));
    s = __builtin_amdgcn_sinf(fr); c = __builtin_amdgcn_cosf(fr);
}

namespace pg8 {
#define PG8_LAS __attribute__((address_space(3)))
typedef unsigned short bf16_t;
typedef short bf16x8 __attribute__((ext_vector_type(8)));
typedef float f32x4 __attribute__((ext_vector_type(4)));
typedef unsigned u32x4 __attribute__((ext_vector_type(4)));
constexpr int BM = 256, BK = 64, HALF = 128, HTB = HALF * BK * 2  , STAGE_BYTES = 8 * HTB, NXCD = 8, WGM = 8;

__host__ __device__ __forceinline__ int lds_byte(int r, int c) { const int st = (r >> 4) * 2 + (c >> 5), rr = r & 15, cc = c & 31, ob = rr * 64 + cc * 2; return st * 1024 + (ob ^ (((ob >> 9) & 1) << 5)); }
__host__ __device__ __forceinline__ void stage_rc(int b, int& R, int& C) { const int st = b / 1024, sb = b % 1024, swz = sb ^ (((sb >> 9) & 1) << 5); R = (st >> 1) * 16 + swz / 64; C = (st & 1) * 32 + (swz % 64) / 2; }
__host__ __device__ __forceinline__ unsigned tiled_off(int r, int c, int kc) { return ((unsigned)((r >> 4) * (kc >> 5) + (c >> 5)) << 10) + (unsigned)((r & 15) * 64 + (c & 31) * 2); }
__host__ __device__ __forceinline__ int perm32(int rho) { const int n = rho >> 4, i = rho & 15; return 8 * (i >> 2) + 4 * n + (i & 3); }

struct Unit { int pm, pn; };
struct Gemm { const bf16_t* A; const bf16_t* Bt; int M, N, K; };

struct StaticOrder {
    int nM, nN, nwg, G, c;
    __host__ __device__ void init(int M, int N, int G_, int c_) { nM = M / BM; nN = N / BM; nwg = nM * nN; G = G_; c = c_; }
    __host__ __device__ bool next(int i, Unit& u) const {
        const long L = (long)i * G + c; if (L >= nwg) return false;
        int wgid = (int)L; { const int q = nwg / NXCD, r = nwg % NXCD, xcd = wgid % NXCD, off = wgid / NXCD; wgid = (xcd < r ? xcd * (q + 1) : r * (q + 1) + (xcd - r) * q) + off; }
        const int nig = WGM * nN, gid = wgid / nig, fm = gid * WGM, gsz = (nM - fm) < WGM ? (nM - fm) : WGM;
        u.pm = fm + ((wgid % nig) % gsz); u.pn = (wgid % nig) / gsz; return true;
    }
    __device__ __forceinline__ void a_ready(const Unit&) const {}
    __device__ __forceinline__ void done(const Unit&) const {}
};

__device__ __forceinline__ unsigned cvt_pk_bf16(float lo, float hi) { unsigned r; asm volatile("v_cvt_pk_bf16_f32 %0, %1, %2" : "=v"(r) : "v"(lo), "v"(hi)); return r; }
template <int ACT  , bool RS  , bool OTILED = false  > struct EpiBf16 {
    static constexpr bool PERM = true, AFTER_DRAIN = false; static_assert(ACT == 0 || ACT == 2, "EpiBf16: ACT is 0 (none) or 2 (squared relu)");
    bf16_t* O; int ldc; const float* rscale;
    struct State { float rs[2][4]; };
    __device__ __forceinline__ void load(State& st, const Unit& u, int wr, int fr) const {
        if constexpr (RS) { const int row0 = u.pm * BM + wr * 64 + fr;
#pragma unroll
            for (int ai = 0; ai < 2; ++ai)
#pragma unroll
                for (int m = 0; m < 4; ++m) st.rs[ai][m] = rscale[row0 + ai * HALF + m * 16]; }
    }
    __device__ __forceinline__ void operator()(const f32x4 (&acc)[2][2][4][2], const Unit& u, int wr, int wc, int fr, int fq, const State& st) const {
        const int row0 = u.pm * BM + wr * 64 + fr; const int col0 = u.pn * BM + wc * 32 + 8 * fq;
#pragma unroll
        for (int ai = 0; ai < 2; ++ai)
#pragma unroll
            for (int m = 0; m < 4; ++m) { bf16_t* rowp = OTILED ? (bf16_t*)((char*)O + tiled_off(row0 + ai * HALF + m * 16, col0, ldc)) : O + (size_t)(row0 + ai * HALF + m * 16) * ldc + col0;
#pragma unroll
                for (int bj = 0; bj < 2; ++bj) { f32x4 v0 = acc[ai][bj][m][0], v1 = acc[ai][bj][m][1];
                    if constexpr (RS) { v0 = v0 * st.rs[ai][m]; v1 = v1 * st.rs[ai][m]; }
                    if (ACT == 2) { const f32x4 z4 = (f32x4){0.f, 0.f, 0.f, 0.f}; v0 = __builtin_elementwise_max(v0, z4); v1 = __builtin_elementwise_max(v1, z4); v0 = v0 * v0; v1 = v1 * v1; }
                    u32x4 w; w.x = cvt_pk_bf16(v0[0], v0[1]); w.y = cvt_pk_bf16(v0[2], v0[3]); w.z = cvt_pk_bf16(v1[0], v1[1]); w.w = cvt_pk_bf16(v1[2], v1[3]);
                    *(u32x4*)(rowp + (OTILED ? bj * (HALF / 32) * 512 : bj * HALF)) = w; } }
    }
};

struct EpiIn {
    static constexpr bool PERM = true, AFTER_DRAIN = false;
    bf16_t* O; int ldc; const float* rscale;
    struct State { float rs[2][4]; };
    __device__ __forceinline__ void load(State& st, const Unit& u, int wr, int fr) const {
        const int row0 = u.pm * BM + wr * 64 + fr;
#pragma unroll
        for (int ai = 0; ai < 2; ++ai)
#pragma unroll
            for (int m = 0; m < 4; ++m) st.rs[ai][m] = rscale[row0 + ai * HALF + m * 16];
    }
    __device__ __forceinline__ void operator()(const f32x4 (&acc)[2][2][4][2], const Unit& u, int wr, int wc, int fr, int fq, const State& st) const {
        const int row0 = u.pm * BM + wr * 64 + fr, pn = u.pn;
        const int kind = (pn >= 2 && pn < 6) ? 1 : (pn >= 12 ? 2 : 0);
        const int colb = pn < 2 ? 256 * pn : (pn < 6 ? 512 + 128 * (pn - 2) : (pn < 12 ? 1024 + 256 * (pn - 6) : 2560 + 128 * (pn - 12)));
        const int col0 = colb + wc * 32 + 8 * fq;
        if (kind == 0) {
#pragma unroll
            for (int ai = 0; ai < 2; ++ai)
#pragma unroll
                for (int m = 0; m < 4; ++m) { bf16_t* rowp = O + (size_t)(row0 + ai * HALF + m * 16) * ldc + col0;
#pragma unroll
                    for (int bj = 0; bj < 2; ++bj) { const f32x4 v0 = acc[ai][bj][m][0] * st.rs[ai][m], v1 = acc[ai][bj][m][1] * st.rs[ai][m];
                        u32x4 w; w.x = cvt_pk_bf16(v0[0], v0[1]); w.y = cvt_pk_bf16(v0[2], v0[3]); w.z = cvt_pk_bf16(v1[0], v1[1]); w.w = cvt_pk_bf16(v1[2], v1[3]);
                        *(u32x4*)(rowp + bj * HALF) = w; } }
        } else {
#pragma unroll
            for (int ai = 0; ai < 2; ++ai)
#pragma unroll
                for (int m = 0; m < 4; ++m) { bf16_t* rowp = O + (size_t)(row0 + ai * HALF + m * 16) * ldc + col0; float o[8];
#pragma unroll
                    for (int n = 0; n < 2; ++n)
#pragma unroll
                        for (int e = 0; e < 4; ++e) { const float a = acc[ai][0][m][n][e] * st.rs[ai][m], b = acc[ai][1][m][n][e] * st.rs[ai][m];
                            o[4 * n + e] = kind == 1 ? a * b : a * __builtin_amdgcn_rcpf(1.0f + __expf(-b)); }
                    u32x4 w; w.x = cvt_pk_bf16(o[0], o[1]); w.y = cvt_pk_bf16(o[2], o[3]); w.z = cvt_pk_bf16(o[4], o[5]); w.w = cvt_pk_bf16(o[6], o[7]);
                    *(u32x4*)rowp = w; }
        }
    }
};

template <class Epi, class Sched, bool ALIGN_EPI = false, bool SP2 = false, bool ATILED = false>
__device__ __forceinline__ void gemm_phase(PG8_LAS unsigned char* lds, const Gemm g, const Sched& S, const Epi& E) {
    int tid_ = threadIdx.x; asm volatile("" : "+v"(tid_));
    const int tid = tid_, wid = __builtin_amdgcn_readfirstlane(tid >> 6), lane = tid & 63, wr = wid >> 2, wc = wid & 3, fr = lane & 15, fq = lane >> 4;
    const int K = g.K, nt = K / BK;
    unsigned voffA[2], voffB[2];
#pragma unroll
    for (int i = 0; i < 2; ++i) { int R, C; stage_rc(tid * 16 + i * 8192, R, C); static_assert(Epi::PERM, "the tiled weight copies are stored in PERM row order");
        voffA[i] = ATILED ? tiled_off(R, C, K) : (unsigned)(R * K + C) * 2u; voffB[i] = tiled_off(R, C, K); }
    const size_t kstepA = ATILED ? 2048 : (size_t)(BK * 2), kstepB = 2048;
    const size_t hstep = (size_t)HALF * K * 2;
    const size_t tstep = 2 * hstep;
    const unsigned ldsw = (unsigned)wid * 1024u;
    const int aoff = lds_byte(wr * 64 + fr, fq * 8), boff = lds_byte(wc * 32 + fr, fq * 8);
#define PG8_SA(b, h) (((b) * 2 + (h)) * HTB)
#define PG8_SB(b, h) ((4 + (b) * 2 + (h)) * HTB)
#define PG8_STAGE(bufoff, gbase, voff) do { _Pragma("unroll") for (int _i = 0; _i < 2; ++_i) \
        __builtin_amdgcn_global_load_lds((const unsigned*)((const char*)(gbase) + (voff)[_i]), (PG8_LAS unsigned*)(lds + (bufoff) + ldsw + _i * 8192), 16, 0, 0); } while (0)
#define PG8_LDA(dst, b, h) do { _Pragma("unroll") for (int m = 0; m < 4; ++m) _Pragma("unroll") for (int k = 0; k < 2; ++k) dst[m][k] = *(const PG8_LAS bf16x8*)(lds + PG8_SA(b, h) + aoff + m * 2048 + k * 1024); } while (0)
#define PG8_LDB(dst, b, h) do { _Pragma("unroll") for (int n = 0; n < 2; ++n) _Pragma("unroll") for (int k = 0; k < 2; ++k) dst[n][k] = *(const PG8_LAS bf16x8*)(lds + PG8_SB(b, h) + boff + n * 2048 + k * 1024); } while (0)
#define PG8_MMA(ai, bj, At, Bt) do { __builtin_amdgcn_s_setprio(1); _Pragma("unroll") for (int m = 0; m < 4; ++m) _Pragma("unroll") for (int n = 0; n < 2; ++n) _Pragma("unroll") for (int k = 0; k < 2; ++k) \
        acc[ai][bj][m][n] = __builtin_amdgcn_mfma_f32_16x16x32_bf16(Bt[n][k], At[m][k], acc[ai][bj][m][n], 0, 0, 0); __builtin_amdgcn_s_setprio(0); } while (0)
#define PG8_WAIT_V(n) asm volatile("s_waitcnt vmcnt(" #n ")" ::: "memory")
#define PG8_WAIT_L(n) asm volatile("s_waitcnt lgkmcnt(" #n ")" ::: "memory")
#define PG8_BAR __builtin_amdgcn_s_barrier()
#define PG8_SCHED __builtin_amdgcn_sched_barrier(0)
    Unit cur, nxt; int ui = 0;
    if (!S.next(0, cur)) return;
    typename Epi::State est; E.load(est, cur, wr, fr);
    f32x4 acc[2][2][4][2];
#pragma unroll
    for (int a = 0; a < 2; ++a)
#pragma unroll
        for (int b = 0; b < 2; ++b)
#pragma unroll
            for (int m = 0; m < 4; ++m)
#pragma unroll
                for (int n = 0; n < 2; ++n) acc[a][b][m][n] = (f32x4){0.f, 0.f, 0.f, 0.f};
    bf16x8 At[4][2], B0[2][2], B1[2][2];
    const char* cA = (const char*)g.A + (size_t)cur.pm * tstep; const char* cB = (const char*)g.Bt + (size_t)cur.pn * tstep;
    S.a_ready(cur);
    if constexpr (SP2) {
        PG8_STAGE(PG8_SB(0, 0), cB, voffB); PG8_STAGE(PG8_SB(0, 1), cB + hstep, voffB); PG8_STAGE(PG8_SA(0, 0), cA, voffA); PG8_STAGE(PG8_SA(0, 1), cA + hstep, voffA);
        if (wr == 1) PG8_BAR;
        PG8_WAIT_V(2); PG8_BAR;
        PG8_STAGE(PG8_SB(1, 0), cB + kstepB, voffB); PG8_STAGE(PG8_SB(1, 1), cB + hstep + kstepB, voffB);
        PG8_WAIT_V(4); PG8_BAR;
    } else {
        PG8_STAGE(PG8_SB(0, 0), cB, voffB); PG8_STAGE(PG8_SA(0, 0), cA, voffA); PG8_STAGE(PG8_SB(0, 1), cB + hstep, voffB); PG8_STAGE(PG8_SA(0, 1), cA + hstep, voffA);
        if (wr == 1) PG8_BAR;
        PG8_WAIT_V(4); PG8_BAR;
        PG8_STAGE(PG8_SB(1, 0), cB + kstepB, voffB); PG8_STAGE(PG8_SA(1, 0), cA + kstepA, voffA); PG8_STAGE(PG8_SB(1, 1), cB + hstep + kstepB, voffB);
        PG8_WAIT_V(6); PG8_BAR;
    }
    for (;;) {
        const bool has_next = S.next(ui + 1, nxt);
        const char* nA = has_next ? (const char*)g.A + (size_t)nxt.pm * tstep : cA; const char* nB = has_next ? (const char*)g.Bt + (size_t)nxt.pn * tstep : cB;
        for (int t = 0; t < nt; t += 2) {
            const bool last = (t == nt - 2);
            const char* a1 = cA + (size_t)(t + 1) * kstepA;
            const char* a2 = last ? nA : cA + (size_t)(t + 2) * kstepA; const char* b2 = last ? nB : cB + (size_t)(t + 2) * kstepB;
            const char* a3 = a2 + kstepA; const char* b3 = b2 + kstepB;
            if (last && has_next) S.a_ready(nxt);
            if constexpr (SP2) {
            PG8_LDB(B0, 0, 0); PG8_LDB(B1, 0, 1); PG8_SCHED; PG8_LDA(At, 0, 0); PG8_STAGE(PG8_SA(1, 0), a1, voffA); PG8_STAGE(PG8_SA(1, 1), a1 + hstep, voffA);
            PG8_WAIT_V(8); PG8_WAIT_L(0); PG8_BAR; PG8_MMA(0, 0, At, B0); PG8_MMA(0, 1, At, B1); PG8_BAR; PG8_SCHED;
            PG8_LDA(At, 0, 1); PG8_STAGE(PG8_SB(0, 0), b2, voffB); PG8_STAGE(PG8_SB(0, 1), b2 + hstep, voffB);
            PG8_WAIT_V(6); PG8_WAIT_L(0); PG8_BAR; PG8_MMA(1, 0, At, B0); PG8_MMA(1, 1, At, B1); PG8_BAR; PG8_SCHED;
            PG8_LDB(B0, 1, 0); PG8_LDB(B1, 1, 1); PG8_SCHED; PG8_LDA(At, 1, 0); PG8_STAGE(PG8_SA(0, 0), a2, voffA); PG8_STAGE(PG8_SA(0, 1), a2 + hstep, voffA);
            PG8_WAIT_V(8); PG8_WAIT_L(0); PG8_BAR; PG8_MMA(0, 0, At, B0); PG8_MMA(0, 1, At, B1); PG8_BAR; PG8_SCHED;
            PG8_LDA(At, 1, 1); PG8_STAGE(PG8_SB(1, 0), b3, voffB); PG8_STAGE(PG8_SB(1, 1), b3 + hstep, voffB);
            PG8_WAIT_V(6); PG8_WAIT_L(0); PG8_BAR; PG8_MMA(1, 0, At, B0); PG8_MMA(1, 1, At, B1); PG8_BAR; PG8_SCHED;
            } else {
            PG8_LDB(B0, 0, 0); PG8_SCHED; PG8_LDA(At, 0, 0); PG8_STAGE(PG8_SA(1, 1), a1 + hstep, voffA);
            PG8_WAIT_L(8); PG8_BAR; PG8_WAIT_L(0); PG8_MMA(0, 0, At, B0); PG8_BAR; PG8_SCHED;
            PG8_LDB(B1, 0, 1); PG8_STAGE(PG8_SB(0, 0), b2, voffB);
            PG8_BAR; PG8_WAIT_L(0); PG8_MMA(0, 1, At, B1); PG8_BAR;
            PG8_LDA(At, 0, 1); PG8_STAGE(PG8_SA(0, 0), a2, voffA);
            PG8_BAR; PG8_WAIT_L(0); PG8_MMA(1, 0, At, B0); PG8_BAR; PG8_SCHED;
            PG8_STAGE(PG8_SB(0, 1), b2 + hstep, voffB);
            PG8_WAIT_V(6); PG8_BAR; PG8_MMA(1, 1, At, B1); PG8_BAR;
            PG8_LDB(B0, 1, 0); PG8_SCHED; PG8_LDA(At, 1, 0); PG8_STAGE(PG8_SA(0, 1), a2 + hstep, voffA);
            PG8_WAIT_L(8); PG8_BAR; PG8_WAIT_L(0); PG8_MMA(0, 0, At, B0); PG8_BAR; PG8_SCHED;
            PG8_LDB(B1, 1, 1); PG8_STAGE(PG8_SB(1, 0), b3, voffB);
            PG8_BAR; PG8_WAIT_L(0); PG8_MMA(0, 1, At, B1); PG8_BAR;
            PG8_LDA(At, 1, 1); PG8_STAGE(PG8_SA(1, 0), a3, voffA);
            PG8_BAR; PG8_WAIT_L(0); PG8_MMA(1, 0, At, B0); PG8_BAR; PG8_SCHED;
            PG8_STAGE(PG8_SB(1, 1), b3 + hstep, voffB);
            PG8_WAIT_V(6); PG8_BAR; PG8_MMA(1, 1, At, B1); PG8_BAR;
            }
        }
        if constexpr (ALIGN_EPI) { if (wr == 0) PG8_BAR; }
        if constexpr (!Epi::AFTER_DRAIN) { E(acc, cur, wr, wc, fr, fq, est); S.done(cur); }
        if (!has_next) break;
        E.load(est, nxt, wr, fr);
#pragma unroll
        for (int a = 0; a < 2; ++a)
#pragma unroll
            for (int b = 0; b < 2; ++b)
#pragma unroll
                for (int m = 0; m < 4; ++m)
#pragma unroll
                    for (int n = 0; n < 2; ++n) acc[a][b][m][n] = (f32x4){0.f, 0.f, 0.f, 0.f};
        cur = nxt; cA = nA; cB = nB; ++ui;
        if constexpr (ALIGN_EPI) { if (wr == 1) PG8_BAR; }
    }
    PG8_WAIT_V(0);
    if constexpr (!ALIGN_EPI) { if (wr == 0) PG8_BAR; }
    PG8_BAR;
    if constexpr (Epi::AFTER_DRAIN) { E.fused(acc, cur, wr, wc, fr, fq, lds, wid, lane); S.done(cur); }
#undef PG8_SA
#undef PG8_SB
#undef PG8_STAGE
#undef PG8_LDA
#undef PG8_LDB
#undef PG8_MMA
#undef PG8_WAIT_V
#undef PG8_WAIT_L
#undef PG8_BAR
#undef PG8_SCHED
}
}

namespace attn_body {
using bf16=__hip_bfloat16;
using bf16x8=__attribute__((ext_vector_type(8)))short;
using s16x4=__attribute__((ext_vector_type(4)))short;
using f32x16=__attribute__((ext_vector_type(16)))float;
using u32x4=__attribute__((ext_vector_type(4)))unsigned;
constexpr int D=64,ZP=3072,OP=2048;
constexpr int NW=8,QBLK=32,QB=QBLK*NW,KVBLK=64;
constexpr int ATTN_UNIT_ROWS=QB;
__device__ __forceinline__ int crow(int r,int hi){return (r&3)+8*(r>>2)+4*hi;}
#define SBAR() __builtin_amdgcn_sched_barrier(0)
template<int MODE> __device__ __forceinline__ int trow(int t,int q0,int S){
  if constexpr(MODE!=1){ return 64*t; }
  else { const int j=(t+3)&7; const int kpos=q0-128+64*j; return (kpos>=0&&kpos<S)?kpos:(q0+64); }
}
template<int MODE> __device__ __forceinline__ void tmask(f32x16&p0,f32x16&p1,int t,int qrel,int hi,int q0,int S){
  if constexpr(MODE==1){
    const float NEG=-INFINITY; const int j=(t+3)&7; const int krel0=-128+64*j; const int kpos=q0+krel0;
    const int base=(kpos>=0&&kpos<S)?(krel0+4*hi-qrel+128):100000;
    #pragma unroll
    for(int r=0;r<16;++r){const int kv=base+(r&3)+8*(r>>2); if((unsigned)kv>256u)p0[r]=NEG; if((unsigned)(kv+32)>256u)p1[r]=NEG;}
  }
}

constexpr int NSLOT=6, SLOTB=4096;
constexpr int LDS_K=0, LDS_V=NSLOT*SLOTB, LDS_WS=2*NSLOT*SLOTB, LDS_OST=LDS_WS+NW*64*4, LDS_BYTES=LDS_OST+NW*4096;
constexpr float C2=0.125f*1.4426950408889634f;
__device__ __forceinline__ void glds16(const void*gsrc,unsigned lds_dst){unsigned keep;
  asm volatile("s_mov_b32 %0, m0\n\ts_mov_b32 m0, %2\n\ts_nop 0\n\tglobal_load_lds_dwordx4 %1, off\n\ts_mov_b32 m0, %0":"=&s"(keep):"v"(gsrc),"s"(lds_dst):"memory");}
__device__ __forceinline__ float max3f(float a,float b,float c){float r;asm("v_max3_f32 %0, %1, %2, %3":"=v"(r):"v"(a),"v"(b),"v"(c));return r;}
__device__ __forceinline__ float max2f(float a,float b){float r;asm("v_max_f32_e32 %0, %1, %2":"=v"(r):"v"(a),"v"(b));return r;}
__device__ __forceinline__ float fadd_s(float a,float b){float r;asm("v_add_f32_e32 %0, %1, %2":"=v"(r):"v"(a),"v"(b));return r;}
__device__ __forceinline__ float fsub_s(float a,float b){float r;asm("v_sub_f32_e32 %0, %1, %2":"=v"(r):"v"(a),"v"(b));return r;}
typedef float f32x2_t __attribute__((ext_vector_type(2))); typedef __bf16 bf16x2_t __attribute__((ext_vector_type(2)));
__device__ __forceinline__ unsigned cvtpk_s(float lo,float hi){f32x2_t v={lo,hi};bf16x2_t b=__builtin_convertvector(v,bf16x2_t);return __builtin_bit_cast(unsigned,b);}
#define WAIT_BAR(N) asm volatile("s_waitcnt vmcnt(" #N ") lgkmcnt(0)\n\ts_barrier":::"memory")
#define WAIT_BAR2W() WAIT_BAR(2)
static_assert(NSLOT==6,"ring protocol literals");

typedef int v8i_t __attribute__((ext_vector_type(8))); typedef int v4i_t __attribute__((ext_vector_type(4)));
typedef __attribute__((address_space(3))) const char* lds_cptr;
typedef short v4i16_t __attribute__((ext_vector_type(4))); typedef float f32x4d_t __attribute__((ext_vector_type(4))); typedef short v2s16_t __attribute__((ext_vector_type(2)));
#define FP8_SC 0
__device__ __forceinline__ v8i_t kfrag(lds_cptr kp){ const v4i_t lo=*(const __attribute__((address_space(3))) v4i_t*)(kp), hi=*(const __attribute__((address_space(3))) v4i_t*)(kp+1024); return __builtin_shufflevector(lo,hi,0,1,2,3,4,5,6,7); }
#define QK8(KF,QF,C) __builtin_amdgcn_mfma_scale_f32_32x32x64_f8f6f4((KF),(QF),(C),0,0,0,FP8_SC,0,FP8_SC)
__device__ __forceinline__ void qkt(f32x16&p0,f32x16&p1,lds_cptr Kslot,const v8i_t qf,const f32x16&negm,int r32,int hi){
  const lds_cptr kb=Kslot+hi*2048+r32*16;
  p0=QK8(kfrag(kb),qf,negm); p1=QK8(kfrag(kb+512),qf,negm);
}
__device__ __forceinline__ s16x4 vtr(lds_cptr p){ return __builtin_bit_cast(s16x4,__builtin_amdgcn_ds_read_tr16_b64_v4i16((__attribute__((address_space(3))) v4i16_t*)p)); }
__device__ __forceinline__ float rowmax(const f32x16&p0,const f32x16&p1){
  float a=max3f(p0[0],p0[1],p1[0]),b=max3f(p0[2],p0[3],p1[1]);a=max3f(a,p1[2],p1[3]);
  #pragma unroll
  for(int r=4;r<16;r+=4){a=max3f(a,p0[r],p0[r+1]);b=max3f(b,p0[r+2],p0[r+3]);a=max3f(a,p1[r],p1[r+1]);b=max3f(b,p1[r+2],p1[r+3]);}
  const float m=max2f(a,b);
  auto rr=__builtin_amdgcn_permlane32_swap(__float_as_uint(m),__float_as_uint(m),false,false);
  return max2f(__uint_as_float(rr[0]),__uint_as_float(rr[1]));
}
__device__ __forceinline__ void pv(f32x16*o,int vb,bf16x8 pa0,bf16x8 pa1,bf16x8 pa2,bf16x8 pa3){
  #pragma unroll
  for(int d0=0;d0<2;++d0){s16x4 lo[4],hi[4];
    #pragma unroll
    for(int ks=0;ks<4;++ks){
      asm volatile("ds_read_b64_tr_b16 %0,%1 offset:%c2":"=&v"(lo[ks]):"v"(vb),"i"(d0*4096+ks*1024):"memory");
      asm volatile("ds_read_b64_tr_b16 %0,%1 offset:%c2":"=&v"(hi[ks]):"v"(vb),"i"(d0*4096+ks*1024+512):"memory");}
    asm volatile("s_waitcnt lgkmcnt(0)":::"memory");SBAR();
    #define PK(k) (bf16x8){lo[k][0],lo[k][1],lo[k][2],lo[k][3],hi[k][0],hi[k][1],hi[k][2],hi[k][3]}
    o[d0]=__builtin_amdgcn_mfma_f32_32x32x16_bf16(pa0,PK(0),o[d0],0,0,0);
    o[d0]=__builtin_amdgcn_mfma_f32_32x32x16_bf16(pa1,PK(1),o[d0],0,0,0);
    o[d0]=__builtin_amdgcn_mfma_f32_32x32x16_bf16(pa2,PK(2),o[d0],0,0,0);
    o[d0]=__builtin_amdgcn_mfma_f32_32x32x16_bf16(pa3,PK(3),o[d0],0,0,0);
    #undef PK
  }
}

template<int QT> __device__ __forceinline__ v8i_t q_transform(const bf16x8 (&qr)[4],const int t,const int hi,const float*gq){
  float x[4][8];
  #pragma unroll
  for(int d0=0;d0<4;++d0)
    #pragma unroll
    for(int e=0;e<8;++e)x[d0][e]=__uint_as_float(((unsigned)(unsigned short)qr[d0][e])<<16);
  if constexpr(QT==1){
    float ss=0.f;
    #pragma unroll
    for(int d0=0;d0<4;++d0)
      #pragma unroll
      for(int e=0;e<8;++e)ss+=x[d0][e]*x[d0][e];
    {auto rr=__builtin_amdgcn_permlane32_swap(__float_as_uint(ss),__float_as_uint(ss),false,false);ss=__uint_as_float(rr[0])+__uint_as_float(rr[1]);}
    const float r=rsqrtf(ss*(1.0f/64.0f)+1e-6f);
    #pragma unroll
    for(int d0=0;d0<4;++d0)
      #pragma unroll
      for(int e=0;e<8;++e)x[d0][e]=x[d0][e]*r*gq[16*d0+8*hi+e];
    const int pr=t>>6,pc=t&63;
    #pragma unroll
    for(int e=0;e<8;++e){ const float f=INVF[2*(8*hi+e)]; float sn,cs;
      sincos_f((float)pr*f,sn,cs); { const float a=x[0][e],b=x[1][e]; x[0][e]=a*cs-b*sn; x[1][e]=b*cs+a*sn; }
      sincos_f((float)pc*f,sn,cs); { const float a=x[2][e],b=x[3][e]; x[2][e]=a*cs-b*sn; x[3][e]=b*cs+a*sn; } }
  } else {
    #pragma unroll
    for(int e=0;e<8;++e){ float sn,cs;
      sincos_f((float)t*INVF[8*hi+e],sn,cs);    { const float a=x[0][e],b=x[2][e]; x[0][e]=a*cs-b*sn; x[2][e]=b*cs+a*sn; }
      sincos_f((float)t*INVF[16+8*hi+e],sn,cs); { const float a=x[1][e],b=x[3][e]; x[1][e]=a*cs-b*sn; x[3][e]=b*cs+a*sn; } }
  }
  v8i_t qf;
  #pragma unroll
  for(int d0=0;d0<4;++d0){ int w0=0,w1=0;
    w0=__builtin_amdgcn_cvt_pk_fp8_f32(x[d0][0]*C2,x[d0][1]*C2,w0,false); w0=__builtin_amdgcn_cvt_pk_fp8_f32(x[d0][2]*C2,x[d0][3]*C2,w0,true);
    w1=__builtin_amdgcn_cvt_pk_fp8_f32(x[d0][4]*C2,x[d0][5]*C2,w1,false); w1=__builtin_amdgcn_cvt_pk_fp8_f32(x[d0][6]*C2,x[d0][7]*C2,w1,true);
    qf[2*d0]=w0; qf[2*d0+1]=w1; }
  return qf;
}
#ifndef ATTN_STORE16
#define ATTN_STORE16(p,v) (*(u32x4*)(p)=(v))
#endif
template<int MODE,int THRL,int QT> __device__ __forceinline__ void attn_unit(const bf16*Qu,const char*__restrict__ Kt,const char*__restrict__ Vt,bf16*Ou,const int NT,const int q0,const int S,const float sink2,const int tq0,const float*gq,char*shm){
  int tid_=threadIdx.x; asm volatile("":"+v"(tid_)); const int tid=tid_,lane=tid&63,r32=lane&31,hi=lane>>5; const int wid=__builtin_amdgcn_readfirstlane(tid>>6);
  const bf16*Qw=Qu+(long)(wid*QBLK)*ZP;
  const unsigned lds0=(unsigned)(uintptr_t)shm;
  float*wsf=(float*)(shm+LDS_WS)+wid*64;
  const bool kw=wid<4; const char*psrc=(kw?Kt+wid*1024:Vt+(wid&3)*1024)+lane*16; const unsigned pdst=lds0+(kw?LDS_K+wid*1024:LDS_V+(wid&3)*1024);
  #define DMA_P(t,slot) glds16(psrc+((long)(trow<MODE>((t),q0,S)>>6)<<12),(unsigned)__builtin_amdgcn_readfirstlane(pdst+(slot)))
  #define DMA_K(t,slot) if(kw) DMA_P(t,slot)
  #define DMA_V(t,slot) if(!kw) DMA_P(t,slot)
  #define DMA_STEP(t,GK,GV) do{ if(kw?(GK):(GV)){ const int tt_=(t)+(kw?5:3); const int sl_=kw?sl_prev:sl_v; DMA_P(tt_,sl_); } }while(0)
  v8i_t kf[2];
  const lds_cptr shm3=(lds_cptr)shm; const lds_cptr kp0=shm3+LDS_K+hi*2048+r32*16; const lds_cptr vp0=shm3+LDS_V+hi*2048+r32*16;
  bf16x8 qr[4];
  #pragma unroll
  for(int d0=0;d0<4;++d0)qr[d0]=*reinterpret_cast<const bf16x8*>(&Qw[(long)r32*ZP+d0*16+hi*8]);
  #pragma unroll
  for(int i=0;i<5;++i){ DMA_K(i,i*SLOTB); if(i<3){ DMA_V(i,i*SLOTB); } }
  const v8i_t qf=q_transform<QT>(qr,tq0+wid*QBLK+r32,hi,gq);
  float mhat=0.f;f32x16 o[2];o[0]=f32x16{};o[1]=f32x16{};f32x4d_t o2={0.f,0.f,0.f,0.f};
  v8i_t ones; { const int sel_=((((lane>>4)&1)==0)==((lane&15)<8))?0x38383838:0; _Pragma("unroll") for(int i=0;i<8;++i)ones[i]=sel_; } asm volatile("":"+v"(ones));
  const int l2row=4*(lane>>4)+(((lane&15)>=8)?16:0);
  #define SUM8(A,C) __builtin_amdgcn_mfma_scale_f32_16x16x128_f8f6f4((A),ones,(C),1,0,0,FP8_SC,0,FP8_SC)
  f32x16 negm=f32x16{};if constexpr(MODE!=2){asm volatile("":"+v"(negm));}
  const float pscl=(MODE==2)?sink2:1.0f;
  const int qrel=wid*QBLK+r32;
  #define CMASK(P0,P1,t) tmask<MODE>(P0,P1,(t),qrel,hi,q0,S)
  bool resc=false;
  #define START(P0,P1) do{ resc=false; if constexpr(MODE!=2) \
    { const float rm=rowmax(P0,P1); const float dl=rm; mhat=fadd_s(mhat,dl); \
      _Pragma("unroll") for(int r=0;r<16;++r){P0[r]=fsub_s(P0[r],dl);P1[r]=fsub_s(P1[r],dl);} \
      _Pragma("unroll") for(int r=0;r<16;++r)negm[r]=-mhat; asm volatile("":"+v"(negm)); } \
    _Pragma("unroll") for(int r=0;r<16;++r)P0[r]=__builtin_amdgcn_exp2f(P0[r]); }while(0)
  #define RESC() do{ if constexpr(MODE!=2) if(resc){ asm volatile("s_waitcnt lgkmcnt(0)":::"memory"); \
      _Pragma("unroll") for(int r=0;r<16;++r){ const float f_=wsf[crow(r,hi)]; o[0][r]*=f_; o[1][r]*=f_; } _Pragma("unroll") for(int e=0;e<4;++e)o2[e]*=wsf[l2row+e]; } }while(0)
  f32x16 pA0,pA1,pB0,pB1;
  int sl_prev=(NSLOT-1)*SLOTB,sl_cur=0,sl_next=SLOTB,sl_v=3*SLOTB;
  #define NXT(x) (((x)==(NSLOT-1)*SLOTB)?0:(x)+SLOTB)
  #define ROT() do{sl_prev=sl_cur;sl_cur=sl_next;sl_next=NXT(sl_next);sl_v=NXT(sl_v);}while(0)
  WAIT_BAR(4);
  qkt(pA0,pA1,shm3+LDS_K,qf,negm,r32,hi);asm volatile("s_nop 15\n\ts_nop 7":"+v"(pA0),"+v"(pA1));CMASK(pA0,pA1,0);
  START(pA0,pA1);
  _Pragma("unroll") for(int r=0;r<16;++r)pA1[r]=__builtin_amdgcn_exp2f(pA1[r]);
  DMA_P(kw?5:3,kw?5*SLOTB:3*SLOTB);
  WAIT_BAR(2);
  ROT();
  kf[0]=kfrag(kp0+sl_cur); kf[1]=kfrag(kp0+sl_cur+512);
  v8i_t vf[2], pa;
  #define PK8(P,B,W) do{ v2s16_t w2_=__builtin_bit_cast(v2s16_t,W); w2_=__builtin_amdgcn_cvt_scalef32_pk_bf8_f32(w2_,P[B],P[(B)+1],pscl,false); w2_=__builtin_amdgcn_cvt_scalef32_pk_bf8_f32(w2_,P[(B)+2],P[(B)+3],pscl,true); W=__builtin_bit_cast(int,w2_); }while(0)
  #define PV8(A,B,C) __builtin_amdgcn_mfma_scale_f32_32x32x64_f8f6f4((A),(B),(C),1,0,0,FP8_SC,0,FP8_SC)
  #define PIN(x) asm volatile("":"+v"(x))
  #define MX3(a,b,c) __builtin_fmaxf(__builtin_fmaxf((a),(b)),(c))
  #define EX(v) __builtin_amdgcn_exp2f(v)
  #define KRD(G,j) do{ if(G){ kf[(j)]=kfrag(kp0+sl_next+(j)*512); } }while(0)
  #define HALFA(P,J0) do{ _Pragma("unroll") for(int j_=0;j_<4;++j_){ int w_; asm volatile("":"=v"(w_)); PK8(P,4*j_,w_); pa[(J0)+j_]=w_; } }while(0)
  #define STEP(C0,C1,P0,P1,t,GK,GV,GL) do{ SBAR(); \
    { const lds_cptr vp_=vp0+sl_prev; vf[0]=kfrag(vp_); vf[1]=kfrag(vp_+512); } \
    PIN(kf[0]); C0=QK8(kf[0],qf,negm); PIN(C0); \
    PIN(P0); PIN(P1); HALFA(P0,0); HALFA(P1,4); PIN(pa); \
    PIN(kf[1]); C1=QK8(kf[1],qf,negm); PIN(C1); KRD(GL,0); KRD(GL,1);     \
    DMA_STEP(t,GK,GV); \
    CMASK(C0,C1,t); \
    if constexpr(MODE!=2){ float a=MX3(C0[0],C0[1],C1[0]),b=MX3(C0[2],C0[3],C1[1]); a=MX3(a,C1[2],C1[3]); \
      _Pragma("unroll") for(int r=4;r<16;r+=4){a=MX3(a,C0[r],C0[r+1]);b=MX3(b,C0[r+2],C0[r+3]);a=MX3(a,C1[r],C1[r+1]);b=MX3(b,C1[r+2],C1[r+3]);} \
      float rm=__builtin_fmaxf(a,b); { auto rr=__builtin_amdgcn_permlane32_swap(__float_as_uint(rm),__float_as_uint(rm),false,false); rm=__builtin_fmaxf(__uint_as_float(rr[0]),__uint_as_float(rr[1])); } \
      resc=false; \
      if(__builtin_expect(__any(rm>(float)THRL),0)){ const float dl=__builtin_fmaxf(rm,0.f); mhat+=dl; \
        _Pragma("unroll") for(int r=0;r<16;++r){C0[r]-=dl;C1[r]-=dl;} \
        _Pragma("unroll") for(int r=0;r<16;++r)negm[r]=-mhat; asm volatile("":"+v"(negm)); \
        const float f=__builtin_amdgcn_exp2f(-dl); if(hi==0)wsf[r32]=f; resc=true; } } \
    PIN(pa); o[0]=PV8(pa,vf[0],o[0]); PIN(o[0]); \
    PIN(C0); _Pragma("unroll") for(int r=0;r<11;++r)C0[r]=EX(C0[r]); PIN(C0); \
    PIN(pa); o[1]=PV8(pa,vf[1],o[1]); PIN(o[1]); \
    PIN(C0); PIN(C1); _Pragma("unroll") for(int r=11;r<16;++r)C0[r]=EX(C0[r]); _Pragma("unroll") for(int r=0;r<6;++r)C1[r]=EX(C1[r]); PIN(C0); PIN(C1); \
    PIN(pa); o2=SUM8(pa,o2); PIN(o2); \
    PIN(C1); _Pragma("unroll") for(int r=6;r<16;++r)C1[r]=EX(C1[r]); PIN(C1); \
    SBAR(); \
    }while(0)
  int t=1;
  for(;t+6<NT;t+=2){
    STEP(pB0,pB1,pA0,pA1,t,true,true,true);     RESC(); ROT();
    STEP(pA0,pA1,pB0,pB1,t+1,true,true,true);   WAIT_BAR2W(); RESC(); ROT();
  }
  #define ENDW(tt) do{ int n_=kw?(NT-4-(tt)):(NT-2-(tt)); n_=n_<0?0:(n_>2?2:n_); if(n_==0){WAIT_BAR(0);} else if(n_==1){WAIT_BAR(1);} else {WAIT_BAR(2);} }while(0)
  for(;t+1<NT;t+=2){
    STEP(pB0,pB1,pA0,pA1,t,(t+5<NT),(t+3<NT),(t+1<NT));       RESC(); ROT();
    STEP(pA0,pA1,pB0,pB1,t+1,(t+6<NT),(t+4<NT),(t+2<NT));     ENDW(t+1); RESC(); ROT();
  }
  STEP(pB0,pB1,pA0,pA1,NT-1,false,false,false); RESC();
  { HALFA(pB0,0); HALFA(pB1,4);
    { const lds_cptr vp_=vp0+sl_cur; vf[0]=kfrag(vp_); vf[1]=kfrag(vp_+512); }
    o[0]=PV8(pa,vf[0],o[0]); o[1]=PV8(pa,vf[1],o[1]); o2=SUM8(pa,o2); }
  #undef PK8
  #undef SUM8
  #undef PV8
  #undef HALFA
  #undef PIN
  #undef MX3
  #undef EX
  #undef KRD
  #undef DMA_STEP
  #undef STEP
  #undef ENDW
  asm volatile("s_nop 15\n\ts_nop 7":"+v"(o2));
  if((lane&7)==0){ _Pragma("unroll") for(int e=0;e<4;++e)wsf[32+l2row+e]=o2[e]; }
  asm volatile("s_waitcnt lgkmcnt(0)":::"memory");
  if constexpr(MODE==1){ if(hi==0)wsf[32+r32]+=__builtin_amdgcn_exp2f(sink2-mhat); asm volatile("s_waitcnt lgkmcnt(0)":::"memory"); }
  float rli[16];
  #pragma unroll
  for(int r=0;r<16;++r)rli[r]=__builtin_amdgcn_rcpf(wsf[32+crow(r,hi)]);
  bf16*Ow=Ou+(long)(wid*QBLK)*OP;
  { bf16*stg=(bf16*)(shm+LDS_OST)+wid*2048;
    #pragma unroll
    for(int r=0;r<16;++r){const int orow=crow(r,hi);
      #pragma unroll
      for(int d0=0;d0<2;++d0)stg[orow*64+d0*32+r32]=__float2bfloat16(o[d0][r]*rli[r]);}
    asm volatile("s_waitcnt lgkmcnt(0)":::"memory");
    #pragma unroll
    for(int i=0;i<4;++i){const int row=i*8+(lane>>3),ch=lane&7; const u32x4 v=*(const u32x4*)(stg+row*64+ch*8); ATTN_STORE16(Ow+(long)row*OP+ch*8,v);} }
  asm volatile("s_waitcnt lgkmcnt(0)\n\ts_barrier":::"memory");
  #undef DMA_K
  #undef DMA_V
  #undef DMA_P
  #undef CMASK
  #undef START
  #undef RESC
  #undef ROT
}
constexpr int ATTN_LDS_BYTES=LDS_BYTES;
#undef SBAR
#undef WAIT_BAR
#undef WAIT_BAR2W
#undef QK8
}
#define GAS __attribute__((address_space(1)))
#define LAS __attribute__((address_space(3)))
typedef unsigned short bf16;
typedef unsigned v4u __attribute__((ext_vector_type(4)));
typedef float f32x4 __attribute__((ext_vector_type(4)));
typedef short bf16x8 __attribute__((ext_vector_type(8)));
typedef GAS unsigned gu32;
typedef GAS unsigned long long gu64;
#define RLX_AGENT __ATOMIC_RELAXED, __HIP_MEMORY_SCOPE_AGENT
#define LDS_WAIT() asm volatile("s_waitcnt lgkmcnt(0)" ::: "memory")
#define VM_WAIT() asm volatile("s_waitcnt vmcnt(0)" ::: "memory")
__device__ __forceinline__ unsigned long long rt() { return __builtin_amdgcn_s_memrealtime(); }
__device__ __forceinline__ unsigned f2bf(float f) { unsigned u = __builtin_bit_cast(unsigned, f); return (u + 0x7fffu + ((u >> 16) & 1u)) >> 16; }
__device__ __forceinline__ unsigned pk2(float lo, float hi) { return f2bf(lo) | (f2bf(hi) << 16); }

#define XB_TMO      128
#define XB_XCNT(j)  (256  + 64 * (j))
#define XB_XSUB(j)  (1280 + 64 * (j))
#define XB_XGEN(j)  (2304 + 64 * (j))
#define XB_TOP      3328
#define XB_TOPGEN   3392
#define XCD_BAR_WORDS 3456
#define XB_SPIN_CAP (1u << 18)

__device__ __forceinline__ unsigned xb_ld(unsigned* p)              { return __hip_atomic_load(p, __ATOMIC_RELAXED, __HIP_MEMORY_SCOPE_AGENT); }
__device__ __forceinline__ unsigned xb_add(unsigned* p, unsigned v) { return __hip_atomic_fetch_add(p, v, __ATOMIC_RELAXED, __HIP_MEMORY_SCOPE_AGENT); }
__device__ __forceinline__ unsigned xb_xcc_id() { return (unsigned)__builtin_amdgcn_s_getreg((3 << 11) | 20) & 0xFu; }
#define XB_SPIN(cond, bar) do { unsigned _sp = 0; while (cond) { __builtin_amdgcn_s_sleep(1); \
    if ((++_sp & 255u) == 0u) { if (xb_ld(&(bar)[XB_TMO])) break; if (_sp > XB_SPIN_CAP) { atomicAdd(&(bar)[XB_TMO], 1u); break; } } } } while (0)

struct XcdBarrier {
    unsigned* bar; unsigned x;
    volatile LAS unsigned* st;
};

__device__ __forceinline__ XcdBarrier xcd_barrier_post(unsigned* bar, volatile LAS unsigned* st) {
    XcdBarrier b; b.bar = bar; b.x = xb_xcc_id(); b.st = st;
    if (threadIdx.x == 0) (void)xb_add(&bar[XB_XCNT(b.x)], 1u);
    return b;
}
__device__ __forceinline__ void xcd_barrier_complete(unsigned* bar, unsigned x, unsigned& nloc, unsigned& nx) {
    const unsigned G = gridDim.x * gridDim.y * gridDim.z;
    unsigned sum, cnt, mine, sp = 0u;
    for (;;) {
        sum = 0u; cnt = 0u; mine = 0u;
#pragma unroll
        for (unsigned j = 0; j < 16; ++j) { const unsigned c = xb_ld(&bar[XB_XCNT(j)]); sum += c; cnt += (c > 0u) ? 1u : 0u; mine = (j == x) ? c : mine; }
        if (sum == G) break;
        __builtin_amdgcn_s_sleep(1);
        if ((++sp & 255u) == 0u) { if (xb_ld(&bar[XB_TMO])) break; if (sp > XB_SPIN_CAP) { atomicAdd(&bar[XB_TMO], 1u); break; } }
    }
    nloc = mine > 0u ? mine : 1u; nx = cnt > 0u ? cnt : 1u;
}

__device__ __forceinline__ void xcd_barrier(const XcdBarrier& b) {
    asm volatile("s_waitcnt vmcnt(0)" ::: "memory");
    __syncthreads();
    if (threadIdx.x == 0) {
        unsigned* bar = b.bar;
        __builtin_amdgcn_s_waitcnt(0);
        unsigned nloc = b.st[0], nx = b.st[1];
        if (nloc == 0u) { xcd_barrier_complete(bar, b.x, nloc, nx); b.st[0] = nloc; b.st[1] = nx; }
        const unsigned old = xb_add(&bar[XB_XSUB(b.x)], 1u);
        const unsigned gen = old / nloc;
        if (old + 1u == (gen + 1u) * nloc) {
            __builtin_amdgcn_fence(__ATOMIC_RELEASE, "agent");
            asm volatile("s_waitcnt vmcnt(0)" ::: "memory");
            const unsigned og = xb_add(&bar[XB_TOP], 1u);
            const unsigned tg = og / nx;
            if (og + 1u == (tg + 1u) * nx) xb_add(&bar[XB_TOPGEN], 1u);
            else XB_SPIN(xb_ld(&bar[XB_TOPGEN]) == tg, bar);
            __builtin_amdgcn_fence(__ATOMIC_ACQUIRE, "agent");
            xb_add(&bar[XB_XGEN(b.x)], 1u);
            asm volatile("s_waitcnt vmcnt(0)" ::: "memory");
        } else {
            XB_SPIN(xb_ld(&bar[XB_XGEN(b.x)]) == gen, bar);
            __builtin_amdgcn_fence(__ATOMIC_ACQUIRE, "agent");
            asm volatile("s_waitcnt vmcnt(0)" ::: "memory");
        }
    }
    __syncthreads();
}

constexpr int NWAVES = 8;
#ifndef MK_N_LAUNCHES
#define MK_N_LAUNCHES 1
#endif

constexpr int DM = 2048, INW = 4096, FF = 8192, DEPTH = 2;
constexpr int SP = 16384, SS = 2048;
constexpr int MP = 2 * SP, MS = 4 * SS, M = MP + MS;
constexpr int NCHUNK = 5, MC = M / NCHUNK;
constexpr int N_PHASES = 1 + DEPTH * (5 + (NCHUNK + 1) + 1);
constexpr float RMS_EPS = 1e-6f, LN_EPS = 1e-5f, LOG2E = 1.4426950408889634f;
constexpr int ZW = 3072, ZA_B = 0, Z_P = 512, ZB_Q = 1024, ZB_K = 1536, ZB_V = 1664, ZC_Q = 1792, ZC_K = 2304, ZC_V = 2432, Z_U = 2560;
constexpr int Y_A = 0, Y_B = 512, Y_C = 1024, Y_D = 1536;
static_assert(attn_body::ZP == ZW && attn_body::OP == DM, "attention body pitches");

constexpr size_t MiB = 1u << 20;
constexpr size_t WS_CTL = 0, CTL_ZERO_BYTES = 1 * MiB;
constexpr size_t WS_W = 2 * MiB, W_LAYER = 88 * MiB;
constexpr size_t WO_IN = 0, WO_OUT = 16 * MiB, WO_F1 = 24 * MiB, WO_F2 = 56 * MiB;
constexpr size_t WS_Z = WS_W + DEPTH * W_LAYER;
constexpr size_t WS_Y = WS_Z + (size_t)M * INW * 2;
constexpr size_t WS_U1 = WS_Z + (size_t)M * DM * 2;
static_assert(WS_U1 + (size_t)MC * FF * 2 <= WS_Y, "U1 fits above YP inside the z region");
constexpr size_t WS_H = WS_Y + (size_t)M * DM * 2;
constexpr size_t WS_RS = 1 * MiB;
constexpr size_t WS_KT = WS_H + (size_t)M * DM * 2;
constexpr size_t KV_IMG = (size_t)4 * (M / 64) * 8192;
constexpr size_t WS_VT = WS_KT + KV_IMG;
constexpr size_t WS_END = WS_VT + KV_IMG;
static_assert((size_t)MC * FF * 2 <= (size_t)M * DM * 2, "U chunk fits in the y region");
constexpr int CW_ATT = 8192;
constexpr int CW_BAR = 4096;

constexpr int RING_OFF = 0, RING_BYTES = 131072;
constexpr int LDSCTL_OFF = RING_BYTES, MISC_OFF = LDSCTL_OFF + 320;
constexpr int LDS_BYTES = 147456;
static_assert(MISC_OFF + 128 <= LDS_BYTES && attn_body::ATTN_LDS_BYTES <= RING_BYTES, "LDS map");

typedef unsigned u32x2 __attribute__((ext_vector_type(2)));
struct Frame {
    LAS unsigned char* lds;
    volatile LAS unsigned* MISC;
    int tid, lane, wave;
    int vcu, G;
    __device__ __forceinline__ const float* in(int i) const { asm volatile("" : "+s"(i)); return ((const float* const __attribute__((address_space(4)))*)__builtin_amdgcn_kernarg_segment_ptr())[i]; }
    __device__ __forceinline__ const float* xp() const { return in(0); }
    __device__ __forceinline__ const float* xs() const { return in(1); }
    __device__ __forceinline__ const float* pre_mix_g() const { return in(2); }
    __device__ __forceinline__ const float* w_in() const { return in(3); }
    __device__ __forceinline__ const float* conv_a_w() const { return in(4); }
    __device__ __forceinline__ const float* q_norm_g() const { return in(5); }
    __device__ __forceinline__ const float* k_norm_g() const { return in(6); }
    __device__ __forceinline__ const float* sink_c() const { return in(7); }
    __device__ __forceinline__ const float* conv_d_w() const { return in(8); }
    __device__ __forceinline__ const float* conv_d_b() const { return in(9); }
    __device__ __forceinline__ const float* ln_d_g() const { return in(10); }
    __device__ __forceinline__ const float* ln_d_b() const { return in(11); }
    __device__ __forceinline__ const float* w_out() const { return in(12); }
    __device__ __forceinline__ const float* post_mix_g() const { return in(13); }
    __device__ __forceinline__ const float* pre_ffn_g() const { return in(14); }
    __device__ __forceinline__ const float* w_ff1() const { return in(15); }
    __device__ __forceinline__ const float* w_ff2() const { return in(16); }
    __device__ __forceinline__ const float* post_ffn_g() const { return in(17); }
    float* out;
    unsigned char* ws;
    __device__ __forceinline__ bf16* Z() const { return (bf16*)(ws + WS_Z); }
    __device__ __forceinline__ bf16* Y() const { return (bf16*)(ws + WS_Y); }
    __device__ __forceinline__ bf16* H() const { return (bf16*)(ws + WS_H); }
    __device__ __forceinline__ float* RS() const { return (float*)(ws + WS_RS); }
    __device__ __forceinline__ char* KT() const { return (char*)(ws + WS_KT); }
    __device__ __forceinline__ char* VT() const { return (char*)(ws + WS_VT); }
    __device__ __forceinline__ gu32* ctl() const { return (gu32*)(ws + WS_CTL); }
};
__device__ __forceinline__ bf16* wt_ptr(Frame& F, int l, size_t off) { return (bf16*)(F.ws + WS_W + (size_t)l * W_LAYER + off); }

__device__ __forceinline__ float wave_sum(float v) {
#pragma unroll
    for (int o = 1; o < 64; o <<= 1) v += __shfl_xor(v, o);
    return v;
}
__device__ __forceinline__ unsigned cvtpk(float lo, float hi) { typedef float f2 __attribute__((ext_vector_type(2))); typedef __bf16 b2 __attribute__((ext_vector_type(2))); f2 v = {lo, hi}; b2 b = __builtin_convertvector(v, b2); return __builtin_bit_cast(unsigned, b); }
__device__ __forceinline__ float bflo(unsigned w) { return __uint_as_float(w << 16); }
__device__ __forceinline__ float bfhi(unsigned w) { return __uint_as_float(w & 0xffff0000u); }
__device__ __forceinline__ float sigmoidf_(float x) { return __builtin_amdgcn_rcpf(1.0f + __expf(-x)); }
__device__ __forceinline__ int win_dst_row(int ns) {
    if (ns >= 512 && ns < 1536) { const int v = ns >= 1024, r = ns - (v ? 1024 : 512); return 512 + 256 * (r >> 7) + 128 * v + (r & 127); }
    if (ns >= 3072) { const int v = ns >= 3584, r = ns - (v ? 3584 : 3072); return 3072 + 256 * (r >> 7) + 128 * v + (r & 127); }
    return ns;
}
template <bool WIN_ORDER>
__device__ __forceinline__ void p0_transpose_item(const float* W, int K, int N, bf16* WT, LAS unsigned char* scr, int item, int lane, const float* gk) {
    const int nblk = N / 64, kb = item / nblk, nb = item % nblk, k0 = 64 * kb, n0 = 64 * nb;
    const int sub = lane >> 4, nq = 4 * (lane & 15);
    f32x4 v[16]; float g[16];
#pragma unroll
    for (int i = 0; i < 16; ++i) v[i] = __builtin_nontemporal_load((const GAS f32x4*)(W + (size_t)(k0 + 4 * i + sub) * N + n0 + nq));
#pragma unroll
    for (int i = 0; i < 16; ++i) g[i] = gk ? gk[k0 + 4 * i + sub] : 1.0f;
#pragma unroll
    for (int i = 0; i < 16; ++i) { const int k = 4 * i + sub; const f32x4 x = v[i] * g[i]; const unsigned w01 = cvtpk(x.x, x.y), w23 = cvtpk(x.z, x.w);
        LAS unsigned short* t = (LAS unsigned short*)(scr + nq * 132 + 2 * k);
        t[0] = (unsigned short)w01; t[66] = (unsigned short)(w01 >> 16); t[132] = (unsigned short)w23; t[198] = (unsigned short)(w23 >> 16); }
    LDS_WAIT(); asm volatile("" ::: "memory");
    const int rbase = WIN_ORDER ? win_dst_row(n0) : n0, r16 = lane >> 2, cg = lane & 3;
#pragma unroll
    for (int j = 0; j < 8; ++j) { const int rbi = j >> 1, cbi = j & 1, p = 16 * rbi + r16, n = (p & ~31) + pg8::perm32(p & 31);
        const LAS unsigned* r = (const LAS unsigned*)(scr + n * 132 + (32 * cbi + 8 * cg) * 2);
        v4u o; o.x = r[0]; o.y = r[1]; o.z = r[2]; o.w = r[3];
        *(GAS v4u*)((char*)WT + pg8::tiled_off(rbase + p, k0 + 32 * cbi + 8 * cg, K)) = o; }
    LDS_WAIT(); asm volatile("" ::: "memory");
}
__device__ __forceinline__ const float* xin_row(Frame& F, int m) { return m < MP ? F.xp() + (size_t)m * DM : F.xs() + (size_t)(m - MP) * DM; }

__device__ __forceinline__ void p0_prologue(Frame& F) {
    LAS unsigned char* scr = F.lds + RING_OFF + F.wave * 16384;
    const int gw = F.vcu * NWAVES + F.wave, NGW = F.G * NWAVES;
    constexpr int I_IN = (DM / 64) * (INW / 64), I_OUT = (DM / 64) * (DM / 64), I_F1 = (DM / 64) * (FF / 64), I_F2 = (FF / 64) * (DM / 64), I_L = I_IN + I_OUT + I_F1 + I_F2;
    for (int it = gw; it < DEPTH * I_L; it += NGW) {
        const int l = it / I_L; int r = it % I_L;
        if (r < I_IN) { p0_transpose_item<true>(F.w_in() + (size_t)l * DM * INW, DM, INW, wt_ptr(F, l, WO_IN), scr, r, F.lane, F.pre_mix_g() + l * DM); continue; } r -= I_IN;
        if (r < I_OUT) { p0_transpose_item<false>(F.w_out() + (size_t)l * DM * DM, DM, DM, wt_ptr(F, l, WO_OUT), scr, r, F.lane, nullptr); continue; } r -= I_OUT;
        if (r < I_F1) { p0_transpose_item<false>(F.w_ff1() + (size_t)l * DM * FF, DM, FF, wt_ptr(F, l, WO_F1), scr, r, F.lane, F.pre_ffn_g() + l * DM); continue; } r -= I_F1;
        p0_transpose_item<false>(F.w_ff2() + (size_t)l * FF * DM, FF, DM, wt_ptr(F, l, WO_F2), scr, r, F.lane, nullptr);
    }
    for (int mb = gw; mb < M; mb += 4 * NGW) {
        f32x4 x[4][4][2];
#pragma unroll
        for (int k = 0; k < 4; ++k) { const int m = mb + k * NGW; if (m < M) { const float* xr = xin_row(F, m);
#pragma unroll
            for (int j = 0; j < 4; ++j) { x[k][j][0] = __builtin_nontemporal_load((const GAS f32x4*)(xr + j * 512 + F.lane * 8)); x[k][j][1] = __builtin_nontemporal_load((const GAS f32x4*)(xr + j * 512 + F.lane * 8 + 4)); } } }
#pragma unroll
        for (int k = 0; k < 4; ++k) { const int m = mb + k * NGW; if (m < M) { float ss = 0.f;
#pragma unroll
            for (int j = 0; j < 4; ++j) { const f32x4 a = x[k][j][0], b = x[k][j][1]; ss += (a.x * a.x + a.y * a.y) + (a.z * a.z + a.w * a.w) + (b.x * b.x + b.y * b.y) + (b.z * b.z + b.w * b.w);
                v4u o; o.x = cvtpk(a.x, a.y); o.y = cvtpk(a.z, a.w); o.z = cvtpk(b.x, b.y); o.w = cvtpk(b.z, b.w);
                *(GAS v4u*)(F.H() + (size_t)m * DM + j * 512 + F.lane * 8) = o; }
            const float r = rsqrtf(wave_sum(ss) * (1.0f / DM) + RMS_EPS);
            if (F.lane == 0) F.RS()[m] = r; } }
    }
}

template <bool FINAL, bool FIRSTX>
__device__ __forceinline__ void norm_pass(Frame& F, const bf16* YPb, const float* gpost) {
    constexpr int R = FIRSTX ? 2 : 4;
    const int gw = F.vcu * NWAVES + F.wave, NGW = F.G * NWAVES;
    f32x4 ga[4][2];
#pragma unroll
    for (int j = 0; j < 4; ++j) { ga[j][0] = *(const GAS f32x4*)(gpost + j * 512 + F.lane * 8); ga[j][1] = *(const GAS f32x4*)(gpost + j * 512 + F.lane * 8 + 4); }
    for (int mb = gw; mb < M; mb += R * NGW) {
        v4u y[R][4]; v4u xb[R][4]; f32x4 xf[FIRSTX ? R : 1][4][2];
#pragma unroll
        for (int k = 0; k < R; ++k) { const int m = mb + k * NGW; if (m < M) {
#pragma unroll
            for (int j = 0; j < 4; ++j) y[k][j] = __builtin_nontemporal_load((const GAS v4u*)(YPb + (size_t)m * DM + j * 512 + F.lane * 8));
            if constexpr (FIRSTX) { const float* xr = xin_row(F, m);
#pragma unroll
                for (int j = 0; j < 4; ++j) { xf[k][j][0] = __builtin_nontemporal_load((const GAS f32x4*)(xr + j * 512 + F.lane * 8)); xf[k][j][1] = __builtin_nontemporal_load((const GAS f32x4*)(xr + j * 512 + F.lane * 8 + 4)); }
            } else {
#pragma unroll
                for (int j = 0; j < 4; ++j) xb[k][j] = __builtin_nontemporal_load((const GAS v4u*)(F.H() + (size_t)m * DM + j * 512 + F.lane * 8));
            } } }
#pragma unroll
        for (int k = 0; k < R; ++k) { const int m = mb + k * NGW; if (m < M) {
            float ss = 0.f;
#pragma unroll
            for (int j = 0; j < 4; ++j) { const v4u w = y[k][j]; const float a0 = bflo(w.x), a1 = bfhi(w.x), a2 = bflo(w.y), a3 = bfhi(w.y), a4 = bflo(w.z), a5 = bfhi(w.z), a6 = bflo(w.w), a7 = bfhi(w.w);
                ss += (a0 * a0 + a1 * a1) + (a2 * a2 + a3 * a3) + (a4 * a4 + a5 * a5) + (a6 * a6 + a7 * a7); }
            const float r = rsqrtf(wave_sum(ss) * (1.0f / DM) + RMS_EPS);
            float s2 = 0.f;
#pragma unroll
            for (int j = 0; j < 4; ++j) { const v4u w = y[k][j];
                const f32x4 y0 = (f32x4){bflo(w.x), bfhi(w.x), bflo(w.y), bfhi(w.y)}, y1 = (f32x4){bflo(w.z), bfhi(w.z), bflo(w.w), bfhi(w.w)};
                f32x4 x0, x1;
                if constexpr (FIRSTX) { x0 = xf[k][j][0]; x1 = xf[k][j][1]; }
                else { const v4u q = xb[k][j]; x0 = (f32x4){bflo(q.x), bfhi(q.x), bflo(q.y), bfhi(q.y)}; x1 = (f32x4){bflo(q.z), bfhi(q.z), bflo(q.w), bfhi(q.w)}; }
                const f32x4 v0 = x0 + y0 * r * ga[j][0], v1 = x1 + y1 * r * ga[j][1];
                if constexpr (FINAL) { __builtin_nontemporal_store(v0, (GAS f32x4*)(F.out + (size_t)m * DM + j * 512 + F.lane * 8)); __builtin_nontemporal_store(v1, (GAS f32x4*)(F.out + (size_t)m * DM + j * 512 + F.lane * 8 + 4)); }
                else { s2 += (v0.x * v0.x + v0.y * v0.y) + (v0.z * v0.z + v0.w * v0.w) + (v1.x * v1.x + v1.y * v1.y) + (v1.z * v1.z + v1.w * v1.w);
                    v4u o; o.x = cvtpk(v0.x, v0.y); o.y = cvtpk(v0.z, v0.w); o.z = cvtpk(v1.x, v1.y); o.w = cvtpk(v1.z, v1.w);
                    *(GAS v4u*)(F.H() + (size_t)m * DM + j * 512 + F.lane * 8) = o; } }
            if constexpr (!FINAL) { const float r2 = rsqrtf(wave_sum(s2) * (1.0f / DM) + RMS_EPS); if (F.lane == 0) F.RS()[m] = r2; }
        } }
    }
}

constexpr int PREP_T = 32, PREP_U_ROWS = PREP_T + 30, PREP_TW = PREP_T / NWAVES;
constexpr int PREP_V_OFF = PREP_U_ROWS * 512 * 2;
static_assert(PREP_V_OFF % 16 == 0 && PREP_V_OFF + PREP_T * 512 * 4 <= RING_BYTES, "prep LDS");
__device__ __forceinline__ void rope_store4(bf16* p1, bf16* p2, const float (&a)[4], const float (&b)[4], const float (&c)[4], const float (&s)[4], float scale, bool pred) {
    float o1[4], o2[4];
#pragma unroll
    for (int k = 0; k < 4; ++k) { o1[k] = (a[k] * c[k] - b[k] * s[k]) * scale; o2[k] = (b[k] * c[k] + a[k] * s[k]) * scale; }
    if (pred) { u32x2 w1, w2; w1.x = cvtpk(o1[0], o1[1]); w1.y = cvtpk(o1[2], o1[3]); w2.x = cvtpk(o2[0], o2[1]); w2.y = cvtpk(o2[2], o2[3]);
        *(GAS u32x2*)p1 = w1; *(GAS u32x2*)p2 = w2; }
}
__device__ __forceinline__ void load4x2(const bf16* p1, const bf16* p2, float (&a)[4], float (&b)[4]) {
    const u32x2 w1 = *(const GAS u32x2*)p1, w2 = *(const GAS u32x2*)p2;
    a[0] = bflo(w1.x); a[1] = bfhi(w1.x); a[2] = bflo(w1.y); a[3] = bfhi(w1.y); b[0] = bflo(w2.x); b[1] = bfhi(w2.x); b[2] = bflo(w2.y); b[3] = bfhi(w2.y);
}
__device__ __forceinline__ void unpack8(const v4u w, float (&f)[8]) { f[0] = bflo(w.x); f[1] = bfhi(w.x); f[2] = bflo(w.y); f[3] = bfhi(w.y); f[4] = bflo(w.z); f[5] = bfhi(w.z); f[6] = bflo(w.w); f[7] = bfhi(w.w); }

__device__ __forceinline__ void prep_phase(Frame& F, const int l) {
    LAS bf16* Ub = (LAS bf16*)(F.lds + RING_OFF);
    LAS float* V = (LAS float*)(F.lds + RING_OFF + PREP_V_OFF);
    const int lane = F.lane, tid = F.tid, wave = F.wave;
    const float* cdw = F.conv_d_w() + (size_t)l * 31 * 512;
    float wd[31];
#pragma unroll
    for (int j = 0; j < 31; ++j) wd[j] = cdw[j * 512 + tid];
    const float cdb = F.conv_d_b()[l * 512 + tid];
    const float* caw = F.conv_a_w() + (size_t)l * 3 * 512;
    const float* gk = F.k_norm_g() + l * 64;
    const int c0 = lane * 8;
    f32x4 wa[3][2];
#pragma unroll
    for (int j = 0; j < 3; ++j) { wa[j][0] = *(const GAS f32x4*)(caw + j * 512 + c0); wa[j][1] = *(const GAS f32x4*)(caw + j * 512 + c0 + 4); }
    const f32x4 g0 = *(const GAS f32x4*)(F.ln_d_g() + l * 512 + c0), g1 = *(const GAS f32x4*)(F.ln_d_g() + l * 512 + c0 + 4), b0 = *(const GAS f32x4*)(F.ln_d_b() + l * 512 + c0), b1 = *(const GAS f32x4*)(F.ln_d_b() + l * 512 + c0 + 4);
    constexpr int NST = (PREP_U_ROWS * 64 + 511) / 512;
    for (int item = F.vcu; item < M / PREP_T; item += F.G) {
        const int m0 = item * PREP_T;
        int t0, S; if (m0 < MP) { t0 = m0 & (SP - 1); S = SP; } else { t0 = (m0 - MP) & (SS - 1); S = SS; }
        v4u stg[NST];
#pragma unroll
        for (int it = 0; it < NST; ++it) { const int id = it * 512 + tid, rr = id >> 6, ch = (id & 63) * 8, tp = t0 - 15 + rr;
            stg[it] = (v4u){0u, 0u, 0u, 0u};
            if (id < PREP_U_ROWS * 64 && tp >= 0 && tp < S) stg[it] = *(const GAS v4u*)(F.Z() + (size_t)(m0 - 15 + rr) * ZW + Z_U + ch); }
        const int ta = t0 + PREP_TW * wave, ma = m0 + PREP_TW * wave;
        v4u pr[PREP_TW + 2], ab[PREP_TW];
#pragma unroll
        for (int j = 0; j < PREP_TW + 2; ++j) { const int tp = ta + j - 1; pr[j] = (v4u){0u, 0u, 0u, 0u};
            if (tp >= 0 && tp < S) pr[j] = *(const GAS v4u*)(F.Z() + (size_t)(ma + j - 1) * ZW + Z_P + c0); }
#pragma unroll
        for (int j = 0; j < PREP_TW; ++j) ab[j] = *(const GAS v4u*)(F.Z() + (size_t)(ma + j) * ZW + ZA_B + c0);
        const int grp = lane >> 5, hk = (lane >> 3) & 1, sl = lane & 7, half = sl >> 2;
        const int i0 = grp ? 4 * sl : 4 * (sl & 3);
        const int koff = grp ? (ZC_K + hk * 64 + i0) : (ZB_K + hk * 64 + half * 32 + i0), kd = grp ? 32 : 16;
        u32x2 kw[PREP_TW / 2][2];
#pragma unroll
        for (int q = 0; q < PREP_TW / 2; ++q) { const bf16* p1 = F.Z() + (size_t)(ma + 2 * q + ((lane >> 4) & 1)) * ZW + koff; kw[q][0] = *(const GAS u32x2*)p1; kw[q][1] = *(const GAS u32x2*)(p1 + kd); }
        unsigned vld[2][4];
#pragma unroll
        for (int it = 0; it < 2; ++it) { const int id = it * 512 + tid, qd = id >> 7, cb = (id >> 5) & 3, dp = id & 31;
#pragma unroll
            for (int j = 0; j < 4; ++j) vld[it][j] = *(const GAS unsigned*)(F.Z() + (size_t)(m0 + 4 * qd + j) * ZW + ((cb >> 1) ? ZC_V : ZB_V) + (cb & 1) * 64 + 2 * dp); }
#pragma unroll
        for (int it = 0; it < NST; ++it) { const int id = it * 512 + tid, rr = id >> 6, ch = (id & 63) * 8;
            if (id < PREP_U_ROWS * 64) *(LAS v4u*)(Ub + rr * 512 + ch) = stg[it]; }
#pragma unroll
        for (int it = 0; it < 2; ++it) { const int id = it * 512 + tid, qd = id >> 7, cb = (id >> 5) & 3, dp = id & 31;
            int w0 = 0, w1 = 0;
            w0 = __builtin_amdgcn_cvt_pk_fp8_f32(bflo(vld[it][0]), bflo(vld[it][1]), w0, false); w0 = __builtin_amdgcn_cvt_pk_fp8_f32(bflo(vld[it][2]), bflo(vld[it][3]), w0, true);
            w1 = __builtin_amdgcn_cvt_pk_fp8_f32(bfhi(vld[it][0]), bfhi(vld[it][1]), w1, false); w1 = __builtin_amdgcn_cvt_pk_fp8_f32(bfhi(vld[it][2]), bfhi(vld[it][3]), w1, true);
            char* vt = F.VT() + ((size_t)(cb * (M / 64) + (m0 >> 6)) << 12) + (qd & 1) * 2048 + ((m0 >> 5) & 1) * 1024 + 4 * (qd >> 1);
            *(GAS int*)(vt + (2 * dp) * 16) = w0; *(GAS int*)(vt + (2 * dp + 1) * 16) = w1; }
#pragma unroll
        for (int q = 0; q < PREP_TW; ++q) { float acc[8], bb[8];
#pragma unroll
            for (int k = 0; k < 8; ++k) acc[k] = 0.f;
#pragma unroll
            for (int j = 0; j < 3; ++j) { float pp[8]; unpack8(pr[q + j], pp);
                acc[0] += wa[j][0].x * pp[0]; acc[1] += wa[j][0].y * pp[1]; acc[2] += wa[j][0].z * pp[2]; acc[3] += wa[j][0].w * pp[3];
                acc[4] += wa[j][1].x * pp[4]; acc[5] += wa[j][1].y * pp[5]; acc[6] += wa[j][1].z * pp[6]; acc[7] += wa[j][1].w * pp[7]; }
            unpack8(ab[q], bb);
            v4u o; o.x = cvtpk(bb[0] * acc[0], bb[1] * acc[1]); o.y = cvtpk(bb[2] * acc[2], bb[3] * acc[3]); o.z = cvtpk(bb[4] * acc[4], bb[5] * acc[5]); o.w = cvtpk(bb[6] * acc[6], bb[7] * acc[7]);
            *(GAS v4u*)(F.Y() + (size_t)(ma + q) * DM + Y_A + c0) = o; }
#pragma unroll
        for (int q = 0; q < PREP_TW / 2; ++q) {
            const int tk = PREP_TW * wave + 2 * q + ((lane >> 4) & 1), tpos = t0 + tk;
            const int pos = grp ? tpos : (half ? (tpos & 63) : (tpos >> 6));
            const int mr = m0 + tk, f1 = grp ? i0 : half * 32 + i0, f2 = f1 + kd;
            char* kt = F.KT() + ((size_t)((grp * 2 + hk) * (M / 64) + (mr >> 6)) << 12) + (mr & 63) * 16;
            int* p1 = (int*)(kt + ((f1 >> 3) & 1) * 2048 + (f1 >> 5) * 1024 + ((f1 >> 4) & 1) * 8 + (f1 & 7)); int* p2 = (int*)(kt + ((f2 >> 3) & 1) * 2048 + (f2 >> 5) * 1024 + ((f2 >> 4) & 1) * 8 + (f2 & 7));
            float cs[4], sn[4];
#pragma unroll
            for (int k = 0; k < 4; ++k) sincos_f((float)pos * INVF[grp ? (i0 + k) : 2 * (i0 + k)], sn[k], cs[k]);
            float a[4], b[4];
            a[0] = bflo(kw[q][0].x); a[1] = bfhi(kw[q][0].x); a[2] = bflo(kw[q][0].y); a[3] = bfhi(kw[q][0].y); b[0] = bflo(kw[q][1].x); b[1] = bfhi(kw[q][1].x); b[2] = bflo(kw[q][1].y); b[3] = bfhi(kw[q][1].y);
            float ss = (a[0] * a[0] + a[1] * a[1]) + (a[2] * a[2] + a[3] * a[3]) + (b[0] * b[0] + b[1] * b[1]) + (b[2] * b[2] + b[3] * b[3]);
            ss += __shfl_xor(ss, 1); ss += __shfl_xor(ss, 2); ss += __shfl_xor(ss, 4);
            const float r = grp ? 1.0f : rsqrtf(ss * (1.0f / 64.0f) + RMS_EPS);
#pragma unroll
            for (int k = 0; k < 4; ++k) { const int gi = grp ? 0 : (half * 32 + i0);
                const float g1k = grp ? 1.0f : gk[gi + k], g2k = grp ? 1.0f : gk[gi + 16 + k]; a[k] = a[k] * r * g1k; b[k] = b[k] * r * g2k; }
            {   float o1[4], o2[4];
#pragma unroll
                for (int k = 0; k < 4; ++k) { o1[k] = a[k] * cs[k] - b[k] * sn[k]; o2[k] = b[k] * cs[k] + a[k] * sn[k]; }
                int w1 = 0, w2 = 0;
                w1 = __builtin_amdgcn_cvt_pk_fp8_f32(o1[0], o1[1], w1, false); w1 = __builtin_amdgcn_cvt_pk_fp8_f32(o1[2], o1[3], w1, true);
                w2 = __builtin_amdgcn_cvt_pk_fp8_f32(o2[0], o2[1], w2, false); w2 = __builtin_amdgcn_cvt_pk_fp8_f32(o2[2], o2[3], w2, true);
                *(GAS int*)p1 = w1; *(GAS int*)p2 = w2; }
        }
        __syncthreads();
        {   float uu[PREP_U_ROWS];
#pragma unroll
            for (int rr = 0; rr < PREP_U_ROWS; ++rr) uu[rr] = __uint_as_float((unsigned)Ub[rr * 512 + tid] << 16);
#pragma unroll
            for (int tt = 0; tt < PREP_T; ++tt) { float a = cdb;
#pragma unroll
                for (int j = 0; j < 31; ++j) a += wd[j] * uu[tt + j];
                V[tt * 512 + tid] = a; } }
        __syncthreads();
        {   f32x4 v0[PREP_TW], v1[PREP_TW]; float sm[PREP_TW];
#pragma unroll
            for (int q = 0; q < PREP_TW; ++q) { const int tt = PREP_TW * wave + q; v0[q] = *(const LAS f32x4*)(V + tt * 512 + c0); v1[q] = *(const LAS f32x4*)(V + tt * 512 + c0 + 4);
                sm[q] = (v0[q].x + v0[q].y) + (v0[q].z + v0[q].w) + (v1[q].x + v1[q].y) + (v1[q].z + v1[q].w); }
#pragma unroll
            for (int o = 1; o < 64; o <<= 1)
#pragma unroll
                for (int q = 0; q < PREP_TW; ++q) sm[q] += __shfl_xor(sm[q], o);
#pragma unroll
            for (int q = 0; q < PREP_TW; ++q) { const float mean = sm[q] * (1.0f / 512.0f); v0[q] = v0[q] - mean; v1[q] = v1[q] - mean;
                sm[q] = (v0[q].x * v0[q].x + v0[q].y * v0[q].y) + (v0[q].z * v0[q].z + v0[q].w * v0[q].w) + (v1[q].x * v1[q].x + v1[q].y * v1[q].y) + (v1[q].z * v1[q].z + v1[q].w * v1[q].w); }
#pragma unroll
            for (int o = 1; o < 64; o <<= 1)
#pragma unroll
                for (int q = 0; q < PREP_TW; ++q) sm[q] += __shfl_xor(sm[q], o);
#pragma unroll
            for (int q = 0; q < PREP_TW; ++q) { const int m = m0 + PREP_TW * wave + q; const float r = rsqrtf(sm[q] * (1.0f / 512.0f) + LN_EPS);
                f32x4 y0 = v0[q] * r * g0 + b0, y1 = v1[q] * r * g1 + b1;
                y0 = (f32x4){y0.x * sigmoidf_(y0.x), y0.y * sigmoidf_(y0.y), y0.z * sigmoidf_(y0.z), y0.w * sigmoidf_(y0.w)};
                y1 = (f32x4){y1.x * sigmoidf_(y1.x), y1.y * sigmoidf_(y1.y), y1.z * sigmoidf_(y1.z), y1.w * sigmoidf_(y1.w)};
                v4u o; o.x = cvtpk(y0.x, y0.y); o.y = cvtpk(y0.z, y0.w); o.z = cvtpk(y1.x, y1.y); o.w = cvtpk(y1.z, y1.w);
                *(GAS v4u*)(F.Y() + (size_t)m * DM + Y_D + c0) = o; } }
        __syncthreads();
    }
}

__device__ __forceinline__ void attn_phase_all(Frame& F, const int l, char* shm) {
    typedef attn_body::bf16 abf;
    const abf* Z = (const abf*)F.Z(); abf* Y = (abf*)F.Y();
    float gqm = __builtin_fabsf(F.q_norm_g()[l * 64 + F.lane]), gkm = __builtin_fabsf(F.k_norm_g()[l * 64 + F.lane]);
#pragma unroll
    for (int o = 1; o < 64; o <<= 1) { gqm = __builtin_fmaxf(gqm, __shfl_xor(gqm, o)); gkm = __builtin_fmaxf(gkm, __shfl_xor(gkm, o)); }
    const int ref0 = __builtin_amdgcn_readfirstlane((int)__builtin_ceilf(__builtin_fminf(__builtin_fmaxf((8.0f * LOG2E) * gqm * gkm - 15.5f, 0.f), 100.f)));
    const bool fast = ref0 <= 6;
    const float pscale = __int_as_float((127 + ref0) << 23);
    LAS int* const tkw = (LAS int*)(F.lds + LDSCTL_OFF + 64);
    unsigned* const ctrA = (unsigned*)(F.ctl() + CW_ATT + l * 128), * const ctrB = ctrA + 64;
#define ATT_BCAST(dst, v) do { if (F.tid == 0) *tkw = (v); asm volatile("s_waitcnt lgkmcnt(0)\n\ts_barrier" ::: "memory"); { const int r_ = *tkw; asm volatile("s_waitcnt lgkmcnt(0)\n\ts_barrier" ::: "memory"); (dst) = __builtin_amdgcn_readfirstlane(r_); } } while (0)
    {   int i = 0, tkt = -1;
        for (;;) {
            int idx;
            if (tkt < 0) { idx = i * F.G + F.vcu; ++i; if (idx >= 1024) { int t0 = 0; if (F.tid == 0) t0 = (int)__hip_atomic_fetch_add(ctrA, 1u, __ATOMIC_RELAXED, __HIP_MEMORY_SCOPE_AGENT); ATT_BCAST(tkt, t0); continue; } }
            else { if (tkt >= 256) break; idx = 1024 + tkt; }
            int tn = 0; if (tkt >= 0 && F.tid == 0) tn = (int)__hip_atomic_fetch_add(ctrA, 1u, __ATOMIC_RELAXED, __HIP_MEMORY_SCOPE_AGENT);
            const int r = idx >> 8, v = idx & 255, x = v >> 5, j = v & 31;
            int head, kv, qb, NT; long srow;
            if (r < 4) { const int sx = x >> 1; kv = sx & 1; head = kv * 4 + (x & 1) * 2 + (r >> 1); qb = (r & 1) * 32 + j; srow = (long)(sx >> 1) * SP; NT = SP / 64; }
            else { kv = x & 1; head = kv * 4 + (j >> 3); qb = j & 7; srow = (long)MP + (long)(x >> 1) * SS; NT = SS / 64; }
            const long qrow = srow + qb * 256;
            const size_t kvo = ((size_t)(kv * (M / 64)) + (size_t)(srow >> 6)) << 13;
            if (fast) attn_body::attn_unit<2, 8, 1>(Z + qrow * ZW + ZB_Q + head * 64, F.KT() + (kvo >> 1), F.VT() + (kvo >> 1), Y + qrow * DM + Y_B + head * 64, NT, 0, 0, pscale, qb * 256, F.q_norm_g() + l * 64, shm);
            else attn_body::attn_unit<0, 8, 1>(Z + qrow * ZW + ZB_Q + head * 64, F.KT() + (kvo >> 1), F.VT() + (kvo >> 1), Y + qrow * DM + Y_B + head * 64, NT, 0, 0, 0.f, qb * 256, F.q_norm_g() + l * 64, shm);
            if (tkt >= 0) ATT_BCAST(tkt, tn);
        }
    }
    {   int tkt, t0 = 0; if (F.tid == 0) t0 = (int)__hip_atomic_fetch_add(ctrB, 1u, __ATOMIC_RELAXED, __HIP_MEMORY_SCOPE_AGENT); ATT_BCAST(tkt, t0);
        while (tkt < 1280) {
            int tn = 0; if (F.tid == 0) tn = (int)__hip_atomic_fetch_add(ctrB, 1u, __ATOMIC_RELAXED, __HIP_MEMORY_SCOPE_AGENT);
            const int u = tkt, qblk = u >> 3, head = u & 7, kv = head >> 2; const long qrow = (long)qblk * 256;
            long srow; int S; if (qrow < MP) { srow = (qrow / SP) * SP; S = SP; } else { srow = MP + ((qrow - MP) / SS) * SS; S = SS; }
            const int q0 = (int)(qrow - srow);
            const float sink2 = F.sink_c()[l * 8 + head] * LOG2E;
            const size_t kvo = ((size_t)((2 + kv) * (M / 64)) + (size_t)(srow >> 6)) << 13;
            attn_body::attn_unit<1, 8, 2>(Z + qrow * ZW + ZC_Q + head * 64, F.KT() + (kvo >> 1), F.VT() + (kvo >> 1), Y + qrow * DM + Y_C + head * 64, 8, q0, S, sink2, q0, nullptr, shm);
            ATT_BCAST(tkt, tn);
        }
    }
#undef ATT_BCAST
}

struct Args { const float* in[18]; float* out; unsigned char* ws; int ph_lo, ph_hi, li, pad; };
__global__ void __launch_bounds__(NWAVES * 64, 2) fwd(Args args) {
    extern __shared__ __attribute__((aligned(16))) unsigned char lds[];
    Frame F;
    F.lds = (LAS unsigned char*)lds;
    F.MISC = (volatile LAS unsigned*)(F.lds + MISC_OFF);
    F.tid = threadIdx.x; F.lane = F.tid & 63; F.wave = __builtin_amdgcn_readfirstlane(F.tid >> 6);
    F.G = gridDim.x; { const int bx = blockIdx.x; F.vcu = (F.G % 8 == 0) ? (bx % 8) * (F.G / 8) + bx / 8 : bx; }
    unsigned char* ws = args.ws; F.ws = ws;
    F.out = args.out;
    bf16* const YPb = F.Z();
    bf16* const U0 = F.Y();
    bf16* const U1 = (bf16*)(ws + WS_U1);
    for (int u = F.tid; u < (LDS_BYTES - LDSCTL_OFF) / 4; u += NWAVES * 64) ((LAS unsigned*)(F.lds + LDSCTL_OFF))[u] = 0u;
    __syncthreads();
    XcdBarrier bar; bar.bar = (unsigned*)(F.ctl() + CW_BAR); bar.x = 0; bar.st = nullptr;
    if (MK_N_LAUNCHES == 1) bar = xcd_barrier_post((unsigned*)(F.ctl() + CW_BAR), F.MISC + 8);
    const int lo = args.ph_lo, hi = args.ph_hi; int ph = 0;
#define PH_BEGIN if (lo <= ph && ph < hi) { { int t_ = threadIdx.x; asm volatile("" : "+v"(t_)); F.tid = t_; F.lane = t_ & 63; F.wave = __builtin_amdgcn_readfirstlane(t_ >> 6); }
#define PH_END   if (ph + 1 < hi) xcd_barrier(bar); } ++ph;

    PH_BEGIN p0_prologue(F); PH_END

#pragma unroll 1
    for (int l = 0; l < DEPTH; ++l) {
        PH_BEGIN { pg8::Gemm g{F.H(), wt_ptr(F, l, WO_IN), M, INW, DM}; pg8::StaticOrder S; S.init(M, INW, F.G, (int)blockIdx.x);
            pg8::EpiIn E{F.Z(), ZW, F.RS()};
            pg8::gemm_phase<pg8::EpiIn, pg8::StaticOrder, true, true>(F.lds + RING_OFF, g, S, E); } PH_END
        PH_BEGIN prep_phase(F, l); PH_END
        PH_BEGIN attn_phase_all(F, l, (char*)lds + RING_OFF); PH_END
        PH_BEGIN { pg8::Gemm g{F.Y(), wt_ptr(F, l, WO_OUT), M, DM, DM}; pg8::StaticOrder S; S.init(M, DM, F.G, (int)blockIdx.x);
            pg8::EpiBf16<0, false> E{YPb, DM, nullptr};
            pg8::gemm_phase<pg8::EpiBf16<0, false>, pg8::StaticOrder, true, true>(F.lds + RING_OFF, g, S, E); } PH_END
        PH_BEGIN if (l == 0) norm_pass<false, true>(F, YPb, F.post_mix_g() + l * DM); else norm_pass<false, false>(F, YPb, F.post_mix_g() + l * DM); PH_END
        PH_BEGIN { pg8::Gemm g{F.H(), wt_ptr(F, l, WO_F1), MC, FF, DM}; pg8::StaticOrder S; S.init(MC, FF, F.G, (int)blockIdx.x);
            pg8::EpiBf16<2, true, true> E{U0, FF, F.RS()};
            pg8::gemm_phase<pg8::EpiBf16<2, true, true>, pg8::StaticOrder, true, true>(F.lds + RING_OFF, g, S, E); } PH_END
#pragma unroll 1
        for (int c = 0; c + 1 < NCHUNK; ++c) {
            PH_BEGIN {
                bf16* const Ur = (c & 1) ? U1 : U0; bf16* const Uw = (c & 1) ? U0 : U1;
                { pg8::Gemm g{Ur, wt_ptr(F, l, WO_F2), MC, DM, FF}; pg8::StaticOrder S; S.init(MC, DM, F.G, (int)blockIdx.x);
                  pg8::EpiBf16<0, false> E{YPb + (size_t)c * MC * DM, DM, nullptr};
                  pg8::gemm_phase<pg8::EpiBf16<0, false>, pg8::StaticOrder, true, true, true>(F.lds + RING_OFF, g, S, E); }
                __syncthreads();
                { pg8::Gemm g{F.H() + (size_t)(c + 1) * MC * DM, wt_ptr(F, l, WO_F1), MC, FF, DM}; pg8::StaticOrder S; S.init(MC, FF, F.G, (int)blockIdx.x);
                  pg8::EpiBf16<2, true, true> E{Uw, FF, F.RS() + (size_t)(c + 1) * MC};
                  pg8::gemm_phase<pg8::EpiBf16<2, true, true>, pg8::StaticOrder, true, true>(F.lds + RING_OFF, g, S, E); }
            } PH_END
        }
        PH_BEGIN { pg8::Gemm g{((NCHUNK - 1) & 1) ? U1 : U0, wt_ptr(F, l, WO_F2), MC, DM, FF}; pg8::StaticOrder S; S.init(MC, DM, F.G, (int)blockIdx.x);
            pg8::EpiBf16<0, false> E{YPb + (size_t)(NCHUNK - 1) * MC * DM, DM, nullptr};
            pg8::gemm_phase<pg8::EpiBf16<0, false>, pg8::StaticOrder, true, true, true>(F.lds + RING_OFF, g, S, E); } PH_END
        PH_BEGIN if (l + 1 < DEPTH) norm_pass<false, false>(F, YPb, F.post_ffn_g() + l * DM); else norm_pass<true, false>(F, YPb, F.post_ffn_g() + l * DM); PH_END
    }
#undef PH_BEGIN
#undef PH_END
}

extern "C" void kernel_launch(void* const* d_in, const int* in_sizes, int n_in, void* d_out, int out_size, void* d_ws, size_t ws_size, hipStream_t stream) {
    static int grid = 0;
    if (grid == 0) {
        if (n_in != 18 || in_sizes[0] != MP * DM || in_sizes[1] != MS * DM || out_size != M * DM || ws_size < WS_END) {
            fprintf(stderr, "kernel_launch: unexpected shapes (n_in %d, in0 %d, in1 %d, out %d, ws %zu; need ws >= %zu); nothing launched\n", n_in, n_in > 0 ? in_sizes[0] : -1, n_in > 1 ? in_sizes[1] : -1, out_size, ws_size, (size_t)WS_END); grid = -1; return; }
        int dev = 0, cus = 0, per_cu = 0;
        if (hipGetDevice(&dev) != hipSuccess || hipDeviceGetAttribute(&cus, hipDeviceAttributeMultiprocessorCount, dev) != hipSuccess) { fprintf(stderr, "kernel_launch: device query failed\n"); grid = -1; return; }
        if (hipFuncSetAttribute((const void*)fwd, hipFuncAttributeMaxDynamicSharedMemorySize, LDS_BYTES) != hipSuccess) { fprintf(stderr, "kernel_launch: hipFuncSetAttribute failed\n"); grid = -1; return; }
        if (hipOccupancyMaxActiveBlocksPerMultiprocessor(&per_cu, (const void*)fwd, NWAVES * 64, LDS_BYTES) != hipSuccess || per_cu < 1)
            fprintf(stderr, "kernel_launch: note: occupancy query reports %d workgroups per CU\n", per_cu);
        (void)hipGetLastError();
        grid = cus;
    }
    if (grid < 0) return;
    if (hipMemsetAsync((char*)d_ws + WS_CTL, 0, CTL_ZERO_BYTES, stream) != hipSuccess) { fprintf(stderr, "kernel_launch: memset failed\n"); return; }
    Args a{};
    for (int i = 0; i < 18; ++i) a.in[i] = (const float*)d_in[i];
    a.out = (float*)d_out; a.ws = (unsigned char*)d_ws;
    for (int li = 0; li < MK_N_LAUNCHES; ++li) {
        a.ph_lo = (MK_N_LAUNCHES == 1) ? 0 : li; a.ph_hi = (MK_N_LAUNCHES == 1) ? N_PHASES : li + 1; a.li = li; a.pad = 0;
        hipLaunchKernelGGL(fwd, dim3(grid), dim3(NWAVES * 64), LDS_BYTES, stream, a);
        const hipError_t le = hipPeekAtLastError();
        if (le != hipSuccess) { fprintf(stderr, "kernel_launch: launch %d failed: %s\n", li, hipGetErrorName(le)); break; }
    }
}
```

```cpp
#include <hip/hip_runtime.h>
#include <type_traits>
#include <hip/hip_bf16.h>
#include <cstdio>
#include <cstdint>
#include <cmath>
__constant__ float INVF[32] = {
    1.000000000e+00f, 7.498942018e-01f, 5.623413324e-01f, 4.216965139e-01f, 3.162277639e-01f, 2.371373922e-01f, 1.778279394e-01f, 1.333521456e-01f,
    1.000000015e-01f, 7.498941571e-02f, 5.623412877e-02f, 4.216964915e-02f, 3.162277862e-02f, 2.371373586e-02f, 1.778279431e-02f, 1.333521493e-02f,
    9.999999776e-03f, 7.498942316e-03f, 5.623413250e-03f, 4.216964822e-03f, 3.162277862e-03f, 2.371373819e-03f, 1.778279431e-03f, 1.333521446e-03f,
    1.000000047e-03f, 7.498941850e-04f, 5.623413017e-04f, 4.216965463e-04f, 3.162277862e-04f, 2.371373848e-04f, 1.778279402e-04f, 1.333521504e-04f};

__device__ __forceinline__ void sincos_f(float ang, float& s, float& c) {
    const double rev = (double)ang * 0.15915494309189535; const float fr = (float)(rev - __builtin_rint(rev));
    s = __builtin_amdgcn_sinf(fr); c = __builtin_amdgcn_cosf(fr);
}

__device__ __forceinline__ int hw_lane() { int l_; asm volatile("v_mbcnt_lo_u32_b32 %0, -1, 0\n\tv_mbcnt_hi_u32_b32 %0, -1, %0" : "=v"(l_)); return l_; }
__device__ __forceinline__ int hw_tid(int wave0) { return (wave0 << 6) | hw_lane(); }

namespace pg8 {
#define PG8_LAS __attribute__((address_space(3)))
typedef unsigned short bf16_t;
typedef short bf16x8 __attribute__((ext_vector_type(8)));
typedef float f32x4 __attribute__((ext_vector_type(4)));
typedef unsigned u32x4 __attribute__((ext_vector_type(4))); typedef unsigned u32x2 __attribute__((ext_vector_type(2))); typedef int i32x4 __attribute__((ext_vector_type(4))); typedef int i32x8 __attribute__((ext_vector_type(8)));
constexpr int BM = 256, BK = 64, HALF = 128, HTB = HALF * BK * 2  , STAGE_BYTES = 8 * HTB, NXCD = 8, WGM = 8;

__host__ __device__ __forceinline__ int lds_byte(int r, int c) { const int st = (r >> 4) * 2 + (c >> 5), rr = r & 15, cc = c & 31, ob = rr * 64 + cc * 2; return st * 1024 + (ob ^ (((ob >> 9) & 1) << 5)); }
__host__ __device__ __forceinline__ void stage_rc(int b, int& R, int& C) { const int st = b / 1024, sb = b % 1024, swz = sb ^ (((sb >> 9) & 1) << 5); R = (st >> 1) * 16 + swz / 64; C = (st & 1) * 32 + (swz % 64) / 2; }
__host__ __device__ __forceinline__ unsigned tiled_off(int r, int c, int kc) { return ((unsigned)((r >> 4) * (kc >> 5) + (c >> 5)) << 10) + (unsigned)((r & 15) * 64 + (c & 31) * 2); }
__host__ __device__ __forceinline__ int perm32(int rho) { const int n = rho >> 4, i = rho & 15; return 8 * (i >> 2) + 4 * n + (i & 3); }

struct Unit { int pm, pn; };
struct Gemm { const bf16_t* A; const bf16_t* Bt; int M, N, K; };

struct StaticOrder {
    int nM, nN, nwg, G, c;
    __host__ __device__ void init(int M, int N, int G_, int c_) { nM = M / BM; nN = N / BM; nwg = nM * nN; G = G_; c = c_; }
    __host__ __device__ bool next(int i, Unit& u) const {
        const long L = (long)i * G + c; if (L >= nwg) return false;
        int wgid = (int)L; { const int q = nwg / NXCD, r = nwg % NXCD, xcd = wgid % NXCD, off = wgid / NXCD; wgid = (xcd < r ? xcd * (q + 1) : r * (q + 1) + (xcd - r) * q) + off; }
        const int nig = WGM * nN, gid = wgid / nig, fm = gid * WGM, gsz = (nM - fm) < WGM ? (nM - fm) : WGM;
        u.pm = fm + ((wgid % nig) % gsz); u.pn = (wgid % nig) / gsz; return true;
    }
    __device__ __forceinline__ void a_ready(const Unit&) const {}
    __device__ __forceinline__ void done(const Unit&) const {}
};

__device__ __forceinline__ unsigned cvt_pk_bf16(float lo, float hi) { unsigned r; asm volatile("v_cvt_pk_bf16_f32 %0, %1, %2" : "=v"(r) : "v"(lo), "v"(hi)); return r; }
template <int ACT  , bool RS  , bool OTILED = false  ,
          bool O8 = false  , bool DOWN = false  > struct EpiBf16 {
    static constexpr bool PERM = true, AFTER_DRAIN = false; static_assert(ACT == 0 || ACT == 2, "EpiBf16: ACT is 0 (none) or 2 (squared relu)"); static_assert(!O8 || OTILED, "fp8 output is tiled");
    bf16_t* O; int ldc; const float* rscale;
    struct State { float rs[2][4]; };
    __device__ __forceinline__ void load(State& st, const Unit& u, int wr, int fr) const {
        if constexpr (RS) { const int row0 = u.pm * BM + wr * 64 + fr;
#pragma unroll
            for (int ai = 0; ai < 2; ++ai)
#pragma unroll
                for (int m = 0; m < 4; ++m) st.rs[ai][m] = rscale[row0 + ai * HALF + m * 16]; }
    }
    __device__ __forceinline__ void operator()(const f32x4 (&acc)[2][2][4][2], const Unit& u, int wr, int wc, int fr, int fq, const State& st) const {
        const int row0 = u.pm * BM + wr * 64 + fr; const int col0 = u.pn * BM + wc * 32 + 8 * fq;
#pragma unroll
        for (int ai = 0; ai < 2; ++ai)
#pragma unroll
            for (int m = 0; m < 4; ++m) { bf16_t* rowp = O8 ? (bf16_t*)((char*)O + tiled_off(row0 + ai * HALF + m * 16, col0 >> 1, ldc >> 1)) : OTILED ? (bf16_t*)((char*)O + tiled_off(row0 + ai * HALF + m * 16, col0, ldc)) : O + (size_t)(row0 + ai * HALF + m * 16) * ldc + col0;
#pragma unroll
                for (int bj = 0; bj < 2; ++bj) { f32x4 v0 = acc[ai][bj][m][0], v1 = acc[ai][bj][m][1];
                    if constexpr (RS) { v0 = v0 * st.rs[ai][m]; v1 = v1 * st.rs[ai][m]; }
                    if constexpr (DOWN) { v0 = v0 * 0.00390625f; v1 = v1 * 0.00390625f; }
                    if (ACT == 2) { const f32x4 z4 = (f32x4){0.f, 0.f, 0.f, 0.f}; v0 = __builtin_elementwise_max(v0, z4); v1 = __builtin_elementwise_max(v1, z4); v0 = v0 * v0; v1 = v1 * v1; }
                    if constexpr (O8) { const f32x4 c4 = (f32x4){448.f, 448.f, 448.f, 448.f}; v0 = __builtin_elementwise_min(v0, c4); v1 = __builtin_elementwise_min(v1, c4);
                        int w0 = 0, w1 = 0; w0 = __builtin_amdgcn_cvt_pk_fp8_f32(v0[0], v0[1], w0, false); w0 = __builtin_amdgcn_cvt_pk_fp8_f32(v0[2], v0[3], w0, true); w1 = __builtin_amdgcn_cvt_pk_fp8_f32(v1[0], v1[1], w1, false); w1 = __builtin_amdgcn_cvt_pk_fp8_f32(v1[2], v1[3], w1, true);
                        u32x2 w; w.x = (unsigned)w0; w.y = (unsigned)w1; *(u32x2*)((char*)rowp + bj * 2048) = w; }
                    else { u32x4 w; w.x = cvt_pk_bf16(v0[0], v0[1]); w.y = cvt_pk_bf16(v0[2], v0[3]); w.z = cvt_pk_bf16(v1[0], v1[1]); w.w = cvt_pk_bf16(v1[2], v1[3]);
                        *(u32x4*)(rowp + (OTILED ? bj * (HALF / 32) * 512 : bj * HALF)) = w; } } }
    }
};

struct EpiIn {
    static constexpr bool PERM = true, AFTER_DRAIN = false;
    bf16_t* O; int ldc; const float* rscale;
    struct State { float rs[2][4]; };
    __device__ __forceinline__ void load(State& st, const Unit& u, int wr, int fr) const {
        const int row0 = u.pm * BM + wr * 64 + fr;
#pragma unroll
        for (int ai = 0; ai < 2; ++ai)
#pragma unroll
            for (int m = 0; m < 4; ++m) st.rs[ai][m] = rscale[row0 + ai * HALF + m * 16];
    }
    __device__ __forceinline__ void operator()(const f32x4 (&acc)[2][2][4][2], const Unit& u, int wr, int wc, int fr, int fq, const State& st) const {
        const int row0 = u.pm * BM + wr * 64 + fr, pn = u.pn;
        const int kind = (pn >= 2 && pn < 6) ? 1 : (pn >= 12 ? 2 : 0);
        const int colb = pn < 2 ? 256 * pn : (pn < 6 ? 512 + 128 * (pn - 2) : (pn < 12 ? 1024 + 256 * (pn - 6) : 2560 + 128 * (pn - 12)));
        const int col0 = colb + wc * 32 + 8 * fq;
        if (kind == 0) {
#pragma unroll
            for (int ai = 0; ai < 2; ++ai)
#pragma unroll
                for (int m = 0; m < 4; ++m) { bf16_t* rowp = O + (size_t)(row0 + ai * HALF + m * 16) * ldc + col0;
#pragma unroll
                    for (int bj = 0; bj < 2; ++bj) { const f32x4 v0 = acc[ai][bj][m][0] * st.rs[ai][m], v1 = acc[ai][bj][m][1] * st.rs[ai][m];
                        u32x4 w; w.x = cvt_pk_bf16(v0[0], v0[1]); w.y = cvt_pk_bf16(v0[2], v0[3]); w.z = cvt_pk_bf16(v1[0], v1[1]); w.w = cvt_pk_bf16(v1[2], v1[3]);
                        *(u32x4*)(rowp + bj * HALF) = w; } }
        } else {
#pragma unroll
            for (int ai = 0; ai < 2; ++ai)
#pragma unroll
                for (int m = 0; m < 4; ++m) { bf16_t* rowp = O + (size_t)(row0 + ai * HALF + m * 16) * ldc + col0; float o[8];
#pragma unroll
                    for (int n = 0; n < 2; ++n)
#pragma unroll
                        for (int e = 0; e < 4; ++e) { const float a = acc[ai][0][m][n][e] * st.rs[ai][m], b = acc[ai][1][m][n][e] * st.rs[ai][m];
                            o[4 * n + e] = kind == 1 ? a * b : a * __builtin_amdgcn_rcpf(1.0f + __expf(-b)); }
                    u32x4 w; w.x = cvt_pk_bf16(o[0], o[1]); w.y = cvt_pk_bf16(o[2], o[3]); w.z = cvt_pk_bf16(o[4], o[5]); w.w = cvt_pk_bf16(o[6], o[7]);
                    *(u32x4*)rowp = w; }
        }
    }
};

template <class Epi, class Sched, bool ALIGN_EPI = false, bool SP2 = false, bool ATILED = false, bool F8 = false>
__device__ __forceinline__ void gemm_phase(PG8_LAS unsigned char* lds, const Gemm g, const Sched& S, const Epi& E, const int wave0) {
    int tid_ = hw_tid(wave0); asm volatile("" : "+v"(tid_));
    const int tid = tid_, wid = __builtin_amdgcn_readfirstlane(tid >> 6), lane = tid & 63, wr = wid >> 2, wc = wid & 3, fr = lane & 15, fq = lane >> 4;
    const int K = g.K, nt = K / BK;
    unsigned voffA[2], voffB[2];
#pragma unroll
    for (int i = 0; i < 2; ++i) { int R, C; stage_rc(tid * 16 + i * 8192, R, C); static_assert(Epi::PERM, "the tiled weight copies are stored in PERM row order");
        voffA[i] = ATILED ? tiled_off(R, C, K) : (unsigned)(R * K + C) * 2u; voffB[i] = tiled_off(R, C, K); }
    const size_t kstepA = ATILED ? 2048 : (size_t)(BK * 2), kstepB = 2048;
    const size_t hstep = (size_t)HALF * K * 2;
    const size_t tstep = 2 * hstep;
    const unsigned ldsw = (unsigned)wid * 1024u;
    const unsigned ldsb = (unsigned)__builtin_amdgcn_readfirstlane((int)((unsigned)(__UINTPTR_TYPE__)lds + ldsw));
    const int aoff = lds_byte(wr * 64 + fr, fq * 8), boff = lds_byte(wc * 32 + fr, fq * 8);
#define PG8_SA(b, h) (((b) * 2 + (h)) * HTB)
#define PG8_SB(b, h) ((4 + (b) * 2 + (h)) * HTB)
#define PG8_STAGE(bufoff, gbase, voff) do { _Pragma("unroll") for (int _i = 0; _i < 2; ++_i) { \
        if constexpr (F8) { unsigned keep_; asm volatile("s_mov_b32 %0, m0\n\ts_mov_b32 m0, %3\n\ts_nop 0\n\tglobal_load_lds_dwordx4 %1, %2\n\ts_mov_b32 m0, %0" : "=&s"(keep_) : "v"((voff)[_i]), "s"((const char*)(gbase)), "s"(ldsb + (unsigned)((bufoff) + _i * 8192)) : "memory"); } \
        else __builtin_amdgcn_global_load_lds((const unsigned*)((const char*)(gbase) + (voff)[_i]), (PG8_LAS unsigned*)(lds + (bufoff) + ldsw + _i * 8192), 16, 0, 0); } } while (0)
#define PG8_LDA(dst, b, h) do { _Pragma("unroll") for (int m = 0; m < 4; ++m) _Pragma("unroll") for (int k = 0; k < 2; ++k) dst[m][k] = *(const PG8_LAS bf16x8*)(lds + PG8_SA(b, h) + aoff + m * 2048 + k * 1024); } while (0)
#define PG8_LDB(dst, b, h) do { _Pragma("unroll") for (int n = 0; n < 2; ++n) _Pragma("unroll") for (int k = 0; k < 2; ++k) dst[n][k] = *(const PG8_LAS bf16x8*)(lds + PG8_SB(b, h) + boff + n * 2048 + k * 1024); } while (0)
#define PG8_CAT(x) __builtin_shufflevector(__builtin_bit_cast(i32x4, (x)[0]), __builtin_bit_cast(i32x4, (x)[1]), 0, 1, 2, 3, 4, 5, 6, 7)
#define PG8_MMA(ai, bj, At, Bt) do { __builtin_amdgcn_s_setprio(1); _Pragma("unroll") for (int m = 0; m < 4; ++m) _Pragma("unroll") for (int n = 0; n < 2; ++n) { \
        if constexpr (F8) acc[ai][bj][m][n] = __builtin_amdgcn_mfma_scale_f32_16x16x128_f8f6f4(PG8_CAT(Bt[n]), PG8_CAT(At[m]), acc[ai][bj][m][n], 0, 0, 0, 0, 0, 0); \
        else { _Pragma("unroll") for (int k = 0; k < 2; ++k) acc[ai][bj][m][n] = __builtin_amdgcn_mfma_f32_16x16x32_bf16(Bt[n][k], At[m][k], acc[ai][bj][m][n], 0, 0, 0); } } __builtin_amdgcn_s_setprio(0); } while (0)
#define PG8_WAIT_V(n) asm volatile("s_waitcnt vmcnt(" #n ")" ::: "memory")
#define PG8_WAIT_L(n) asm volatile("s_waitcnt lgkmcnt(" #n ")" ::: "memory")
#define PG8_BAR __builtin_amdgcn_s_barrier()
#define PG8_SCHED __builtin_amdgcn_sched_barrier(0)
    Unit cur, nxt; int ui = 0;
    if (!S.next(0, cur)) return;
    typename Epi::State est; E.load(est, cur, wr, fr);
    f32x4 acc[2][2][4][2];
#pragma unroll
    for (int a = 0; a < 2; ++a)
#pragma unroll
        for (int b = 0; b < 2; ++b)
#pragma unroll
            for (int m = 0; m < 4; ++m)
#pragma unroll
                for (int n = 0; n < 2; ++n) acc[a][b][m][n] = (f32x4){0.f, 0.f, 0.f, 0.f};
    bf16x8 At[4][2], B0[2][2], B1[2][2];
    const char* cA = (const char*)g.A + (size_t)cur.pm * tstep; const char* cB = (const char*)g.Bt + (size_t)cur.pn * tstep;
    S.a_ready(cur);
    if constexpr (SP2) {
        PG8_STAGE(PG8_SB(0, 0), cB, voffB); PG8_STAGE(PG8_SB(0, 1), cB + hstep, voffB); PG8_STAGE(PG8_SA(0, 0), cA, voffA); PG8_STAGE(PG8_SA(0, 1), cA + hstep, voffA);
        if (wr == 1) PG8_BAR;
        PG8_WAIT_V(2); PG8_BAR;
        PG8_STAGE(PG8_SB(1, 0), cB + kstepB, voffB); PG8_STAGE(PG8_SB(1, 1), cB + hstep + kstepB, voffB);
        PG8_WAIT_V(4); PG8_BAR;
    } else {
        PG8_STAGE(PG8_SB(0, 0), cB, voffB); PG8_STAGE(PG8_SA(0, 0), cA, voffA); PG8_STAGE(PG8_SB(0, 1), cB + hstep, voffB); PG8_STAGE(PG8_SA(0, 1), cA + hstep, voffA);
        if (wr == 1) PG8_BAR;
        PG8_WAIT_V(4); PG8_BAR;
        PG8_STAGE(PG8_SB(1, 0), cB + kstepB, voffB); PG8_STAGE(PG8_SA(1, 0), cA + kstepA, voffA); PG8_STAGE(PG8_SB(1, 1), cB + hstep + kstepB, voffB);
        PG8_WAIT_V(6); PG8_BAR;
    }
    for (;;) {
        const bool has_next = S.next(ui + 1, nxt);
        const char* nA = has_next ? (const char*)g.A + (size_t)nxt.pm * tstep : cA; const char* nB = has_next ? (const char*)g.Bt + (size_t)nxt.pn * tstep : cB;
        for (int t = 0; t < nt; t += 2) {
            const bool last = (t == nt - 2);
            const char* a1 = cA + (size_t)(t + 1) * kstepA;
            const char* a2 = last ? nA : cA + (size_t)(t + 2) * kstepA; const char* b2 = last ? nB : cB + (size_t)(t + 2) * kstepB;
            const char* a3 = a2 + kstepA; const char* b3 = b2 + kstepB;
            if (last && has_next) S.a_ready(nxt);
            if constexpr (SP2) {
            PG8_LDB(B0, 0, 0); PG8_LDB(B1, 0, 1); PG8_SCHED; PG8_LDA(At, 0, 0); PG8_STAGE(PG8_SA(1, 0), a1, voffA); PG8_STAGE(PG8_SA(1, 1), a1 + hstep, voffA);
            PG8_WAIT_V(8); PG8_WAIT_L(0); PG8_BAR; PG8_MMA(0, 0, At, B0); PG8_MMA(0, 1, At, B1); PG8_BAR; PG8_SCHED;
            PG8_LDA(At, 0, 1); PG8_STAGE(PG8_SB(0, 0), b2, voffB); PG8_STAGE(PG8_SB(0, 1), b2 + hstep, voffB);
            PG8_WAIT_V(6); PG8_WAIT_L(0); PG8_BAR; PG8_MMA(1, 0, At, B0); PG8_MMA(1, 1, At, B1); PG8_BAR; PG8_SCHED;
            PG8_LDB(B0, 1, 0); PG8_LDB(B1, 1, 1); PG8_SCHED; PG8_LDA(At, 1, 0); PG8_STAGE(PG8_SA(0, 0), a2, voffA); PG8_STAGE(PG8_SA(0, 1), a2 + hstep, voffA);
            PG8_WAIT_V(8); PG8_WAIT_L(0); PG8_BAR; PG8_MMA(0, 0, At, B0); PG8_MMA(0, 1, At, B1); PG8_BAR; PG8_SCHED;
            PG8_LDA(At, 1, 1); PG8_STAGE(PG8_SB(1, 0), b3, voffB); PG8_STAGE(PG8_SB(1, 1), b3 + hstep, voffB);
            PG8_WAIT_V(6); PG8_WAIT_L(0); PG8_BAR; PG8_MMA(1, 0, At, B0); PG8_MMA(1, 1, At, B1); PG8_BAR; PG8_SCHED;
            } else {
            PG8_LDB(B0, 0, 0); PG8_SCHED; PG8_LDA(At, 0, 0); PG8_STAGE(PG8_SA(1, 1), a1 + hstep, voffA);
            PG8_WAIT_L(8); PG8_BAR; PG8_WAIT_L(0); PG8_MMA(0, 0, At, B0); PG8_BAR; PG8_SCHED;
            PG8_LDB(B1, 0, 1); PG8_STAGE(PG8_SB(0, 0), b2, voffB);
            PG8_BAR; PG8_WAIT_L(0); PG8_MMA(0, 1, At, B1); PG8_BAR;
            PG8_LDA(At, 0, 1); PG8_STAGE(PG8_SA(0, 0), a2, voffA);
            PG8_BAR; PG8_WAIT_L(0); PG8_MMA(1, 0, At, B0); PG8_BAR; PG8_SCHED;
            PG8_STAGE(PG8_SB(0, 1), b2 + hstep, voffB);
            PG8_WAIT_V(6); PG8_BAR; PG8_MMA(1, 1, At, B1); PG8_BAR;
            PG8_LDB(B0, 1, 0); PG8_SCHED; PG8_LDA(At, 1, 0); PG8_STAGE(PG8_SA(0, 1), a2 + hstep, voffA);
            PG8_WAIT_L(8); PG8_BAR; PG8_WAIT_L(0); PG8_MMA(0, 0, At, B0); PG8_BAR; PG8_SCHED;
            PG8_LDB(B1, 1, 1); PG8_STAGE(PG8_SB(1, 0), b3, voffB);
            PG8_BAR; PG8_WAIT_L(0); PG8_MMA(0, 1, At, B1); PG8_BAR;
            PG8_LDA(At, 1, 1); PG8_STAGE(PG8_SA(1, 0), a3, voffA);
            PG8_BAR; PG8_WAIT_L(0); PG8_MMA(1, 0, At, B0); PG8_BAR; PG8_SCHED;
            PG8_STAGE(PG8_SB(1, 1), b3 + hstep, voffB);
            PG8_WAIT_V(6); PG8_BAR; PG8_MMA(1, 1, At, B1); PG8_BAR;
            }
        }
        if constexpr (ALIGN_EPI) { if (wr == 0) PG8_BAR; }
        if constexpr (!Epi::AFTER_DRAIN) { E(acc, cur, wr, wc, fr, fq, est); S.done(cur); }
        if (!has_next) break;
        E.load(est, nxt, wr, fr);
#pragma unroll
        for (int a = 0; a < 2; ++a)
#pragma unroll
            for (int b = 0; b < 2; ++b)
#pragma unroll
                for (int m = 0; m < 4; ++m)
#pragma unroll
                    for (int n = 0; n < 2; ++n) acc[a][b][m][n] = (f32x4){0.f, 0.f, 0.f, 0.f};
        cur = nxt; cA = nA; cB = nB; ++ui;
        if constexpr (ALIGN_EPI) { if (wr == 1) PG8_BAR; }
    }
    PG8_WAIT_V(0);
    if constexpr (!ALIGN_EPI) { if (wr == 0) PG8_BAR; }
    PG8_BAR;
    if constexpr (Epi::AFTER_DRAIN) { E.fused(acc, cur, wr, wc, fr, fq, lds, wid, lane); S.done(cur); }
#undef PG8_SA
#undef PG8_SB
#undef PG8_STAGE
#undef PG8_LDA
#undef PG8_LDB
#undef PG8_MMA
#undef PG8_CAT
#undef PG8_WAIT_V
#undef PG8_WAIT_L
#undef PG8_BAR
#undef PG8_SCHED
}
}

namespace attn_body {
using bf16=__hip_bfloat16;
using bf16x8=__attribute__((ext_vector_type(8)))short;
using s16x4=__attribute__((ext_vector_type(4)))short;
using f32x16=__attribute__((ext_vector_type(16)))float;
using u32x4=__attribute__((ext_vector_type(4)))unsigned;
constexpr int D=64,ZP=3072,OP=2048;
constexpr int NW=8,QBLK=32,QB=QBLK*NW,KVBLK=64;
constexpr int ATTN_UNIT_ROWS=QB;
__device__ __forceinline__ int crow(int r,int hi){return (r&3)+8*(r>>2)+4*hi;}
#define SBAR() __builtin_amdgcn_sched_barrier(0)
template<int MODE> __device__ __forceinline__ int trow(int t,int q0,int S){
  if constexpr(MODE!=1){ return 64*t; }
  else { const int j=(t+3)&7; const int kpos=q0-128+64*j; return (kpos>=0&&kpos<S)?kpos:(q0+64); }
}
template<int MODE> __device__ __forceinline__ void tmask(f32x16&p0,f32x16&p1,int t,int qrel,int hi,int q0,int S){
  if constexpr(MODE==1){
    const float NEG=-INFINITY; const int j=(t+3)&7; const int krel0=-128+64*j; const int kpos=q0+krel0;
    const int base=(kpos>=0&&kpos<S)?(krel0+4*hi-qrel+128):100000;
    #pragma unroll
    for(int r=0;r<16;++r){const int kv=base+(r&3)+8*(r>>2); if((unsigned)kv>256u)p0[r]=NEG; if((unsigned)(kv+32)>256u)p1[r]=NEG;}
  }
}

constexpr int NSLOT=6, SLOTB=4096;
constexpr int LDS_K=0, LDS_V=NSLOT*SLOTB, LDS_WS=2*NSLOT*SLOTB, LDS_OST=LDS_WS+NW*64*4, LDS_BYTES=LDS_OST+NW*4096;
constexpr float C2=0.125f*1.4426950408889634f;
__device__ __forceinline__ void glds16(const void*gsrc,unsigned lds_dst){unsigned keep;
  asm volatile("s_mov_b32 %0, m0\n\ts_mov_b32 m0, %2\n\ts_nop 0\n\tglobal_load_lds_dwordx4 %1, off\n\ts_mov_b32 m0, %0":"=&s"(keep):"v"(gsrc),"s"(lds_dst):"memory");}
__device__ __forceinline__ float max3f(float a,float b,float c){float r;asm("v_max3_f32 %0, %1, %2, %3":"=v"(r):"v"(a),"v"(b),"v"(c));return r;}
__device__ __forceinline__ float max2f(float a,float b){float r;asm("v_max_f32_e32 %0, %1, %2":"=v"(r):"v"(a),"v"(b));return r;}
__device__ __forceinline__ float fadd_s(float a,float b){float r;asm("v_add_f32_e32 %0, %1, %2":"=v"(r):"v"(a),"v"(b));return r;}
__device__ __forceinline__ float fsub_s(float a,float b){float r;asm("v_sub_f32_e32 %0, %1, %2":"=v"(r):"v"(a),"v"(b));return r;}
typedef float f32x2_t __attribute__((ext_vector_type(2))); typedef __bf16 bf16x2_t __attribute__((ext_vector_type(2)));
__device__ __forceinline__ unsigned cvtpk_s(float lo,float hi){f32x2_t v={lo,hi};bf16x2_t b=__builtin_convertvector(v,bf16x2_t);return __builtin_bit_cast(unsigned,b);}
#define WAIT_BAR(N) asm volatile("s_waitcnt vmcnt(" #N ") lgkmcnt(0)\n\ts_barrier":::"memory")
#define WAIT_BAR2W() WAIT_BAR(2)
static_assert(NSLOT==6,"ring protocol literals");

typedef int v8i_t __attribute__((ext_vector_type(8))); typedef int v4i_t __attribute__((ext_vector_type(4)));
typedef __attribute__((address_space(3))) const char* lds_cptr;
typedef short v4i16_t __attribute__((ext_vector_type(4))); typedef float f32x4d_t __attribute__((ext_vector_type(4))); typedef short v2s16_t __attribute__((ext_vector_type(2)));
#define FP8_SC 0
__device__ __forceinline__ v8i_t kfrag(lds_cptr kp){ const v4i_t lo=*(const __attribute__((address_space(3))) v4i_t*)(kp), hi=*(const __attribute__((address_space(3))) v4i_t*)(kp+1024); return __builtin_shufflevector(lo,hi,0,1,2,3,4,5,6,7); }
#define QK8(KF,QF,C) __builtin_amdgcn_mfma_scale_f32_32x32x64_f8f6f4((KF),(QF),(C),0,0,0,FP8_SC,0,FP8_SC)
__device__ __forceinline__ void qkt(f32x16&p0,f32x16&p1,lds_cptr Kslot,const v8i_t qf,const f32x16&negm,int r32,int hi){
  const lds_cptr kb=Kslot+hi*2048+r32*16;
  p0=QK8(kfrag(kb),qf,negm); p1=QK8(kfrag(kb+512),qf,negm);
}
__device__ __forceinline__ s16x4 vtr(lds_cptr p){ return __builtin_bit_cast(s16x4,__builtin_amdgcn_ds_read_tr16_b64_v4i16((__attribute__((address_space(3))) v4i16_t*)p)); }
__device__ __forceinline__ float rowmax(const f32x16&p0,const f32x16&p1){
  float a=max3f(p0[0],p0[1],p1[0]),b=max3f(p0[2],p0[3],p1[1]);a=max3f(a,p1[2],p1[3]);
  #pragma unroll
  for(int r=4;r<16;r+=4){a=max3f(a,p0[r],p0[r+1]);b=max3f(b,p0[r+2],p0[r+3]);a=max3f(a,p1[r],p1[r+1]);b=max3f(b,p1[r+2],p1[r+3]);}
  const float m=max2f(a,b);
  auto rr=__builtin_amdgcn_permlane32_swap(__float_as_uint(m),__float_as_uint(m),false,false);
  return max2f(__uint_as_float(rr[0]),__uint_as_float(rr[1]));
}
__device__ __forceinline__ void pv(f32x16*o,int vb,bf16x8 pa0,bf16x8 pa1,bf16x8 pa2,bf16x8 pa3){
  #pragma unroll
  for(int d0=0;d0<2;++d0){s16x4 lo[4],hi[4];
    #pragma unroll
    for(int ks=0;ks<4;++ks){
      asm volatile("ds_read_b64_tr_b16 %0,%1 offset:%c2":"=&v"(lo[ks]):"v"(vb),"i"(d0*4096+ks*1024):"memory");
      asm volatile("ds_read_b64_tr_b16 %0,%1 offset:%c2":"=&v"(hi[ks]):"v"(vb),"i"(d0*4096+ks*1024+512):"memory");}
    asm volatile("s_waitcnt lgkmcnt(0)":::"memory");SBAR();
    #define PK(k) (bf16x8){lo[k][0],lo[k][1],lo[k][2],lo[k][3],hi[k][0],hi[k][1],hi[k][2],hi[k][3]}
    o[d0]=__builtin_amdgcn_mfma_f32_32x32x16_bf16(pa0,PK(0),o[d0],0,0,0);
    o[d0]=__builtin_amdgcn_mfma_f32_32x32x16_bf16(pa1,PK(1),o[d0],0,0,0);
    o[d0]=__builtin_amdgcn_mfma_f32_32x32x16_bf16(pa2,PK(2),o[d0],0,0,0);
    o[d0]=__builtin_amdgcn_mfma_f32_32x32x16_bf16(pa3,PK(3),o[d0],0,0,0);
    #undef PK
  }
}

template<int QT> __device__ __forceinline__ v8i_t q_transform(const bf16x8 (&qr)[4],const int t,const int hi,const float*gq){
  float x[4][8];
  #pragma unroll
  for(int d0=0;d0<4;++d0)
    #pragma unroll
    for(int e=0;e<8;++e)x[d0][e]=__uint_as_float(((unsigned)(unsigned short)qr[d0][e])<<16);
  if constexpr(QT==1){
    float ss=0.f;
    #pragma unroll
    for(int d0=0;d0<4;++d0)
      #pragma unroll
      for(int e=0;e<8;++e)ss+=x[d0][e]*x[d0][e];
    {auto rr=__builtin_amdgcn_permlane32_swap(__float_as_uint(ss),__float_as_uint(ss),false,false);ss=__uint_as_float(rr[0])+__uint_as_float(rr[1]);}
    const float r=rsqrtf(ss*(1.0f/64.0f)+1e-6f);
    #pragma unroll
    for(int d0=0;d0<4;++d0)
      #pragma unroll
      for(int e=0;e<8;++e)x[d0][e]=x[d0][e]*r*gq[16*d0+8*hi+e];
    const int pr=t>>6,pc=t&63;
    #pragma unroll
    for(int e=0;e<8;++e){ const float f=INVF[2*(8*hi+e)]; float sn,cs;
      sincos_f((float)pr*f,sn,cs); { const float a=x[0][e],b=x[1][e]; x[0][e]=a*cs-b*sn; x[1][e]=b*cs+a*sn; }
      sincos_f((float)pc*f,sn,cs); { const float a=x[2][e],b=x[3][e]; x[2][e]=a*cs-b*sn; x[3][e]=b*cs+a*sn; } }
  } else {
    #pragma unroll
    for(int e=0;e<8;++e){ float sn,cs;
      sincos_f((float)t*INVF[8*hi+e],sn,cs);    { const float a=x[0][e],b=x[2][e]; x[0][e]=a*cs-b*sn; x[2][e]=b*cs+a*sn; }
      sincos_f((float)t*INVF[16+8*hi+e],sn,cs); { const float a=x[1][e],b=x[3][e]; x[1][e]=a*cs-b*sn; x[3][e]=b*cs+a*sn; } }
  }
  v8i_t qf;
  #pragma unroll
  for(int d0=0;d0<4;++d0){ int w0=0,w1=0;
    w0=__builtin_amdgcn_cvt_pk_fp8_f32(x[d0][0]*C2,x[d0][1]*C2,w0,false); w0=__builtin_amdgcn_cvt_pk_fp8_f32(x[d0][2]*C2,x[d0][3]*C2,w0,true);
    w1=__builtin_amdgcn_cvt_pk_fp8_f32(x[d0][4]*C2,x[d0][5]*C2,w1,false); w1=__builtin_amdgcn_cvt_pk_fp8_f32(x[d0][6]*C2,x[d0][7]*C2,w1,true);
    qf[2*d0]=w0; qf[2*d0+1]=w1; }
  return qf;
}
#ifndef ATTN_STORE16
#define ATTN_STORE16(p,v) (*(u32x4*)(p)=(v))
#endif
template<int MODE,int THRL,int QT> __device__ __forceinline__ void attn_unit(const bf16*Qu,const char*__restrict__ Kt,const char*__restrict__ Vt,bf16*Ou,const int NT,const int q0,const int S,const float sink2,const int tq0,const float*gq,char*shm,const int wave0){
  int tid_=hw_tid(wave0); asm volatile("":"+v"(tid_)); const int tid=tid_,lane=tid&63,r32=lane&31,hi=lane>>5; const int wid=__builtin_amdgcn_readfirstlane(tid>>6);
  const bf16*Qw=Qu+(long)(wid*QBLK)*ZP;
  const unsigned lds0=(unsigned)(uintptr_t)shm;
  float*wsf=(float*)(shm+LDS_WS)+wid*64;
  const bool kw=wid<4; const char*psrc=(kw?Kt+wid*1024:Vt+(wid&3)*1024)+lane*16; const unsigned pdst=lds0+(kw?LDS_K+wid*1024:LDS_V+(wid&3)*1024);
  #define DMA_P(t,slot) glds16(psrc+((long)(trow<MODE>((t),q0,S)>>6)<<12),(unsigned)__builtin_amdgcn_readfirstlane(pdst+(slot)))
  #define DMA_K(t,slot) if(kw) DMA_P(t,slot)
  #define DMA_V(t,slot) if(!kw) DMA_P(t,slot)
  #define DMA_STEP(t,GK,GV) do{ if(kw?(GK):(GV)){ const int tt_=(t)+(kw?5:3); const int sl_=kw?sl_prev:sl_v; DMA_P(tt_,sl_); } }while(0)
  v8i_t kf[2];
  const lds_cptr shm3=(lds_cptr)shm; const lds_cptr kp0=shm3+LDS_K+hi*2048+r32*16; const lds_cptr vp0=shm3+LDS_V+hi*2048+r32*16;
  bf16x8 qr[4];
  #pragma unroll
  for(int d0=0;d0<4;++d0)qr[d0]=*reinterpret_cast<const bf16x8*>(&Qw[(long)r32*ZP+d0*16+hi*8]);
  #pragma unroll
  for(int i=0;i<5;++i){ DMA_K(i,i*SLOTB); if(i<3){ DMA_V(i,i*SLOTB); } }
  const v8i_t qf=q_transform<QT>(qr,tq0+wid*QBLK+r32,hi,gq);
  float mhat=0.f;f32x16 o[2];o[0]=f32x16{};o[1]=f32x16{};f32x4d_t o2={0.f,0.f,0.f,0.f};
  v8i_t ones; { const int sel_=((((lane>>4)&1)==0)==((lane&15)<8))?0x38383838:0; _Pragma("unroll") for(int i=0;i<8;++i)ones[i]=sel_; } asm volatile("":"+v"(ones));
  const int l2row=4*(lane>>4)+(((lane&15)>=8)?16:0);
  #define SUM8(A,C) __builtin_amdgcn_mfma_scale_f32_16x16x128_f8f6f4((A),ones,(C),1,0,0,FP8_SC,0,FP8_SC)
  f32x16 negm=f32x16{};if constexpr(MODE!=2){asm volatile("":"+v"(negm));}
  const float pscl=(MODE==2)?sink2:1.0f;
  const int qrel=wid*QBLK+r32;
  #define CMASK(P0,P1,t) tmask<MODE>(P0,P1,(t),qrel,hi,q0,S)
  bool resc=false;
  #define START(P0,P1) do{ resc=false; if constexpr(MODE!=2) \
    { const float rm=rowmax(P0,P1); const float dl=rm; mhat=fadd_s(mhat,dl); \
      _Pragma("unroll") for(int r=0;r<16;++r){P0[r]=fsub_s(P0[r],dl);P1[r]=fsub_s(P1[r],dl);} \
      _Pragma("unroll") for(int r=0;r<16;++r)negm[r]=-mhat; asm volatile("":"+v"(negm)); } \
    _Pragma("unroll") for(int r=0;r<16;++r)P0[r]=__builtin_amdgcn_exp2f(P0[r]); }while(0)
  #define RESC() do{ if constexpr(MODE!=2) if(resc){ asm volatile("s_waitcnt lgkmcnt(0)":::"memory"); \
      _Pragma("unroll") for(int r=0;r<16;++r){ const float f_=wsf[crow(r,hi)]; o[0][r]*=f_; o[1][r]*=f_; } _Pragma("unroll") for(int e=0;e<4;++e)o2[e]*=wsf[l2row+e]; } }while(0)
  f32x16 pA0,pA1,pB0,pB1;
  int sl_prev=(NSLOT-1)*SLOTB,sl_cur=0,sl_next=SLOTB,sl_v=3*SLOTB;
  #define NXT(x) (((x)==(NSLOT-1)*SLOTB)?0:(x)+SLOTB)
  #define ROT() do{sl_prev=sl_cur;sl_cur=sl_next;sl_next=NXT(sl_next);sl_v=NXT(sl_v);}while(0)
  WAIT_BAR(4);
  qkt(pA0,pA1,shm3+LDS_K,qf,negm,r32,hi);asm volatile("s_nop 15\n\ts_nop 7":"+v"(pA0),"+v"(pA1));CMASK(pA0,pA1,0);
  START(pA0,pA1);
  _Pragma("unroll") for(int r=0;r<16;++r)pA1[r]=__builtin_amdgcn_exp2f(pA1[r]);
  DMA_P(kw?5:3,kw?5*SLOTB:3*SLOTB);
  WAIT_BAR(2);
  ROT();
  kf[0]=kfrag(kp0+sl_cur); kf[1]=kfrag(kp0+sl_cur+512);
  v8i_t vf[2], pa;
  #define PK8(P,B,W) do{ v2s16_t w2_=__builtin_bit_cast(v2s16_t,W); w2_=__builtin_amdgcn_cvt_scalef32_pk_bf8_f32(w2_,P[B],P[(B)+1],pscl,false); w2_=__builtin_amdgcn_cvt_scalef32_pk_bf8_f32(w2_,P[(B)+2],P[(B)+3],pscl,true); W=__builtin_bit_cast(int,w2_); }while(0)
  #define PV8(A,B,C) __builtin_amdgcn_mfma_scale_f32_32x32x64_f8f6f4((A),(B),(C),1,0,0,FP8_SC,0,FP8_SC)
  #define PIN(x) asm volatile("":"+v"(x))
  #define MX3(a,b,c) __builtin_fmaxf(__builtin_fmaxf((a),(b)),(c))
  #define EX(v) __builtin_amdgcn_exp2f(v)
  #define KRD(G,j) do{ if(G){ kf[(j)]=kfrag(kp0+sl_next+(j)*512); } }while(0)
  #define HALFA(P,J0) do{ _Pragma("unroll") for(int j_=0;j_<4;++j_){ int w_; asm volatile("":"=v"(w_)); PK8(P,4*j_,w_); pa[(J0)+j_]=w_; } }while(0)
  #define STEP(C0,C1,P0,P1,t,GK,GV,GL) do{ SBAR(); \
    { const lds_cptr vp_=vp0+sl_prev; vf[0]=kfrag(vp_); vf[1]=kfrag(vp_+512); } \
    PIN(kf[0]); C0=QK8(kf[0],qf,negm); PIN(C0); \
    PIN(P0); PIN(P1); HALFA(P0,0); HALFA(P1,4); PIN(pa); \
    PIN(kf[1]); C1=QK8(kf[1],qf,negm); PIN(C1); KRD(GL,0); KRD(GL,1);     \
    DMA_STEP(t,GK,GV); \
    CMASK(C0,C1,t); \
    if constexpr(MODE!=2){ float a=MX3(C0[0],C0[1],C1[0]),b=MX3(C0[2],C0[3],C1[1]); a=MX3(a,C1[2],C1[3]); \
      _Pragma("unroll") for(int r=4;r<16;r+=4){a=MX3(a,C0[r],C0[r+1]);b=MX3(b,C0[r+2],C0[r+3]);a=MX3(a,C1[r],C1[r+1]);b=MX3(b,C1[r+2],C1[r+3]);} \
      float rm=__builtin_fmaxf(a,b); { auto rr=__builtin_amdgcn_permlane32_swap(__float_as_uint(rm),__float_as_uint(rm),false,false); rm=__builtin_fmaxf(__uint_as_float(rr[0]),__uint_as_float(rr[1])); } \
      resc=false; \
      if(__builtin_expect(__any(rm>(float)THRL),0)){ const float dl=__builtin_fmaxf(rm,0.f); mhat+=dl; \
        _Pragma("unroll") for(int r=0;r<16;++r){C0[r]-=dl;C1[r]-=dl;} \
        _Pragma("unroll") for(int r=0;r<16;++r)negm[r]=-mhat; asm volatile("":"+v"(negm)); \
        const float f=__builtin_amdgcn_exp2f(-dl); if(hi==0)wsf[r32]=f; resc=true; } } \
    PIN(pa); o[0]=PV8(pa,vf[0],o[0]); PIN(o[0]); \
    PIN(C0); _Pragma("unroll") for(int r=0;r<11;++r)C0[r]=EX(C0[r]); PIN(C0); \
    PIN(pa); o[1]=PV8(pa,vf[1],o[1]); PIN(o[1]); \
    PIN(C0); PIN(C1); _Pragma("unroll") for(int r=11;r<16;++r)C0[r]=EX(C0[r]); _Pragma("unroll") for(int r=0;r<6;++r)C1[r]=EX(C1[r]); PIN(C0); PIN(C1); \
    PIN(pa); o2=SUM8(pa,o2); PIN(o2); \
    PIN(C1); _Pragma("unroll") for(int r=6;r<16;++r)C1[r]=EX(C1[r]); PIN(C1); \
    SBAR(); \
    }while(0)
  int t=1;
  for(;t+6<NT;t+=2){
    STEP(pB0,pB1,pA0,pA1,t,true,true,true);     RESC(); ROT();
    STEP(pA0,pA1,pB0,pB1,t+1,true,true,true);   WAIT_BAR2W(); RESC(); ROT();
  }
  #define ENDW(tt) do{ int n_=kw?(NT-4-(tt)):(NT-2-(tt)); n_=n_<0?0:(n_>2?2:n_); if(n_==0){WAIT_BAR(0);} else if(n_==1){WAIT_BAR(1);} else {WAIT_BAR(2);} }while(0)
  for(;t+1<NT;t+=2){
    STEP(pB0,pB1,pA0,pA1,t,(t+5<NT),(t+3<NT),(t+1<NT));       RESC(); ROT();
    STEP(pA0,pA1,pB0,pB1,t+1,(t+6<NT),(t+4<NT),(t+2<NT));     ENDW(t+1); RESC(); ROT();
  }
  STEP(pB0,pB1,pA0,pA1,NT-1,false,false,false); RESC();
  { HALFA(pB0,0); HALFA(pB1,4);
    { const lds_cptr vp_=vp0+sl_cur; vf[0]=kfrag(vp_); vf[1]=kfrag(vp_+512); }
    o[0]=PV8(pa,vf[0],o[0]); o[1]=PV8(pa,vf[1],o[1]); o2=SUM8(pa,o2); }
  #undef PK8
  #undef SUM8
  #undef PV8
  #undef HALFA
  #undef PIN
  #undef MX3
  #undef EX
  #undef KRD
  #undef DMA_STEP
  #undef STEP
  #undef ENDW
  asm volatile("s_nop 15\n\ts_nop 7":"+v"(o2));
  if((lane&7)==0){ _Pragma("unroll") for(int e=0;e<4;++e)wsf[32+l2row+e]=o2[e]; }
  asm volatile("s_waitcnt lgkmcnt(0)":::"memory");
  if constexpr(MODE==1){ if(hi==0)wsf[32+r32]+=__builtin_amdgcn_exp2f(sink2-mhat); asm volatile("s_waitcnt lgkmcnt(0)":::"memory"); }
  float rli[16];
  #pragma unroll
  for(int r=0;r<16;++r)rli[r]=__builtin_amdgcn_rcpf(wsf[32+crow(r,hi)]);
  bf16*Ow=Ou+(long)(wid*QBLK)*OP;
  { bf16*stg=(bf16*)(shm+LDS_OST)+wid*2048;
    #pragma unroll
    for(int r=0;r<16;++r){const int orow=crow(r,hi);
      #pragma unroll
      for(int d0=0;d0<2;++d0)stg[orow*64+d0*32+r32]=__float2bfloat16(o[d0][r]*rli[r]);}
    asm volatile("s_waitcnt lgkmcnt(0)":::"memory");
    #pragma unroll
    for(int i=0;i<4;++i){const int row=i*8+(lane>>3),ch=lane&7; const u32x4 v=*(const u32x4*)(stg+row*64+ch*8); ATTN_STORE16(Ow+(long)row*OP+ch*8,v);} }
  asm volatile("s_waitcnt lgkmcnt(0)\n\ts_barrier":::"memory");
  #undef DMA_K
  #undef DMA_V
  #undef DMA_P
  #undef CMASK
  #undef START
  #undef RESC
  #undef ROT
}
constexpr int ATTN_LDS_BYTES=LDS_BYTES;
#undef SBAR
#undef WAIT_BAR
#undef WAIT_BAR2W
#undef QK8
}
#define GAS __attribute__((address_space(1)))
#define LAS __attribute__((address_space(3)))
typedef unsigned short bf16;
typedef unsigned v4u __attribute__((ext_vector_type(4)));
typedef float f32x4 __attribute__((ext_vector_type(4)));
typedef short bf16x8 __attribute__((ext_vector_type(8)));
typedef GAS unsigned gu32;
typedef GAS unsigned long long gu64;
#define RLX_AGENT __ATOMIC_RELAXED, __HIP_MEMORY_SCOPE_AGENT
#define LDS_WAIT() asm volatile("s_waitcnt lgkmcnt(0)" ::: "memory")
#define VM_WAIT() asm volatile("s_waitcnt vmcnt(0)" ::: "memory")
__device__ __forceinline__ unsigned long long rt() { return __builtin_amdgcn_s_memrealtime(); }
__device__ __forceinline__ unsigned f2bf(float f) { unsigned u = __builtin_bit_cast(unsigned, f); return (u + 0x7fffu + ((u >> 16) & 1u)) >> 16; }
__device__ __forceinline__ unsigned pk2(float lo, float hi) { return f2bf(lo) | (f2bf(hi) << 16); }

#define XB_TMO      128
#define XB_XCNT(j)  (256  + 64 * (j))
#define XB_XSUB(j)  (1280 + 64 * (j))
#define XB_XGEN(j)  (2304 + 64 * (j))
#define XB_TOP      3328
#define XB_TOPGEN   3392
#define XCD_BAR_WORDS 3456
#define XB_SPIN_CAP (1u << 18)

__device__ __forceinline__ unsigned xb_ld(unsigned* p)              { return __hip_atomic_load(p, __ATOMIC_RELAXED, __HIP_MEMORY_SCOPE_AGENT); }
__device__ __forceinline__ unsigned xb_add(unsigned* p, unsigned v) { return __hip_atomic_fetch_add(p, v, __ATOMIC_RELAXED, __HIP_MEMORY_SCOPE_AGENT); }
__device__ __forceinline__ unsigned xb_xcc_id() { return (unsigned)__builtin_amdgcn_s_getreg((3 << 11) | 20) & 0xFu; }
#define XB_SPIN(cond, bar) do { unsigned _sp = 0; while (cond) { __builtin_amdgcn_s_sleep(1); \
    if ((++_sp & 255u) == 0u) { if (xb_ld(&(bar)[XB_TMO])) break; if (_sp > XB_SPIN_CAP) { atomicAdd(&(bar)[XB_TMO], 1u); break; } } } } while (0)

struct XcdBarrier {
    int wave0;
    unsigned* bar; unsigned x;
    volatile LAS unsigned* st;
};

__device__ __forceinline__ XcdBarrier xcd_barrier_post(unsigned* bar, volatile LAS unsigned* st, int wave0) {
    XcdBarrier b; b.wave0 = wave0; b.bar = bar; b.x = xb_xcc_id(); b.st = st;
    if (threadIdx.x == 0) (void)xb_add(&bar[XB_XCNT(b.x)], 1u);
    return b;
}
__device__ __forceinline__ void xcd_barrier_complete(unsigned* bar, unsigned x, unsigned& nloc, unsigned& nx) {
    const unsigned G = gridDim.x * gridDim.y * gridDim.z;
    unsigned sum, cnt, mine, sp = 0u;
    for (;;) {
        sum = 0u; cnt = 0u; mine = 0u;
#pragma unroll
        for (unsigned j = 0; j < 16; ++j) { const unsigned c = xb_ld(&bar[XB_XCNT(j)]); sum += c; cnt += (c > 0u) ? 1u : 0u; mine = (j == x) ? c : mine; }
        if (sum == G) break;
        __builtin_amdgcn_s_sleep(1);
        if ((++sp & 255u) == 0u) { if (xb_ld(&bar[XB_TMO])) break; if (sp > XB_SPIN_CAP) { atomicAdd(&bar[XB_TMO], 1u); break; } }
    }
    nloc = mine > 0u ? mine : 1u; nx = cnt > 0u ? cnt : 1u;
}

__device__ __forceinline__ void xcd_barrier(const XcdBarrier& b) {
    asm volatile("s_waitcnt vmcnt(0)" ::: "memory");
    __syncthreads();
    if (b.wave0 == 0 && hw_lane() == 0) {
        unsigned* bar = b.bar;
        __builtin_amdgcn_s_waitcnt(0);
        unsigned nloc = b.st[0], nx = b.st[1];
        if (nloc == 0u) { xcd_barrier_complete(bar, b.x, nloc, nx); b.st[0] = nloc; b.st[1] = nx; }
        const unsigned old = xb_add(&bar[XB_XSUB(b.x)], 1u);
        const unsigned gen = old / nloc;
        if (old + 1u == (gen + 1u) * nloc) {
            __builtin_amdgcn_fence(__ATOMIC_RELEASE, "agent");
            asm volatile("s_waitcnt vmcnt(0)" ::: "memory");
            const unsigned og = xb_add(&bar[XB_TOP], 1u);
            const unsigned tg = og / nx;
            if (og + 1u == (tg + 1u) * nx) xb_add(&bar[XB_TOPGEN], 1u);
            else XB_SPIN(xb_ld(&bar[XB_TOPGEN]) == tg, bar);
            __builtin_amdgcn_fence(__ATOMIC_ACQUIRE, "agent");
            xb_add(&bar[XB_XGEN(b.x)], 1u);
            asm volatile("s_waitcnt vmcnt(0)" ::: "memory");
        } else {
            XB_SPIN(xb_ld(&bar[XB_XGEN(b.x)]) == gen, bar);
            __builtin_amdgcn_fence(__ATOMIC_ACQUIRE, "agent");
            asm volatile("s_waitcnt vmcnt(0)" ::: "memory");
        }
    }
    __syncthreads();
}

constexpr int NWAVES = 8;
#ifndef MK_N_LAUNCHES
#define MK_N_LAUNCHES 1
#endif

constexpr int DM = 2048, INW = 4096, FF = 8192, DEPTH = 2;
constexpr int SP = 16384, SS = 2048;
constexpr int MP = 2 * SP, MS = 4 * SS, M = MP + MS;
constexpr int NCHUNK = 5, MC = M / NCHUNK;
constexpr int N_PHASES = 1 + DEPTH * (5 + (NCHUNK + 1) + 1);
constexpr float RMS_EPS = 1e-6f, LN_EPS = 1e-5f, LOG2E = 1.4426950408889634f;
constexpr int ZW = 3072, ZA_B = 0, Z_P = 512, ZB_Q = 1024, ZB_K = 1536, ZB_V = 1664, ZC_Q = 1792, ZC_K = 2304, ZC_V = 2432, Z_U = 2560;
constexpr int Y_A = 0, Y_B = 512, Y_C = 1024, Y_D = 1536;
static_assert(attn_body::ZP == ZW && attn_body::OP == DM, "attention body pitches");

constexpr size_t MiB = 1u << 20;
constexpr size_t WS_CTL = 0, CTL_ZERO_BYTES = 1 * MiB;
constexpr size_t WS_W = 2 * MiB, W_LAYER = 88 * MiB;
constexpr size_t WO_IN = 0, WO_OUT = 16 * MiB, WO_F1 = 24 * MiB, WO_F2 = 56 * MiB;
constexpr size_t WS_Z = WS_W + DEPTH * W_LAYER;
constexpr size_t WS_Y = WS_Z + (size_t)M * INW * 2;
constexpr size_t WS_U1 = WS_Z + (size_t)M * DM * 2;
static_assert(WS_U1 + (size_t)MC * FF * 2 <= WS_Y, "U1 fits above YP inside the z region");
constexpr size_t WS_H = WS_Y + (size_t)M * DM * 2;
constexpr size_t WS_RS = 1 * MiB;
constexpr size_t WS_KT = WS_H + (size_t)M * DM * 2;
constexpr size_t KV_IMG = (size_t)4 * (M / 64) * 8192;
constexpr size_t WS_VT = WS_KT + KV_IMG;
constexpr size_t WS_END = WS_VT + KV_IMG;
static_assert((size_t)MC * FF * 2 <= (size_t)M * DM * 2, "U chunk fits in the y region");
constexpr int CW_ATT = 8192;
constexpr int CW_BAR = 4096;

constexpr int RING_OFF = 0, RING_BYTES = 131072;
constexpr int LDSCTL_OFF = RING_BYTES, MISC_OFF = LDSCTL_OFF + 320;
constexpr int LDS_BYTES = 147456;
static_assert(MISC_OFF + 128 <= LDS_BYTES && attn_body::ATTN_LDS_BYTES <= RING_BYTES, "LDS map");

typedef unsigned u32x2 __attribute__((ext_vector_type(2)));
struct Frame {
    LAS unsigned char* lds;
    volatile LAS unsigned* MISC;
    int tid, lane, wave, wave0;
    int vcu, G;
    __device__ __forceinline__ const float* in(int i) const { asm volatile("" : "+s"(i)); return ((const float* const __attribute__((address_space(4)))*)__builtin_amdgcn_kernarg_segment_ptr())[i]; }
    __device__ __forceinline__ const float* xp() const { return in(0); }
    __device__ __forceinline__ const float* xs() const { return in(1); }
    __device__ __forceinline__ const float* pre_mix_g() const { return in(2); }
    __device__ __forceinline__ const float* w_in() const { return in(3); }
    __device__ __forceinline__ const float* conv_a_w() const { return in(4); }
    __device__ __forceinline__ const float* q_norm_g() const { return in(5); }
    __device__ __forceinline__ const float* k_norm_g() const { return in(6); }
    __device__ __forceinline__ const float* sink_c() const { return in(7); }
    __device__ __forceinline__ const float* conv_d_w() const { return in(8); }
    __device__ __forceinline__ const float* conv_d_b() const { return in(9); }
    __device__ __forceinline__ const float* ln_d_g() const { return in(10); }
    __device__ __forceinline__ const float* ln_d_b() const { return in(11); }
    __device__ __forceinline__ const float* w_out() const { return in(12); }
    __device__ __forceinline__ const float* post_mix_g() const { return in(13); }
    __device__ __forceinline__ const float* pre_ffn_g() const { return in(14); }
    __device__ __forceinline__ const float* w_ff1() const { return in(15); }
    __device__ __forceinline__ const float* w_ff2() const { return in(16); }
    __device__ __forceinline__ const float* post_ffn_g() const { return in(17); }
    float* out;
    unsigned char* ws;
    __device__ __forceinline__ bf16* Z() const { return (bf16*)(ws + WS_Z); }
    __device__ __forceinline__ bf16* Y() const { return (bf16*)(ws + WS_Y); }
    __device__ __forceinline__ bf16* H() const { return (bf16*)(ws + WS_H); }
    __device__ __forceinline__ float* RS() const { return (float*)(ws + WS_RS); }
    __device__ __forceinline__ char* KT() const { return (char*)(ws + WS_KT); }
    __device__ __forceinline__ char* VT() const { return (char*)(ws + WS_VT); }
    __device__ __forceinline__ gu32* ctl() const { return (gu32*)(ws + WS_CTL); }
};
__device__ __forceinline__ bf16* wt_ptr(Frame& F, int l, size_t off) { return (bf16*)(F.ws + WS_W + (size_t)l * W_LAYER + off); }

__device__ __forceinline__ float wave_sum(float v) {
#pragma unroll
    for (int o = 1; o < 64; o <<= 1) v += __shfl_xor(v, o);
    return v;
}
__device__ __forceinline__ unsigned cvtpk(float lo, float hi) { typedef float f2 __attribute__((ext_vector_type(2))); typedef __bf16 b2 __attribute__((ext_vector_type(2))); f2 v = {lo, hi}; b2 b = __builtin_convertvector(v, b2); return __builtin_bit_cast(unsigned, b); }
__device__ __forceinline__ float bflo(unsigned w) { return __uint_as_float(w << 16); }
__device__ __forceinline__ float bfhi(unsigned w) { return __uint_as_float(w & 0xffff0000u); }
__device__ __forceinline__ float sigmoidf_(float x) { return __builtin_amdgcn_rcpf(1.0f + __expf(-x)); }
__device__ __forceinline__ int win_dst_row(int ns) {
    if (ns >= 512 && ns < 1536) { const int v = ns >= 1024, r = ns - (v ? 1024 : 512); return 512 + 256 * (r >> 7) + 128 * v + (r & 127); }
    if (ns >= 3072) { const int v = ns >= 3584, r = ns - (v ? 3584 : 3072); return 3072 + 256 * (r >> 7) + 128 * v + (r & 127); }
    return ns;
}
template <bool WIN_ORDER>
__device__ __forceinline__ void p0_transpose_item(const float* W, int K, int N, bf16* WT, LAS unsigned char* scr, int item, int lane, const float* gk) {
    const int nblk = N / 64, kb = item / nblk, nb = item % nblk, k0 = 64 * kb, n0 = 64 * nb;
    const int sub = lane >> 4, nq = 4 * (lane & 15);
    f32x4 v[16]; float g[16];
#pragma unroll
    for (int i = 0; i < 16; ++i) v[i] = __builtin_nontemporal_load((const GAS f32x4*)(W + (size_t)(k0 + 4 * i + sub) * N + n0 + nq));
#pragma unroll
    for (int i = 0; i < 16; ++i) g[i] = gk ? gk[k0 + 4 * i + sub] : 1.0f;
#pragma unroll
    for (int i = 0; i < 16; ++i) { const int k = 4 * i + sub; const f32x4 x = v[i] * g[i]; const unsigned w01 = cvtpk(x.x, x.y), w23 = cvtpk(x.z, x.w);
        LAS unsigned short* t = (LAS unsigned short*)(scr + nq * 132 + 2 * k);
        t[0] = (unsigned short)w01; t[66] = (unsigned short)(w01 >> 16); t[132] = (unsigned short)w23; t[198] = (unsigned short)(w23 >> 16); }
    LDS_WAIT(); asm volatile("" ::: "memory");
    const int rbase = WIN_ORDER ? win_dst_row(n0) : n0, r16 = lane >> 2, cg = lane & 3;
#pragma unroll
    for (int j = 0; j < 8; ++j) { const int rbi = j >> 1, cbi = j & 1, p = 16 * rbi + r16, n = (p & ~31) + pg8::perm32(p & 31);
        const LAS unsigned* r = (const LAS unsigned*)(scr + n * 132 + (32 * cbi + 8 * cg) * 2);
        v4u o; o.x = r[0]; o.y = r[1]; o.z = r[2]; o.w = r[3];
        *(GAS v4u*)((char*)WT + pg8::tiled_off(rbase + p, k0 + 32 * cbi + 8 * cg, K)) = o; }
    LDS_WAIT(); asm volatile("" ::: "memory");
}
__device__ __forceinline__ void p0_transpose_item_f8(const float* W, int K, int N, bf16* WT, LAS unsigned char* scr, int item, int lane) {
    const int nblk = N / 64, kb = item / nblk, nb = item % nblk, k0 = 64 * kb, n0 = 64 * nb;
    const int sub = lane >> 4, nq = 4 * (lane & 15);
    f32x4 v[16];
#pragma unroll
    for (int i = 0; i < 16; ++i) v[i] = __builtin_nontemporal_load((const GAS f32x4*)(W + (size_t)(k0 + 4 * i + sub) * N + n0 + nq));
#pragma unroll
    for (int i = 0; i < 16; ++i) { const int k = 4 * i + sub; const f32x4 x = v[i] * 256.0f; int w = 0; w = __builtin_amdgcn_cvt_pk_fp8_f32(x.x, x.y, w, false); w = __builtin_amdgcn_cvt_pk_fp8_f32(x.z, x.w, w, true);
        LAS unsigned char* t = scr + nq * 80 + k;
        t[0] = (unsigned char)w; t[80] = (unsigned char)(w >> 8); t[160] = (unsigned char)(w >> 16); t[240] = (unsigned char)(w >> 24); }
    LDS_WAIT(); asm volatile("" ::: "memory");
    const int r16 = lane >> 2, cg = lane & 3;
#pragma unroll
    for (int j = 0; j < 4; ++j) { const int p = 16 * j + r16, n = (p & ~31) + pg8::perm32(p & 31);
        const LAS unsigned* r = (const LAS unsigned*)(scr + n * 80 + 16 * cg);
        v4u o; o.x = r[0]; o.y = r[1]; o.z = r[2]; o.w = r[3];
        *(GAS v4u*)((char*)WT + pg8::tiled_off(n0 + p, (k0 >> 1) + 8 * cg, K >> 1)) = o; }
    LDS_WAIT(); asm volatile("" ::: "memory");
}
__device__ __forceinline__ const float* xin_row(Frame& F, int m) { return m < MP ? F.xp() + (size_t)m * DM : F.xs() + (size_t)(m - MP) * DM; }

__device__ __forceinline__ void p0_prologue(Frame& F) {
    LAS unsigned char* scr = F.lds + RING_OFF + F.wave * 16384;
    const int gw = F.vcu * NWAVES + F.wave, NGW = F.G * NWAVES;
    constexpr int I_IN = (DM / 64) * (INW / 64), I_OUT = (DM / 64) * (DM / 64), I_F1 = (DM / 64) * (FF / 64), I_F2 = (FF / 64) * (DM / 64), I_L = I_IN + I_OUT + I_F1 + I_F2;
    for (int it = gw; it < DEPTH * I_L; it += NGW) {
        const int l = it / I_L; int r = it % I_L;
        if (r < I_IN) { p0_transpose_item<true>(F.w_in() + (size_t)l * DM * INW, DM, INW, wt_ptr(F, l, WO_IN), scr, r, F.lane, F.pre_mix_g() + l * DM); continue; } r -= I_IN;
        if (r < I_OUT) { p0_transpose_item<false>(F.w_out() + (size_t)l * DM * DM, DM, DM, wt_ptr(F, l, WO_OUT), scr, r, F.lane, nullptr); continue; } r -= I_OUT;
        if (r < I_F1) { p0_transpose_item<false>(F.w_ff1() + (size_t)l * DM * FF, DM, FF, wt_ptr(F, l, WO_F1), scr, r, F.lane, F.pre_ffn_g() + l * DM); continue; } r -= I_F1;
        if (l == DEPTH - 1) p0_transpose_item_f8(F.w_ff2() + (size_t)l * FF * DM, FF, DM, wt_ptr(F, l, WO_F2), scr, r, F.lane);
        else p0_transpose_item<false>(F.w_ff2() + (size_t)l * FF * DM, FF, DM, wt_ptr(F, l, WO_F2), scr, r, F.lane, nullptr);
    }
    for (int mb = gw; mb < M; mb += 4 * NGW) {
        f32x4 x[4][4][2];
#pragma unroll
        for (int k = 0; k < 4; ++k) { const int m = mb + k * NGW; if (m < M) { const float* xr = xin_row(F, m);
#pragma unroll
            for (int j = 0; j < 4; ++j) { x[k][j][0] = __builtin_nontemporal_load((const GAS f32x4*)(xr + j * 512 + F.lane * 8)); x[k][j][1] = __builtin_nontemporal_load((const GAS f32x4*)(xr + j * 512 + F.lane * 8 + 4)); } } }
#pragma unroll
        for (int k = 0; k < 4; ++k) { const int m = mb + k * NGW; if (m < M) { float ss = 0.f;
#pragma unroll
            for (int j = 0; j < 4; ++j) { const f32x4 a = x[k][j][0], b = x[k][j][1]; ss += (a.x * a.x + a.y * a.y) + (a.z * a.z + a.w * a.w) + (b.x * b.x + b.y * b.y) + (b.z * b.z + b.w * b.w);
                v4u o; o.x = cvtpk(a.x, a.y); o.y = cvtpk(a.z, a.w); o.z = cvtpk(b.x, b.y); o.w = cvtpk(b.z, b.w);
                *(GAS v4u*)(F.H() + (size_t)m * DM + j * 512 + F.lane * 8) = o; }
            const float r = rsqrtf(wave_sum(ss) * (1.0f / DM) + RMS_EPS);
            if (F.lane == 0) F.RS()[m] = r; } }
    }
}

template <bool FINAL, bool FIRSTX>
__device__ __forceinline__ void norm_pass(Frame& F, const bf16* YPb, const float* gpost) {
    constexpr int R = FIRSTX ? 2 : 4;
    const int gw = F.vcu * NWAVES + F.wave, NGW = F.G * NWAVES;
    f32x4 ga[4][2];
#pragma unroll
    for (int j = 0; j < 4; ++j) { ga[j][0] = *(const GAS f32x4*)(gpost + j * 512 + F.lane * 8); ga[j][1] = *(const GAS f32x4*)(gpost + j * 512 + F.lane * 8 + 4); }
    for (int mb = gw; mb < M; mb += R * NGW) {
        v4u y[R][4]; v4u xb[R][4]; f32x4 xf[FIRSTX ? R : 1][4][2];
#pragma unroll
        for (int k = 0; k < R; ++k) { const int m = mb + k * NGW; if (m < M) {
#pragma unroll
            for (int j = 0; j < 4; ++j) y[k][j] = __builtin_nontemporal_load((const GAS v4u*)(YPb + (size_t)m * DM + j * 512 + F.lane * 8));
            if constexpr (FIRSTX) { const float* xr = xin_row(F, m);
#pragma unroll
                for (int j = 0; j < 4; ++j) { xf[k][j][0] = __builtin_nontemporal_load((const GAS f32x4*)(xr + j * 512 + F.lane * 8)); xf[k][j][1] = __builtin_nontemporal_load((const GAS f32x4*)(xr + j * 512 + F.lane * 8 + 4)); }
            } else {
#pragma unroll
                for (int j = 0; j < 4; ++j) xb[k][j] = __builtin_nontemporal_load((const GAS v4u*)(F.H() + (size_t)m * DM + j * 512 + F.lane * 8));
            } } }
#pragma unroll
        for (int k = 0; k < R; ++k) { const int m = mb + k * NGW; if (m < M) {
            float ss = 0.f;
#pragma unroll
            for (int j = 0; j < 4; ++j) { const v4u w = y[k][j]; const float a0 = bflo(w.x), a1 = bfhi(w.x), a2 = bflo(w.y), a3 = bfhi(w.y), a4 = bflo(w.z), a5 = bfhi(w.z), a6 = bflo(w.w), a7 = bfhi(w.w);
                ss += (a0 * a0 + a1 * a1) + (a2 * a2 + a3 * a3) + (a4 * a4 + a5 * a5) + (a6 * a6 + a7 * a7); }
            const float r = rsqrtf(wave_sum(ss) * (1.0f / DM) + RMS_EPS);
            float s2 = 0.f;
#pragma unroll
            for (int j = 0; j < 4; ++j) { const v4u w = y[k][j];
                const f32x4 y0 = (f32x4){bflo(w.x), bfhi(w.x), bflo(w.y), bfhi(w.y)}, y1 = (f32x4){bflo(w.z), bfhi(w.z), bflo(w.w), bfhi(w.w)};
                f32x4 x0, x1;
                if constexpr (FIRSTX) { x0 = xf[k][j][0]; x1 = xf[k][j][1]; }
                else { const v4u q = xb[k][j]; x0 = (f32x4){bflo(q.x), bfhi(q.x), bflo(q.y), bfhi(q.y)}; x1 = (f32x4){bflo(q.z), bfhi(q.z), bflo(q.w), bfhi(q.w)}; }
                const f32x4 v0 = x0 + y0 * r * ga[j][0], v1 = x1 + y1 * r * ga[j][1];
                if constexpr (FINAL) { __builtin_nontemporal_store(v0, (GAS f32x4*)(F.out + (size_t)m * DM + j * 512 + F.lane * 8)); __builtin_nontemporal_store(v1, (GAS f32x4*)(F.out + (size_t)m * DM + j * 512 + F.lane * 8 + 4)); }
                else { s2 += (v0.x * v0.x + v0.y * v0.y) + (v0.z * v0.z + v0.w * v0.w) + (v1.x * v1.x + v1.y * v1.y) + (v1.z * v1.z + v1.w * v1.w);
                    v4u o; o.x = cvtpk(v0.x, v0.y); o.y = cvtpk(v0.z, v0.w); o.z = cvtpk(v1.x, v1.y); o.w = cvtpk(v1.z, v1.w);
                    *(GAS v4u*)(F.H() + (size_t)m * DM + j * 512 + F.lane * 8) = o; } }
            if constexpr (!FINAL) { const float r2 = rsqrtf(wave_sum(s2) * (1.0f / DM) + RMS_EPS); if (F.lane == 0) F.RS()[m] = r2; }
        } }
    }
}

constexpr int PREP_T = 32, PREP_U_ROWS = PREP_T + 30, PREP_TW = PREP_T / NWAVES;
constexpr int PREP_V_OFF = PREP_U_ROWS * 512 * 2;
static_assert(PREP_V_OFF % 16 == 0 && PREP_V_OFF + PREP_T * 512 * 4 <= RING_BYTES, "prep LDS");
__device__ __forceinline__ void rope_store4(bf16* p1, bf16* p2, const float (&a)[4], const float (&b)[4], const float (&c)[4], const float (&s)[4], float scale, bool pred) {
    float o1[4], o2[4];
#pragma unroll
    for (int k = 0; k < 4; ++k) { o1[k] = (a[k] * c[k] - b[k] * s[k]) * scale; o2[k] = (b[k] * c[k] + a[k] * s[k]) * scale; }
    if (pred) { u32x2 w1, w2; w1.x = cvtpk(o1[0], o1[1]); w1.y = cvtpk(o1[2], o1[3]); w2.x = cvtpk(o2[0], o2[1]); w2.y = cvtpk(o2[2], o2[3]);
        *(GAS u32x2*)p1 = w1; *(GAS u32x2*)p2 = w2; }
}
__device__ __forceinline__ void load4x2(const bf16* p1, const bf16* p2, float (&a)[4], float (&b)[4]) {
    const u32x2 w1 = *(const GAS u32x2*)p1, w2 = *(const GAS u32x2*)p2;
    a[0] = bflo(w1.x); a[1] = bfhi(w1.x); a[2] = bflo(w1.y); a[3] = bfhi(w1.y); b[0] = bflo(w2.x); b[1] = bfhi(w2.x); b[2] = bflo(w2.y); b[3] = bfhi(w2.y);
}
__device__ __forceinline__ void unpack8(const v4u w, float (&f)[8]) { f[0] = bflo(w.x); f[1] = bfhi(w.x); f[2] = bflo(w.y); f[3] = bfhi(w.y); f[4] = bflo(w.z); f[5] = bfhi(w.z); f[6] = bflo(w.w); f[7] = bfhi(w.w); }

__device__ __forceinline__ void prep_phase(Frame& F, const int l) {
    LAS bf16* Ub = (LAS bf16*)(F.lds + RING_OFF);
    LAS float* V = (LAS float*)(F.lds + RING_OFF + PREP_V_OFF);
    const int lane = F.lane, tid = F.tid, wave = F.wave;
    const float* cdw = F.conv_d_w() + (size_t)l * 31 * 512;
    float wd[31];
#pragma unroll
    for (int j = 0; j < 31; ++j) wd[j] = cdw[j * 512 + tid];
    const float cdb = F.conv_d_b()[l * 512 + tid];
    const float* caw = F.conv_a_w() + (size_t)l * 3 * 512;
    const float* gk = F.k_norm_g() + l * 64;
    const int c0 = lane * 8;
    f32x4 wa[3][2];
#pragma unroll
    for (int j = 0; j < 3; ++j) { wa[j][0] = *(const GAS f32x4*)(caw + j * 512 + c0); wa[j][1] = *(const GAS f32x4*)(caw + j * 512 + c0 + 4); }
    const f32x4 g0 = *(const GAS f32x4*)(F.ln_d_g() + l * 512 + c0), g1 = *(const GAS f32x4*)(F.ln_d_g() + l * 512 + c0 + 4), b0 = *(const GAS f32x4*)(F.ln_d_b() + l * 512 + c0), b1 = *(const GAS f32x4*)(F.ln_d_b() + l * 512 + c0 + 4);
    constexpr int NST = (PREP_U_ROWS * 64 + 511) / 512;
    for (int item = F.vcu; item < M / PREP_T; item += F.G) {
        const int m0 = item * PREP_T;
        int t0, S; if (m0 < MP) { t0 = m0 & (SP - 1); S = SP; } else { t0 = (m0 - MP) & (SS - 1); S = SS; }
        v4u stg[NST];
#pragma unroll
        for (int it = 0; it < NST; ++it) { const int id = it * 512 + tid, rr = id >> 6, ch = (id & 63) * 8, tp = t0 - 15 + rr;
            stg[it] = (v4u){0u, 0u, 0u, 0u};
            if (id < PREP_U_ROWS * 64 && tp >= 0 && tp < S) stg[it] = *(const GAS v4u*)(F.Z() + (size_t)(m0 - 15 + rr) * ZW + Z_U + ch); }
        const int ta = t0 + PREP_TW * wave, ma = m0 + PREP_TW * wave;
        v4u pr[PREP_TW + 2], ab[PREP_TW];
#pragma unroll
        for (int j = 0; j < PREP_TW + 2; ++j) { const int tp = ta + j - 1; pr[j] = (v4u){0u, 0u, 0u, 0u};
            if (tp >= 0 && tp < S) pr[j] = *(const GAS v4u*)(F.Z() + (size_t)(ma + j - 1) * ZW + Z_P + c0); }
#pragma unroll
        for (int j = 0; j < PREP_TW; ++j) ab[j] = *(const GAS v4u*)(F.Z() + (size_t)(ma + j) * ZW + ZA_B + c0);
        const int grp = lane >> 5, hk = (lane >> 3) & 1, sl = lane & 7, half = sl >> 2;
        const int i0 = grp ? 4 * sl : 4 * (sl & 3);
        const int koff = grp ? (ZC_K + hk * 64 + i0) : (ZB_K + hk * 64 + half * 32 + i0), kd = grp ? 32 : 16;
        u32x2 kw[PREP_TW / 2][2];
#pragma unroll
        for (int q = 0; q < PREP_TW / 2; ++q) { const bf16* p1 = F.Z() + (size_t)(ma + 2 * q + ((lane >> 4) & 1)) * ZW + koff; kw[q][0] = *(const GAS u32x2*)p1; kw[q][1] = *(const GAS u32x2*)(p1 + kd); }
        unsigned vld[2][4];
#pragma unroll
        for (int it = 0; it < 2; ++it) { const int id = it * 512 + tid, qd = id >> 7, cb = (id >> 5) & 3, dp = id & 31;
#pragma unroll
            for (int j = 0; j < 4; ++j) vld[it][j] = *(const GAS unsigned*)(F.Z() + (size_t)(m0 + 4 * qd + j) * ZW + ((cb >> 1) ? ZC_V : ZB_V) + (cb & 1) * 64 + 2 * dp); }
#pragma unroll
        for (int it = 0; it < NST; ++it) { const int id = it * 512 + tid, rr = id >> 6, ch = (id & 63) * 8;
            if (id < PREP_U_ROWS * 64) *(LAS v4u*)(Ub + rr * 512 + ch) = stg[it]; }
#pragma unroll
        for (int it = 0; it < 2; ++it) { const int id = it * 512 + tid, qd = id >> 7, cb = (id >> 5) & 3, dp = id & 31;
            int w0 = 0, w1 = 0;
            w0 = __builtin_amdgcn_cvt_pk_fp8_f32(bflo(vld[it][0]), bflo(vld[it][1]), w0, false); w0 = __builtin_amdgcn_cvt_pk_fp8_f32(bflo(vld[it][2]), bflo(vld[it][3]), w0, true);
            w1 = __builtin_amdgcn_cvt_pk_fp8_f32(bfhi(vld[it][0]), bfhi(vld[it][1]), w1, false); w1 = __builtin_amdgcn_cvt_pk_fp8_f32(bfhi(vld[it][2]), bfhi(vld[it][3]), w1, true);
            char* vt = F.VT() + ((size_t)(cb * (M / 64) + (m0 >> 6)) << 12) + (qd & 1) * 2048 + ((m0 >> 5) & 1) * 1024 + 4 * (qd >> 1);
            *(GAS int*)(vt + (2 * dp) * 16) = w0; *(GAS int*)(vt + (2 * dp + 1) * 16) = w1; }
#pragma unroll
        for (int q = 0; q < PREP_TW; ++q) { float acc[8], bb[8];
#pragma unroll
            for (int k = 0; k < 8; ++k) acc[k] = 0.f;
#pragma unroll
            for (int j = 0; j < 3; ++j) { float pp[8]; unpack8(pr[q + j], pp);
                acc[0] += wa[j][0].x * pp[0]; acc[1] += wa[j][0].y * pp[1]; acc[2] += wa[j][0].z * pp[2]; acc[3] += wa[j][0].w * pp[3];
                acc[4] += wa[j][1].x * pp[4]; acc[5] += wa[j][1].y * pp[5]; acc[6] += wa[j][1].z * pp[6]; acc[7] += wa[j][1].w * pp[7]; }
            unpack8(ab[q], bb);
            v4u o; o.x = cvtpk(bb[0] * acc[0], bb[1] * acc[1]); o.y = cvtpk(bb[2] * acc[2], bb[3] * acc[3]); o.z = cvtpk(bb[4] * acc[4], bb[5] * acc[5]); o.w = cvtpk(bb[6] * acc[6], bb[7] * acc[7]);
            *(GAS v4u*)(F.Y() + (size_t)(ma + q) * DM + Y_A + c0) = o; }
#pragma unroll
        for (int q = 0; q < PREP_TW / 2; ++q) {
            const int tk = PREP_TW * wave + 2 * q + ((lane >> 4) & 1), tpos = t0 + tk;
            const int pos = grp ? tpos : (half ? (tpos & 63) : (tpos >> 6));
            const int mr = m0 + tk, f1 = grp ? i0 : half * 32 + i0, f2 = f1 + kd;
            char* kt = F.KT() + ((size_t)((grp * 2 + hk) * (M / 64) + (mr >> 6)) << 12) + (mr & 63) * 16;
            int* p1 = (int*)(kt + ((f1 >> 3) & 1) * 2048 + (f1 >> 5) * 1024 + ((f1 >> 4) & 1) * 8 + (f1 & 7)); int* p2 = (int*)(kt + ((f2 >> 3) & 1) * 2048 + (f2 >> 5) * 1024 + ((f2 >> 4) & 1) * 8 + (f2 & 7));
            float cs[4], sn[4];
#pragma unroll
            for (int k = 0; k < 4; ++k) sincos_f((float)pos * INVF[grp ? (i0 + k) : 2 * (i0 + k)], sn[k], cs[k]);
            float a[4], b[4];
            a[0] = bflo(kw[q][0].x); a[1] = bfhi(kw[q][0].x); a[2] = bflo(kw[q][0].y); a[3] = bfhi(kw[q][0].y); b[0] = bflo(kw[q][1].x); b[1] = bfhi(kw[q][1].x); b[2] = bflo(kw[q][1].y); b[3] = bfhi(kw[q][1].y);
            float ss = (a[0] * a[0] + a[1] * a[1]) + (a[2] * a[2] + a[3] * a[3]) + (b[0] * b[0] + b[1] * b[1]) + (b[2] * b[2] + b[3] * b[3]);
            ss += __shfl_xor(ss, 1); ss += __shfl_xor(ss, 2); ss += __shfl_xor(ss, 4);
            const float r = grp ? 1.0f : rsqrtf(ss * (1.0f / 64.0f) + RMS_EPS);
#pragma unroll
            for (int k = 0; k < 4; ++k) { const int gi = grp ? 0 : (half * 32 + i0);
                const float g1k = grp ? 1.0f : gk[gi + k], g2k = grp ? 1.0f : gk[gi + 16 + k]; a[k] = a[k] * r * g1k; b[k] = b[k] * r * g2k; }
            {   float o1[4], o2[4];
#pragma unroll
                for (int k = 0; k < 4; ++k) { o1[k] = a[k] * cs[k] - b[k] * sn[k]; o2[k] = b[k] * cs[k] + a[k] * sn[k]; }
                int w1 = 0, w2 = 0;
                w1 = __builtin_amdgcn_cvt_pk_fp8_f32(o1[0], o1[1], w1, false); w1 = __builtin_amdgcn_cvt_pk_fp8_f32(o1[2], o1[3], w1, true);
                w2 = __builtin_amdgcn_cvt_pk_fp8_f32(o2[0], o2[1], w2, false); w2 = __builtin_amdgcn_cvt_pk_fp8_f32(o2[2], o2[3], w2, true);
                *(GAS int*)p1 = w1; *(GAS int*)p2 = w2; }
        }
        __syncthreads();
        {   float uu[PREP_U_ROWS];
#pragma unroll
            for (int rr = 0; rr < PREP_U_ROWS; ++rr) uu[rr] = __uint_as_float((unsigned)Ub[rr * 512 + tid] << 16);
#pragma unroll
            for (int tt = 0; tt < PREP_T; ++tt) { float a = cdb;
#pragma unroll
                for (int j = 0; j < 31; ++j) a += wd[j] * uu[tt + j];
                V[tt * 512 + tid] = a; } }
        __syncthreads();
        {   f32x4 v0[PREP_TW], v1[PREP_TW]; float sm[PREP_TW];
#pragma unroll
            for (int q = 0; q < PREP_TW; ++q) { const int tt = PREP_TW * wave + q; v0[q] = *(const LAS f32x4*)(V + tt * 512 + c0); v1[q] = *(const LAS f32x4*)(V + tt * 512 + c0 + 4);
                sm[q] = (v0[q].x + v0[q].y) + (v0[q].z + v0[q].w) + (v1[q].x + v1[q].y) + (v1[q].z + v1[q].w); }
#pragma unroll
            for (int o = 1; o < 64; o <<= 1)
#pragma unroll
                for (int q = 0; q < PREP_TW; ++q) sm[q] += __shfl_xor(sm[q], o);
#pragma unroll
            for (int q = 0; q < PREP_TW; ++q) { const float mean = sm[q] * (1.0f / 512.0f); v0[q] = v0[q] - mean; v1[q] = v1[q] - mean;
                sm[q] = (v0[q].x * v0[q].x + v0[q].y * v0[q].y) + (v0[q].z * v0[q].z + v0[q].w * v0[q].w) + (v1[q].x * v1[q].x + v1[q].y * v1[q].y) + (v1[q].z * v1[q].z + v1[q].w * v1[q].w); }
#pragma unroll
            for (int o = 1; o < 64; o <<= 1)
#pragma unroll
                for (int q = 0; q < PREP_TW; ++q) sm[q] += __shfl_xor(sm[q], o);
#pragma unroll
            for (int q = 0; q < PREP_TW; ++q) { const int m = m0 + PREP_TW * wave + q; const float r = rsqrtf(sm[q] * (1.0f / 512.0f) + LN_EPS);
                f32x4 y0 = v0[q] * r * g0 + b0, y1 = v1[q] * r * g1 + b1;
                y0 = (f32x4){y0.x * sigmoidf_(y0.x), y0.y * sigmoidf_(y0.y), y0.z * sigmoidf_(y0.z), y0.w * sigmoidf_(y0.w)};
                y1 = (f32x4){y1.x * sigmoidf_(y1.x), y1.y * sigmoidf_(y1.y), y1.z * sigmoidf_(y1.z), y1.w * sigmoidf_(y1.w)};
                v4u o; o.x = cvtpk(y0.x, y0.y); o.y = cvtpk(y0.z, y0.w); o.z = cvtpk(y1.x, y1.y); o.w = cvtpk(y1.z, y1.w);
                *(GAS v4u*)(F.Y() + (size_t)m * DM + Y_D + c0) = o; } }
        __syncthreads();
    }
}

__device__ __forceinline__ void attn_phase_all(Frame& F, const int l, char* shm) {
    typedef attn_body::bf16 abf;
    const abf* Z = (const abf*)F.Z(); abf* Y = (abf*)F.Y();
    float gqm = __builtin_fabsf(F.q_norm_g()[l * 64 + F.lane]), gkm = __builtin_fabsf(F.k_norm_g()[l * 64 + F.lane]);
#pragma unroll
    for (int o = 1; o < 64; o <<= 1) { gqm = __builtin_fmaxf(gqm, __shfl_xor(gqm, o)); gkm = __builtin_fmaxf(gkm, __shfl_xor(gkm, o)); }
    const int ref0 = __builtin_amdgcn_readfirstlane((int)__builtin_ceilf(__builtin_fminf(__builtin_fmaxf((8.0f * LOG2E) * gqm * gkm - 15.5f, 0.f), 100.f)));
    const bool fast = ref0 <= 6;
    const float pscale = __int_as_float((127 + ref0) << 23);
    LAS int* const tkw = (LAS int*)(F.lds + LDSCTL_OFF + 64);
    unsigned* const ctrA = (unsigned*)(F.ctl() + CW_ATT + l * 128), * const ctrB = ctrA + 64;
#define ATT_BCAST(dst, v) do { if (F.tid == 0) *tkw = (v); asm volatile("s_waitcnt lgkmcnt(0)\n\ts_barrier" ::: "memory"); { const int r_ = *tkw; asm volatile("s_waitcnt lgkmcnt(0)\n\ts_barrier" ::: "memory"); (dst) = __builtin_amdgcn_readfirstlane(r_); } } while (0)
    {   int i = 0, tkt = -1;
        for (;;) {
            int idx;
            if (tkt < 0) { idx = i * F.G + F.vcu; ++i; if (idx >= 1024) { int t0 = 0; if (F.tid == 0) t0 = (int)__hip_atomic_fetch_add(ctrA, 1u, __ATOMIC_RELAXED, __HIP_MEMORY_SCOPE_AGENT); ATT_BCAST(tkt, t0); continue; } }
            else { if (tkt >= 256) break; idx = 1024 + tkt; }
            int tn = 0; if (tkt >= 0 && F.tid == 0) tn = (int)__hip_atomic_fetch_add(ctrA, 1u, __ATOMIC_RELAXED, __HIP_MEMORY_SCOPE_AGENT);
            const int r = idx >> 8, v = idx & 255, x = v >> 5, j = v & 31;
            int head, kv, qb, NT; long srow;
            if (r < 4) { const int sx = x >> 1; kv = sx & 1; head = kv * 4 + (x & 1) * 2 + (r >> 1); qb = (r & 1) * 32 + j; srow = (long)(sx >> 1) * SP; NT = SP / 64; }
            else { kv = x & 1; head = kv * 4 + (j >> 3); qb = j & 7; srow = (long)MP + (long)(x >> 1) * SS; NT = SS / 64; }
            const long qrow = srow + qb * 256;
            const size_t kvo = ((size_t)(kv * (M / 64)) + (size_t)(srow >> 6)) << 13;
            if (fast) attn_body::attn_unit<2, 8, 1>(Z + qrow * ZW + ZB_Q + head * 64, F.KT() + (kvo >> 1), F.VT() + (kvo >> 1), Y + qrow * DM + Y_B + head * 64, NT, 0, 0, pscale, qb * 256, F.q_norm_g() + l * 64, shm, F.wave0);
            else attn_body::attn_unit<0, 8, 1>(Z + qrow * ZW + ZB_Q + head * 64, F.KT() + (kvo >> 1), F.VT() + (kvo >> 1), Y + qrow * DM + Y_B + head * 64, NT, 0, 0, 0.f, qb * 256, F.q_norm_g() + l * 64, shm, F.wave0);
            if (tkt >= 0) ATT_BCAST(tkt, tn);
        }
    }
    {   int tkt, t0 = 0; if (F.tid == 0) t0 = (int)__hip_atomic_fetch_add(ctrB, 1u, __ATOMIC_RELAXED, __HIP_MEMORY_SCOPE_AGENT); ATT_BCAST(tkt, t0);
        while (tkt < 1280) {
            int tn = 0; if (F.tid == 0) tn = (int)__hip_atomic_fetch_add(ctrB, 1u, __ATOMIC_RELAXED, __HIP_MEMORY_SCOPE_AGENT);
            const int u = tkt, qblk = u >> 3, head = u & 7, kv = head >> 2; const long qrow = (long)qblk * 256;
            long srow; int S; if (qrow < MP) { srow = (qrow / SP) * SP; S = SP; } else { srow = MP + ((qrow - MP) / SS) * SS; S = SS; }
            const int q0 = (int)(qrow - srow);
            const float sink2 = F.sink_c()[l * 8 + head] * LOG2E;
            const size_t kvo = ((size_t)((2 + kv) * (M / 64)) + (size_t)(srow >> 6)) << 13;
            attn_body::attn_unit<1, 8, 2>(Z + qrow * ZW + ZC_Q + head * 64, F.KT() + (kvo >> 1), F.VT() + (kvo >> 1), Y + qrow * DM + Y_C + head * 64, 8, q0, S, sink2, q0, nullptr, shm, F.wave0);
            ATT_BCAST(tkt, tn);
        }
    }
#undef ATT_BCAST
}

struct Args { const float* in[18]; float* out; unsigned char* ws; int ph_lo, ph_hi, li, pad; };
__global__ void __launch_bounds__(NWAVES * 64, 2) fwd(Args args) {
    extern __shared__ __attribute__((aligned(16))) unsigned char lds[];
    Frame F;
    F.lds = (LAS unsigned char*)lds;
    F.MISC = (volatile LAS unsigned*)(F.lds + MISC_OFF);
    F.wave0 = __builtin_amdgcn_readfirstlane((int)(threadIdx.x >> 6)); F.tid = hw_tid(F.wave0); F.lane = F.tid & 63; F.wave = F.wave0;
    F.G = gridDim.x; { const int bx = blockIdx.x; F.vcu = (F.G % 8 == 0) ? (bx % 8) * (F.G / 8) + bx / 8 : bx; }
    unsigned char* ws = args.ws; F.ws = ws;
    F.out = args.out;
    bf16* const YPb = F.Z();
    bf16* const U0 = F.Y();
    bf16* const U1 = (bf16*)(ws + WS_U1);
    for (int u = F.tid; u < (LDS_BYTES - LDSCTL_OFF) / 4; u += NWAVES * 64) ((LAS unsigned*)(F.lds + LDSCTL_OFF))[u] = 0u;
    __syncthreads();
    XcdBarrier bar; bar.bar = (unsigned*)(F.ctl() + CW_BAR); bar.x = 0; bar.st = nullptr;
    if (MK_N_LAUNCHES == 1) bar = xcd_barrier_post((unsigned*)(F.ctl() + CW_BAR), F.MISC + 8, F.wave0);
    const int lo = args.ph_lo, hi = args.ph_hi; int ph = 0;
#define PH_BEGIN if (lo <= ph && ph < hi) { { int t_ = hw_tid(F.wave0); asm volatile("" : "+v"(t_)); F.tid = t_; F.lane = t_ & 63; F.wave = __builtin_amdgcn_readfirstlane(t_ >> 6); }
#define PH_END   if (ph + 1 < hi) xcd_barrier(bar); } ++ph;

    PH_BEGIN p0_prologue(F); PH_END

    auto layer_fn = [&](auto LC) __attribute__((always_inline)) { constexpr int l = decltype(LC)::value;
        PH_BEGIN { pg8::Gemm g{F.H(), wt_ptr(F, l, WO_IN), M, INW, DM}; pg8::StaticOrder S; S.init(M, INW, F.G, (int)blockIdx.x);
            pg8::EpiIn E{F.Z(), ZW, F.RS()};
            pg8::gemm_phase<pg8::EpiIn, pg8::StaticOrder, true, true>(F.lds + RING_OFF, g, S, E, F.wave0); } PH_END
        PH_BEGIN prep_phase(F, l); PH_END
        PH_BEGIN attn_phase_all(F, l, (char*)lds + RING_OFF); PH_END
        PH_BEGIN { pg8::Gemm g{F.Y(), wt_ptr(F, l, WO_OUT), M, DM, DM}; pg8::StaticOrder S; S.init(M, DM, F.G, (int)blockIdx.x);
            pg8::EpiBf16<0, false> E{YPb, DM, nullptr};
            pg8::gemm_phase<pg8::EpiBf16<0, false>, pg8::StaticOrder, true, true>(F.lds + RING_OFF, g, S, E, F.wave0); } PH_END
        PH_BEGIN if (l == 0) norm_pass<false, true>(F, YPb, F.post_mix_g() + l * DM); else norm_pass<false, false>(F, YPb, F.post_mix_g() + l * DM); PH_END
#define FF1_SITE(F8_, Uw_, hoff_) do { pg8::Gemm g{F.H() + (size_t)(hoff_) * MC * DM, wt_ptr(F, l, WO_F1), MC, FF, DM}; pg8::StaticOrder S; S.init(MC, FF, F.G, (int)blockIdx.x); \
            pg8::EpiBf16<2, true, true, F8_> E{Uw_, FF, F.RS() + (size_t)(hoff_) * MC}; \
            pg8::gemm_phase<pg8::EpiBf16<2, true, true, F8_>, pg8::StaticOrder, true, true>(F.lds + RING_OFF, g, S, E, F.wave0); } while (0)
#define FF2_SITE(F8_, Ur_, c_) do { pg8::Gemm g{Ur_, wt_ptr(F, l, WO_F2), MC, DM, (F8_) ? FF / 2 : FF}; pg8::StaticOrder S; S.init(MC, DM, F.G, (int)blockIdx.x); \
            pg8::EpiBf16<0, false, false, false, F8_> E{YPb + (size_t)(c_) * MC * DM, DM, nullptr}; \
            pg8::gemm_phase<pg8::EpiBf16<0, false, false, false, F8_>, pg8::StaticOrder, true, true, true, F8_>(F.lds + RING_OFF, g, S, E, F.wave0); } while (0)
        const bool f8l = (l == DEPTH - 1);
        PH_BEGIN { if (f8l) FF1_SITE(true, U0, 0); else FF1_SITE(false, U0, 0); } PH_END
#pragma unroll 1
        for (int c = 0; c + 1 < NCHUNK; ++c) {
            PH_BEGIN {
                bf16* const Ur = (c & 1) ? U1 : U0; bf16* const Uw = (c & 1) ? U0 : U1;
                if (f8l) FF2_SITE(true, Ur, c); else FF2_SITE(false, Ur, c);
                __syncthreads();
                if (f8l) FF1_SITE(true, Uw, c + 1); else FF1_SITE(false, Uw, c + 1);
            } PH_END
        }
        PH_BEGIN { bf16* const Ur = ((NCHUNK - 1) & 1) ? U1 : U0; if (f8l) FF2_SITE(true, Ur, NCHUNK - 1); else FF2_SITE(false, Ur, NCHUNK - 1); } PH_END
#undef FF1_SITE
#undef FF2_SITE
        PH_BEGIN if (l + 1 < DEPTH) norm_pass<false, false>(F, YPb, F.post_ffn_g() + l * DM); else norm_pass<true, false>(F, YPb, F.post_ffn_g() + l * DM); PH_END
    };
    layer_fn(std::integral_constant<int, 0>{}); layer_fn(std::integral_constant<int, 1>{}); static_assert(DEPTH == 2, "one layer_fn call per layer");
#undef PH_BEGIN
#undef PH_END
}

extern "C" void kernel_launch(void* const* d_in, const int* in_sizes, int n_in, void* d_out, int out_size, void* d_ws, size_t ws_size, hipStream_t stream) {
    static int grid = 0;
    if (grid == 0) {
        if (n_in != 18 || in_sizes[0] != MP * DM || in_sizes[1] != MS * DM || out_size != M * DM || ws_size < WS_END) {
            fprintf(stderr, "kernel_launch: unexpected shapes (n_in %d, in0 %d, in1 %d, out %d, ws %zu; need ws >= %zu); nothing launched\n", n_in, n_in > 0 ? in_sizes[0] : -1, n_in > 1 ? in_sizes[1] : -1, out_size, ws_size, (size_t)WS_END); grid = -1; return; }
        int dev = 0, cus = 0, per_cu = 0;
        if (hipGetDevice(&dev) != hipSuccess || hipDeviceGetAttribute(&cus, hipDeviceAttributeMultiprocessorCount, dev) != hipSuccess) { fprintf(stderr, "kernel_launch: device query failed\n"); grid = -1; return; }
        if (hipFuncSetAttribute((const void*)fwd, hipFuncAttributeMaxDynamicSharedMemorySize, LDS_BYTES) != hipSuccess) { fprintf(stderr, "kernel_launch: hipFuncSetAttribute failed\n"); grid = -1; return; }
        if (hipOccupancyMaxActiveBlocksPerMultiprocessor(&per_cu, (const void*)fwd, NWAVES * 64, LDS_BYTES) != hipSuccess || per_cu < 1)
            fprintf(stderr, "kernel_launch: note: occupancy query reports %d workgroups per CU\n", per_cu);
        (void)hipGetLastError();
        grid = cus;
    }
    if (grid < 0) return;
    if (hipMemsetAsync((char*)d_ws + WS_CTL, 0, CTL_ZERO_BYTES, stream) != hipSuccess) { fprintf(stderr, "kernel_launch: memset failed\n"); return; }
    Args a{};
    for (int i = 0; i < 18; ++i) a.in[i] = (const float*)d_in[i];
    a.out = (float*)d_out; a.ws = (unsigned char*)d_ws;
    for (int li = 0; li < MK_N_LAUNCHES; ++li) {
        a.ph_lo = (MK_N_LAUNCHES == 1) ? 0 : li; a.ph_hi = (MK_N_LAUNCHES == 1) ? N_PHASES : li + 1; a.li = li; a.pad = 0;
        hipLaunchKernelGGL(fwd, dim3(grid), dim3(NWAVES * 64), LDS_BYTES, stream, a);
        const hipError_t le = hipPeekAtLastError();
        if (le != hipSuccess) { fprintf(stderr, "kernel_launch: launch %d failed: %s\n", li, hipGetErrorName(le)); break; }
    }
}
```
